# Optimizing an MI355X kernel written in HIP

```python
import math
import jax, jax.numpy as jnp
from jax import lax
import numpy as np

D_MODEL = 2048
BATCH = 4
SEQ = 2048
DEPTH = 2
DEC_BATCH = 128
DEC_SEQ = 8
PAST_LEN = 8192
PAGE_SIZE = 128

ATTN_DIM = D_MODEL // 2
HEAD_DIM = 64
N_HEADS = ATTN_DIM // HEAD_DIM
N_KV_HEADS = N_HEADS // 4
GQA_GROUP = N_HEADS // N_KV_HEADS
KV_DIM = N_KV_HEADS * HEAD_DIM
WINDOW = 128
BLOCK = WINDOW
ROPE_DIM = HEAD_DIM // 4
ROPE_THETA = 500000.0
ATTN_SCALE = HEAD_DIM ** -0.5
CONV_DIM = D_MODEL // 4
CONV_WIDTH = 31
SSM_DIM = D_MODEL // 4
SSM_GROUP = 16
SSM_GROUPS = SSM_DIM // SSM_GROUP
SSM_STATE = 64
FF_DIM = 4 * D_MODEL
N_BRANCHES = 3
IN_SPLITS = (ATTN_DIM,
             ATTN_DIM + KV_DIM,
             ATTN_DIM + 2 * KV_DIM,
             ATTN_DIM + 2 * KV_DIM + 2 * CONV_DIM,
             ATTN_DIM + 2 * KV_DIM + 2 * CONV_DIM + SSM_DIM)
IN_DIM = IN_SPLITS[-1] + N_BRANCHES * D_MODEL
EPS = 1e-6

kernel_name = "hybrid_swa_conformer_s5_step"


def rms_norm(x, gain):
    xf = x.astype(jnp.float32)
    y = xf * lax.rsqrt(jnp.mean(xf * xf, axis=-1, keepdims=True) + EPS)
    return (y * gain.astype(jnp.float32)).astype(x.dtype)


def layer_norm(x, gain, bias):
    xf = x.astype(jnp.float32)
    mu = jnp.mean(xf, axis=-1, keepdims=True)
    xc = xf - mu
    y = xc * lax.rsqrt(jnp.mean(xc * xc, axis=-1, keepdims=True) + EPS)
    return (y * gain.astype(jnp.float32) + bias.astype(jnp.float32)).astype(x.dtype)


def partial_rope(x, pos):
    half = ROPE_DIM // 2
    inv_freq = ROPE_THETA ** (-2.0 * jnp.arange(half, dtype=jnp.float32) / ROPE_DIM)
    ang = pos.astype(jnp.float32)[:, None] * inv_freq[None, :]
    cos = jnp.cos(ang)[:, None, :]
    sin = jnp.sin(ang)[:, None, :]
    xf = x.astype(jnp.float32)
    x1 = xf[..., :half]
    x2 = xf[..., half:ROPE_DIM]
    out = jnp.concatenate([x1 * cos - x2 * sin, x2 * cos + x1 * sin, xf[..., ROPE_DIM:]], axis=-1)
    return out.astype(x.dtype)


def sink_softmax(s, sink):
    m = jnp.maximum(jnp.max(s, axis=-1, keepdims=True), sink)
    p = jnp.exp(s - m)
    return p / (jnp.sum(p, axis=-1, keepdims=True) + jnp.exp(sink - m))


def attention_prompt(q, k, v, sinks):
    bsz, t = q.shape[:2]
    nb = t // BLOCK
    qb = q.reshape(bsz, nb, BLOCK, N_KV_HEADS, GQA_GROUP, HEAD_DIM)
    pad = jnp.zeros((bsz, BLOCK, N_KV_HEADS, HEAD_DIM), k.dtype)
    kb = jnp.concatenate([pad, k], axis=1).reshape(bsz, nb + 1, BLOCK, N_KV_HEADS, HEAD_DIM)
    vb = jnp.concatenate([pad.astype(v.dtype), v], axis=1).reshape(bsz, nb + 1, BLOCK, N_KV_HEADS, HEAD_DIM)
    kk = jnp.concatenate([kb[:, :-1], kb[:, 1:]], axis=2)
    vv = jnp.concatenate([vb[:, :-1], vb[:, 1:]], axis=2)
    s = jnp.einsum('bnqkgd,bnjkd->bnkgqj', qb, kk, preferred_element_type=jnp.float32) * ATTN_SCALE
    qi = jnp.arange(BLOCK)[:, None]
    kj = jnp.arange(2 * BLOCK)[None, :]
    diff = BLOCK + qi - kj
    kpos = (jnp.arange(nb)[:, None, None] - 1) * BLOCK + kj
    mask = (diff >= 0) & (diff < WINDOW) & (kpos >= 0)
    s = jnp.where(mask[:, None, None], s, -jnp.inf)
    w = sink_softmax(s, sinks.astype(jnp.float32).reshape(N_KV_HEADS, GQA_GROUP, 1, 1))
    o = jnp.einsum('bnkgqj,bnjkd->bnqkgd', w.astype(v.dtype), vv)
    return o.reshape(bsz, t, ATTN_DIM)


def attention_sample(q, k, v, cache_k, cache_v, sinks, pos0):
    bsz, t = q.shape[:2]
    w_len = cache_k.shape[1]
    kk = jnp.concatenate([cache_k.astype(k.dtype), k], axis=1)
    vv = jnp.concatenate([cache_v.astype(v.dtype), v], axis=1)
    qg = q.reshape(bsz, t, N_KV_HEADS, GQA_GROUP, HEAD_DIM)
    s = jnp.einsum('bqkgd,bjkd->bkgqj', qg, kk, preferred_element_type=jnp.float32) * ATTN_SCALE
    qpos = pos0 + jnp.arange(t)
    kpos = pos0 - w_len + jnp.arange(w_len + t)
    diff = qpos[:, None] - kpos[None, :]
    mask = (diff >= 0) & (diff < WINDOW)
    s = jnp.where(mask, s, -jnp.inf)
    w = sink_softmax(s, sinks.astype(jnp.float32).reshape(N_KV_HEADS, GQA_GROUP, 1, 1))
    o = jnp.einsum('bkgqj,bjkd->bqkgd', w.astype(vv.dtype), vv)
    return o.reshape(bsz, t, ATTN_DIM), kk[:, -w_len:], vv[:, -w_len:]


def conv_module(xc, conv_buf, p):
    a, b = jnp.split(xc, 2, axis=-1)
    u = a * jax.nn.sigmoid(b)
    full = jnp.concatenate([conv_buf.astype(u.dtype), u], axis=1)
    y = lax.conv_general_dilated(full, p['conv_w'][:, None, :].astype(u.dtype),
                                 window_strides=(1,), padding='VALID',
                                 dimension_numbers=('NWC', 'WIO', 'NWC'),
                                 feature_group_count=CONV_DIM) + p['conv_b']
    y = jax.nn.silu(layer_norm(y, p['conv_ln_g'], p['conv_ln_b']))
    return y @ p['w_conv_out'], full[:, -(CONV_WIDTH - 1):]


def complex_affine_combine(e1, e2):
    a1r, a1i, b1r, b1i = e1
    a2r, a2i, b2r, b2i = e2
    return (a2r * a1r - a2i * a1i,
            a2r * a1i + a2i * a1r,
            a2r * b1r - a2i * b1i + b2r,
            a2r * b1i + a2i * b1r + b2i)


def s5_branch(xs, h0_re, h0_im, p):
    bsz, t, _ = xs.shape
    uf = xs.astype(jnp.float32).reshape(bsz, t, SSM_GROUPS, SSM_GROUP)
    a_re = p['ssm_a_re'].astype(jnp.float32)
    a_im = p['ssm_a_im'].astype(jnp.float32)
    dt = jnp.exp(p['ssm_log_dt'].astype(jnp.float32))[:, None]
    mag = jnp.exp(a_re * dt)
    ang = a_im * dt
    ab_re = mag * jnp.cos(ang)
    ab_im = mag * jnp.sin(ang)
    den = a_re * a_re + a_im * a_im
    z_re = ((ab_re - 1.0) * a_re + ab_im * a_im) / den
    z_im = (ab_im * a_re - (ab_re - 1.0) * a_im) / den
    bu_re = jnp.einsum('btgc,gpc->btgp', uf, p['ssm_b_re'].astype(jnp.float32))
    bu_im = jnp.einsum('btgc,gpc->btgp', uf, p['ssm_b_im'].astype(jnp.float32))
    x_re = z_re * bu_re - z_im * bu_im
    x_im = z_re * bu_im + z_im * bu_re
    h0r = h0_re.astype(jnp.float32)
    h0i = h0_im.astype(jnp.float32)
    x_re = x_re.at[:, 0].add(ab_re * h0r - ab_im * h0i)
    x_im = x_im.at[:, 0].add(ab_re * h0i + ab_im * h0r)
    shape = x_re.shape
    elems = (jnp.broadcast_to(ab_re, shape), jnp.broadcast_to(ab_im, shape), x_re, x_im)
    _, _, h_re, h_im = lax.associative_scan(complex_affine_combine, elems, axis=1)
    y = (jnp.einsum('btgp,gcp->btgc', h_re, p['ssm_c_re'].astype(jnp.float32))
         - jnp.einsum('btgp,gcp->btgc', h_im, p['ssm_c_im'].astype(jnp.float32)))
    y = y.reshape(bsz, t, SSM_DIM) + p['ssm_d'].astype(jnp.float32) * xs.astype(jnp.float32)
    y = jax.nn.gelu(y).astype(xs.dtype)
    out = (y @ p['w_glu_a']) * jax.nn.sigmoid(y @ p['w_glu_b'])
    return out, h_re[:, -1], h_im[:, -1]


def decoder_layer(x, c, pos0, cache_k, cache_v, conv_buf, h0_re, h0_im, p):
    bsz, t, _ = x.shape
    mod = jax.nn.silu(c) @ p['w_ada'] + p['b_ada']
    shift1, scale1, gate1, shift2, scale2, gate2 = [m[:, None, :] for m in jnp.split(mod, 6, axis=-1)]
    h = rms_norm(x, p['norm1']) * (1 + scale1) + shift1
    q, k, v, xc, xs, gl = jnp.split(h @ p['w_in'], IN_SPLITS, axis=-1)
    pos = pos0 + jnp.arange(t, dtype=jnp.int32)
    q = partial_rope(rms_norm(q.reshape(bsz, t, N_HEADS, HEAD_DIM), p['q_norm']), pos)
    k = partial_rope(rms_norm(k.reshape(bsz, t, N_KV_HEADS, HEAD_DIM), p['k_norm']), pos)
    v = v.reshape(bsz, t, N_KV_HEADS, HEAD_DIM)
    if cache_k is None:
        o = attention_prompt(q, k, v, p['sinks'])
        new_k, new_v = k[:, -WINDOW:], v[:, -WINDOW:]
    else:
        o, new_k, new_v = attention_sample(q, k, v, cache_k, cache_v, p['sinks'], pos0)
    y_attn = o @ p['w_o_attn']
    y_conv, new_conv = conv_module(xc, conv_buf, p)
    y_ssm, new_re, new_im = s5_branch(xs, h0_re, h0_im, p)
    g = jax.nn.sigmoid(gl).reshape(bsz, t, N_BRANCHES, D_MODEL)
    merged = g[:, :, 0] * y_attn + g[:, :, 1] * y_conv + g[:, :, 2] * y_ssm
    x = x + gate1 * (merged @ p['w_out'])
    h2 = rms_norm(x, p['norm2']) * (1 + scale2) + shift2
    ff = jnp.square(jax.nn.relu(h2 @ p['w_ff1'])) @ p['w_ff2']
    x = x + gate2 * ff
    return x, (new_k, new_v, new_conv, new_re, new_im)


def setup_inputs(seed: int = 0) -> dict:
    key = jax.random.key(seed)
    ks = iter(jax.random.split(key, 48))
    f32 = jnp.float32

    def nrm(shape, scale):
        return jax.random.normal(next(ks), shape, f32) * scale

    win_buf = min(WINDOW, PAST_LEN)
    a_re = -0.5 + nrm((DEPTH, SSM_GROUPS, SSM_STATE), 0.01)
    a_im = jnp.pi * jnp.arange(SSM_STATE, dtype=f32)[None, None, :] + nrm((DEPTH, SSM_GROUPS, SSM_STATE), 0.01)
    log_dt = jax.random.uniform(next(ks), (DEPTH, SSM_GROUPS), f32,
                                minval=math.log(1e-3), maxval=math.log(1e-1))
    return {
        'x_prompt': nrm((BATCH, SEQ, D_MODEL), 1.0),
        'x_sample': nrm((DEC_BATCH, DEC_SEQ, D_MODEL), 1.0),
        'c_prompt': nrm((BATCH, D_MODEL), 1.0),
        'c_sample': nrm((DEC_BATCH, D_MODEL), 1.0),
        'cache_k': nrm((DEPTH, DEC_BATCH, win_buf, N_KV_HEADS, HEAD_DIM), 1.0),
        'cache_v': nrm((DEPTH, DEC_BATCH, win_buf, N_KV_HEADS, HEAD_DIM), 1.0),
        'state_conv': nrm((DEPTH, DEC_BATCH, CONV_WIDTH - 1, CONV_DIM), 0.5),
        'state_ssm_re': nrm((DEPTH, DEC_BATCH, SSM_GROUPS, SSM_STATE), 0.3),
        'state_ssm_im': nrm((DEPTH, DEC_BATCH, SSM_GROUPS, SSM_STATE), 0.3),
        'w_ada': nrm((DEPTH, D_MODEL, 6 * D_MODEL), 0.5 * D_MODEL ** -0.5),
        'b_ada': nrm((DEPTH, 6 * D_MODEL), 0.01),
        'norm1': 1.0 + nrm((DEPTH, D_MODEL), 0.02),
        'w_in': nrm((DEPTH, D_MODEL, IN_DIM), D_MODEL ** -0.5),
        'q_norm': 1.0 + nrm((DEPTH, HEAD_DIM), 0.02),
        'k_norm': 1.0 + nrm((DEPTH, HEAD_DIM), 0.02),
        'sinks': nrm((DEPTH, N_HEADS), 0.5),
        'w_o_attn': nrm((DEPTH, ATTN_DIM, D_MODEL), ATTN_DIM ** -0.5),
        'conv_w': nrm((DEPTH, CONV_WIDTH, CONV_DIM), CONV_WIDTH ** -0.5),
        'conv_b': nrm((DEPTH, CONV_DIM), 0.01),
        'conv_ln_g': 1.0 + nrm((DEPTH, CONV_DIM), 0.02),
        'conv_ln_b': nrm((DEPTH, CONV_DIM), 0.01),
        'w_conv_out': nrm((DEPTH, CONV_DIM, D_MODEL), CONV_DIM ** -0.5),
        'ssm_a_re': a_re,
        'ssm_a_im': a_im,
        'ssm_log_dt': log_dt,
        'ssm_b_re': nrm((DEPTH, SSM_GROUPS, SSM_STATE, SSM_GROUP), (2 * SSM_GROUP) ** -0.5),
        'ssm_b_im': nrm((DEPTH, SSM_GROUPS, SSM_STATE, SSM_GROUP), (2 * SSM_GROUP) ** -0.5),
        'ssm_c_re': nrm((DEPTH, SSM_GROUPS, SSM_GROUP, SSM_STATE), SSM_STATE ** -0.5),
        'ssm_c_im': nrm((DEPTH, SSM_GROUPS, SSM_GROUP, SSM_STATE), SSM_STATE ** -0.5),
        'ssm_d': nrm((DEPTH, SSM_DIM), 1.0),
        'w_glu_a': nrm((DEPTH, SSM_DIM, D_MODEL), SSM_DIM ** -0.5),
        'w_glu_b': nrm((DEPTH, SSM_DIM, D_MODEL), SSM_DIM ** -0.5),
        'w_out': nrm((DEPTH, D_MODEL, D_MODEL), D_MODEL ** -0.5),
        'norm2': 1.0 + nrm((DEPTH, D_MODEL), 0.02),
        'w_ff1': nrm((DEPTH, D_MODEL, FF_DIM), D_MODEL ** -0.5),
        'w_ff2': nrm((DEPTH, FF_DIM, D_MODEL), FF_DIM ** -0.5),
    }


def reference(x_prompt, x_sample, c_prompt, c_sample, cache_k, cache_v, state_conv,
              state_ssm_re, state_ssm_im, w_ada, b_ada, norm1, w_in, q_norm, k_norm, sinks,
              w_o_attn, conv_w, conv_b, conv_ln_g, conv_ln_b, w_conv_out, ssm_a_re, ssm_a_im,
              ssm_log_dt, ssm_b_re, ssm_b_im, ssm_c_re, ssm_c_im, ssm_d, w_glu_a, w_glu_b,
              w_out, norm2, w_ff1, w_ff2):
    weights = dict(w_ada=w_ada, b_ada=b_ada, norm1=norm1, w_in=w_in, q_norm=q_norm,
                   k_norm=k_norm, sinks=sinks, w_o_attn=w_o_attn, conv_w=conv_w, conv_b=conv_b,
                   conv_ln_g=conv_ln_g, conv_ln_b=conv_ln_b, w_conv_out=w_conv_out,
                   ssm_a_re=ssm_a_re, ssm_a_im=ssm_a_im, ssm_log_dt=ssm_log_dt,
                   ssm_b_re=ssm_b_re, ssm_b_im=ssm_b_im, ssm_c_re=ssm_c_re, ssm_c_im=ssm_c_im,
                   ssm_d=ssm_d, w_glu_a=w_glu_a, w_glu_b=w_glu_b, w_out=w_out, norm2=norm2,
                   w_ff1=w_ff1, w_ff2=w_ff2)
    bp = x_prompt.shape[0]
    yp, ys = x_prompt, x_sample
    new_p = [[], [], [], [], []]
    new_s = [[], [], [], [], []]
    for l in range(DEPTH):
        p = {name: w[l] for name, w in weights.items()}
        zero_buf = jnp.zeros((bp, CONV_WIDTH - 1, CONV_DIM), x_prompt.dtype)
        zero_h = jnp.zeros((bp, SSM_GROUPS, SSM_STATE), jnp.float32)
        yp, st_p = decoder_layer(yp, c_prompt, 0, None, None, zero_buf, zero_h, zero_h, p)
        ys, st_s = decoder_layer(ys, c_sample, PAST_LEN, cache_k[l], cache_v[l], state_conv[l],
                                 state_ssm_re[l], state_ssm_im[l], p)
        for i in range(5):
            new_p[i].append(st_p[i])
            new_s[i].append(st_s[i])
    nkp, nvp, ncp, nrp, nip = [jnp.stack(a) for a in new_p]
    nks, nvs, ncs, nrs, nis = [jnp.stack(a) for a in new_s]
    return (yp, ys, nkp, nvp, ncp, nrp, nip, nks, nvs, ncs, nrs, nis)
```

```cpp
#include <hip/hip_runtime.h>
#include <hip/hip_cooperative_groups.h>
#include <cstdio>
#include <cstdint>
namespace cg = cooperative_groups;
namespace pg8 {
#define PG8_LAS __attribute__((address_space(3)))
typedef unsigned short bf16_t;
typedef short bf16x8 __attribute__((ext_vector_type(8)));
typedef float f32x4 __attribute__((ext_vector_type(4)));
typedef unsigned u32x4 __attribute__((ext_vector_type(4)));
constexpr int BM = 256, BK = 64, HALF = 128, HTB = HALF * BK * 2  , STAGE_BYTES = 8 * HTB, NXCD = 8, WGM = 8;

__host__ __device__ __forceinline__ int lds_byte(int r, int c) { const int st = (r >> 4) * 2 + (c >> 5), rr = r & 15, cc = c & 31, ob = rr * 64 + cc * 2; return st * 1024 + (ob ^ (((ob >> 9) & 1) << 5)); }
__host__ __device__ __forceinline__ void stage_rc(int b, int& R, int& C) { const int st = b / 1024, sb = b % 1024, swz = sb ^ (((sb >> 9) & 1) << 5); R = (st >> 1) * 16 + swz / 64; C = (st & 1) * 32 + (swz % 64) / 2; }
__host__ __device__ __forceinline__ int perm32(int rho) { const int n = rho >> 4, i = rho & 15; return 8 * (i >> 2) + 4 * n + (i & 3); }

struct Unit { int pm, pn; };
struct Gemm { const bf16_t* A; const bf16_t* Bt; int M, N, K; };

struct StaticOrder {
    int nM, nN, nwg, G, c;
    __host__ __device__ void init(int M, int N, int G_, int c_) { nM = M / BM; nN = N / BM; nwg = nM * nN; G = G_; c = c_; }
    __host__ __device__ bool next(int i, Unit& u) const {
        const long L = (long)i * G + c; if (L >= nwg) return false;
        int wgid = (int)L; { const int q = nwg / NXCD, r = nwg % NXCD, xcd = wgid % NXCD, off = wgid / NXCD; wgid = (xcd < r ? xcd * (q + 1) : r * (q + 1) + (xcd - r) * q) + off; }
        const int nig = WGM * nN, gid = wgid / nig, fm = gid * WGM, gsz = (nM - fm) < WGM ? (nM - fm) : WGM;
        u.pm = fm + ((wgid % nig) % gsz); u.pn = (wgid % nig) / gsz; return true;
    }
    __device__ __forceinline__ void a_ready(const Unit&) const {}
    __device__ __forceinline__ void done(const Unit&) const {}
};

__device__ __forceinline__ unsigned cvt_pk_bf16(float lo, float hi) { unsigned r; asm volatile("v_cvt_pk_bf16_f32 %0, %1, %2" : "=v"(r) : "v"(lo), "v"(hi)); return r; }
typedef float f32x2 __attribute__((ext_vector_type(2)));
template <class Epi, class Sched, bool ALIGN_EPI = false, bool SP2 = false>
__device__ __forceinline__ void gemm_phase(PG8_LAS unsigned char* lds, const Gemm g, const Sched& S, const Epi& E) {
    int tid_ = threadIdx.x; asm volatile("" : "+v"(tid_));
    const int tid = tid_, wid = __builtin_amdgcn_readfirstlane(tid >> 6), lane = tid & 63, wr = wid >> 2, wc = wid & 3, fr = lane & 15, fq = lane >> 4;
    const int K = g.K, nt = K / BK;
    unsigned voffA[2], voffB[2];
#pragma unroll
    for (int i = 0; i < 2; ++i) { int R, C; stage_rc(tid * 16 + i * 8192, R, C); const int Rb = Epi::PERM ? ((R & ~31) + perm32(R & 31)) : R;
        voffA[i] = (unsigned)(R * K + C) * 2u; voffB[i] = (unsigned)(Rb * K + C) * 2u; }
    const size_t kstep = (size_t)(BK * 2);
    const size_t hstep = (size_t)HALF * K * 2;
    const size_t tstep = 2 * hstep;
    const unsigned ldsw = (unsigned)wid * 1024u;
    const int aoff = lds_byte(wr * 64 + fr, fq * 8), boff = lds_byte(wc * 32 + fr, fq * 8);
#define PG8_SA(b, h) (((b) * 2 + (h)) * HTB)
#define PG8_SB(b, h) ((4 + (b) * 2 + (h)) * HTB)
#define PG8_STAGE(bufoff, gbase, voff) do { _Pragma("unroll") for (int _i = 0; _i < 2; ++_i) \
        __builtin_amdgcn_global_load_lds((const unsigned*)((const char*)(gbase) + (voff)[_i]), (PG8_LAS unsigned*)(lds + (bufoff) + ldsw + _i * 8192), 16, 0, 0); } while (0)
#define PG8_LDA(dst, b, h) do { _Pragma("unroll") for (int m = 0; m < 4; ++m) _Pragma("unroll") for (int k = 0; k < 2; ++k) dst[m][k] = *(const PG8_LAS bf16x8*)(lds + PG8_SA(b, h) + aoff + m * 2048 + k * 1024); } while (0)
#define PG8_LDB(dst, b, h) do { _Pragma("unroll") for (int n = 0; n < 2; ++n) _Pragma("unroll") for (int k = 0; k < 2; ++k) dst[n][k] = *(const PG8_LAS bf16x8*)(lds + PG8_SB(b, h) + boff + n * 2048 + k * 1024); } while (0)
#define PG8_MMA(ai, bj, At, Bt) do { __builtin_amdgcn_s_setprio(1); _Pragma("unroll") for (int m = 0; m < 4; ++m) _Pragma("unroll") for (int n = 0; n < 2; ++n) _Pragma("unroll") for (int k = 0; k < 2; ++k) \
        acc[ai][bj][m][n] = __builtin_amdgcn_mfma_f32_16x16x32_bf16(Bt[n][k], At[m][k], acc[ai][bj][m][n], 0, 0, 0); __builtin_amdgcn_s_setprio(0); } while (0)
#define PG8_WAIT_V(n) asm volatile("s_waitcnt vmcnt(" #n ")" ::: "memory")
#define PG8_WAIT_L(n) asm volatile("s_waitcnt lgkmcnt(" #n ")" ::: "memory")
#define PG8_BAR __builtin_amdgcn_s_barrier()
#define PG8_SCHED __builtin_amdgcn_sched_barrier(0)
    Unit cur, nxt; int ui = 0;
    if (!S.next(0, cur)) return;
    f32x4 acc[2][2][4][2];
#pragma unroll
    for (int a = 0; a < 2; ++a)
#pragma unroll
        for (int b = 0; b < 2; ++b)
#pragma unroll
            for (int m = 0; m < 4; ++m)
#pragma unroll
                for (int n = 0; n < 2; ++n) acc[a][b][m][n] = (f32x4){0.f, 0.f, 0.f, 0.f};
    bf16x8 At[4][2], B0[2][2], B1[2][2];
    const char* cA = (const char*)g.A + (size_t)cur.pm * tstep; const char* cB = (const char*)g.Bt + (size_t)cur.pn * tstep;
    S.a_ready(cur);
    if constexpr (SP2) {
        PG8_STAGE(PG8_SB(0, 0), cB, voffB); PG8_STAGE(PG8_SB(0, 1), cB + hstep, voffB); PG8_STAGE(PG8_SA(0, 0), cA, voffA); PG8_STAGE(PG8_SA(0, 1), cA + hstep, voffA);
        if (wr == 1) PG8_BAR;
        PG8_WAIT_V(2); PG8_BAR;
        PG8_STAGE(PG8_SB(1, 0), cB + kstep, voffB); PG8_STAGE(PG8_SA(1, 0), cA + kstep, voffA); PG8_STAGE(PG8_SB(1, 1), cB + hstep + kstep, voffB);
        PG8_WAIT_V(6); PG8_BAR;
    } else {
        PG8_STAGE(PG8_SB(0, 0), cB, voffB); PG8_STAGE(PG8_SA(0, 0), cA, voffA); PG8_STAGE(PG8_SB(0, 1), cB + hstep, voffB); PG8_STAGE(PG8_SA(0, 1), cA + hstep, voffA);
        if (wr == 1) PG8_BAR;
        PG8_WAIT_V(4); PG8_BAR;
        PG8_STAGE(PG8_SB(1, 0), cB + kstep, voffB); PG8_STAGE(PG8_SA(1, 0), cA + kstep, voffA); PG8_STAGE(PG8_SB(1, 1), cB + hstep + kstep, voffB);
        PG8_WAIT_V(6); PG8_BAR;
    }
    for (;;) {
        const bool has_next = S.next(ui + 1, nxt);
        const char* nA = has_next ? (const char*)g.A + (size_t)nxt.pm * tstep : cA; const char* nB = has_next ? (const char*)g.Bt + (size_t)nxt.pn * tstep : cB;
        for (int t = 0; t < nt; t += 2) {
            const bool last = (t == nt - 2);
            const char* a1 = cA + (size_t)(t + 1) * kstep;
            const char* a2 = last ? nA : cA + (size_t)(t + 2) * kstep; const char* b2 = last ? nB : cB + (size_t)(t + 2) * kstep;
            const char* a3 = a2 + kstep; const char* b3 = b2 + kstep;
            if (last && has_next) S.a_ready(nxt);
            if constexpr (SP2) {
            PG8_LDB(B0, 0, 0); PG8_LDB(B1, 0, 1); PG8_SCHED; PG8_LDA(At, 0, 0); PG8_STAGE(PG8_SA(1, 1), a1 + hstep, voffA);
            PG8_WAIT_V(8); PG8_WAIT_L(0); PG8_BAR; PG8_MMA(0, 0, At, B0); PG8_MMA(0, 1, At, B1); PG8_BAR; PG8_SCHED;
            PG8_LDA(At, 0, 1); PG8_STAGE(PG8_SB(0, 0), b2, voffB); PG8_STAGE(PG8_SB(0, 1), b2 + hstep, voffB); PG8_STAGE(PG8_SA(0, 0), a2, voffA);
            PG8_WAIT_V(8); PG8_WAIT_L(0); PG8_BAR; PG8_MMA(1, 0, At, B0); PG8_MMA(1, 1, At, B1); PG8_BAR; PG8_SCHED;
            PG8_LDB(B0, 1, 0); PG8_LDB(B1, 1, 1); PG8_SCHED; PG8_LDA(At, 1, 0); PG8_STAGE(PG8_SA(0, 1), a2 + hstep, voffA);
            PG8_WAIT_V(8); PG8_WAIT_L(0); PG8_BAR; PG8_MMA(0, 0, At, B0); PG8_MMA(0, 1, At, B1); PG8_BAR; PG8_SCHED;
            PG8_LDA(At, 1, 1); PG8_STAGE(PG8_SB(1, 0), b3, voffB); PG8_STAGE(PG8_SB(1, 1), b3 + hstep, voffB); PG8_STAGE(PG8_SA(1, 0), a3, voffA);
            PG8_WAIT_V(8); PG8_WAIT_L(0); PG8_BAR; PG8_MMA(1, 0, At, B0); PG8_MMA(1, 1, At, B1); PG8_BAR; PG8_SCHED;
            } else {
            PG8_LDB(B0, 0, 0); PG8_SCHED; PG8_LDA(At, 0, 0); PG8_STAGE(PG8_SA(1, 1), a1 + hstep, voffA);
            PG8_WAIT_L(8); PG8_BAR; PG8_WAIT_L(0); PG8_MMA(0, 0, At, B0); PG8_BAR; PG8_SCHED;
            PG8_LDB(B1, 0, 1); PG8_STAGE(PG8_SB(0, 0), b2, voffB);
            PG8_BAR; PG8_WAIT_L(0); PG8_MMA(0, 1, At, B1); PG8_BAR;
            PG8_LDA(At, 0, 1); PG8_STAGE(PG8_SA(0, 0), a2, voffA);
            PG8_BAR; PG8_WAIT_L(0); PG8_MMA(1, 0, At, B0); PG8_BAR; PG8_SCHED;
            PG8_STAGE(PG8_SB(0, 1), b2 + hstep, voffB);
            PG8_WAIT_V(6); PG8_BAR; PG8_MMA(1, 1, At, B1); PG8_BAR;
            PG8_LDB(B0, 1, 0); PG8_SCHED; PG8_LDA(At, 1, 0); PG8_STAGE(PG8_SA(0, 1), a2 + hstep, voffA);
            PG8_WAIT_L(8); PG8_BAR; PG8_WAIT_L(0); PG8_MMA(0, 0, At, B0); PG8_BAR; PG8_SCHED;
            PG8_LDB(B1, 1, 1); PG8_STAGE(PG8_SB(1, 0), b3, voffB);
            PG8_BAR; PG8_WAIT_L(0); PG8_MMA(0, 1, At, B1); PG8_BAR;
            PG8_LDA(At, 1, 1); PG8_STAGE(PG8_SA(1, 0), a3, voffA);
            PG8_BAR; PG8_WAIT_L(0); PG8_MMA(1, 0, At, B0); PG8_BAR; PG8_SCHED;
            PG8_STAGE(PG8_SB(1, 1), b3 + hstep, voffB);
            PG8_WAIT_V(6); PG8_BAR; PG8_MMA(1, 1, At, B1); PG8_BAR;
            }
        }
        if constexpr (ALIGN_EPI) { if (wr == 0) PG8_BAR; }
        if constexpr (!Epi::AFTER_DRAIN) { E(acc, cur, wr, wc, fr, fq); S.done(cur); }
        if (!has_next) break;
#pragma unroll
        for (int a = 0; a < 2; ++a)
#pragma unroll
            for (int b = 0; b < 2; ++b)
#pragma unroll
                for (int m = 0; m < 4; ++m)
#pragma unroll
                    for (int n = 0; n < 2; ++n) acc[a][b][m][n] = (f32x4){0.f, 0.f, 0.f, 0.f};
        cur = nxt; cA = nA; cB = nB; ++ui;
        if constexpr (ALIGN_EPI) { if (wr == 1) PG8_BAR; }
    }
    PG8_WAIT_V(0);
    if constexpr (!ALIGN_EPI) { if (wr == 0) PG8_BAR; }
    PG8_BAR;
    if constexpr (Epi::AFTER_DRAIN) { E.fused(acc, cur, wr, wc, fr, fq, lds, wid, lane); S.done(cur); }
#undef PG8_SA
#undef PG8_SB
#undef PG8_STAGE
#undef PG8_LDA
#undef PG8_LDB
#undef PG8_MMA
#undef PG8_WAIT_V
#undef PG8_WAIT_L
#undef PG8_BAR
#undef PG8_SCHED
}
}

#define LAS __attribute__((address_space(3)))
typedef unsigned short bf16;
typedef unsigned v4u __attribute__((ext_vector_type(4)));
typedef unsigned v2u __attribute__((ext_vector_type(2)));
typedef float f32x4 __attribute__((ext_vector_type(4)));
typedef float f32x2 __attribute__((ext_vector_type(2)));
typedef short bf16x8 __attribute__((ext_vector_type(8)));
typedef short s16x4 __attribute__((ext_vector_type(4)));

#ifndef MK_ONE_LAUNCH
#define MK_ONE_LAUNCH 0
#endif

constexpr int DM = 2048, NTOK = 9216, NPTOK = 8192, SEQ = 2048, NB = 4, DECB = 128, DECT = 8;
constexpr int IN_DIM = 9216, FF = 8192, ADA_N = 12288;
constexpr int C_K = 1024, C_V = 1280, C_XA = 1536, C_XB = 2048, C_XS = 2560, C_G = 3072;
constexpr int NMODROW = 132;
constexpr int NPHASE = 20;

constexpr size_t MiB = 1u << 20;
constexpr size_t WS_ROPE = 1 * MiB, WS_AC = 2 * MiB, WS_MOD = 3 * MiB, WS_WADA = 16 * MiB;
constexpr size_t WS_WL = 112 * MiB, WL_STRIDE = 118 * MiB;
constexpr size_t WL_IN = 0, WL_O = 36 * MiB, WL_CO = 40 * MiB, WL_GA = 42 * MiB, WL_GB = 44 * MiB, WL_OUT = 46 * MiB, WL_F1 = 54 * MiB, WL_F2 = 86 * MiB;
constexpr size_t WS_H = 348 * MiB;
constexpr size_t WS_P = 384 * MiB;
constexpr size_t WS_QN = 546 * MiB, WS_KN = 564 * MiB, WS_O = 569 * MiB, WS_YC = 587 * MiB, WS_YS = 596 * MiB;
constexpr size_t WS_MG = 605 * MiB;
constexpr size_t WS_X = 677 * MiB;
constexpr size_t WS_END = 749 * MiB;

constexpr size_t O_Y = 0;
constexpr size_t O_NKP = (size_t)NTOK * DM;
constexpr size_t O_NVP = O_NKP + 2 * 4 * 128 * 256;
constexpr size_t O_NCP = O_NVP + 2 * 4 * 128 * 256;
constexpr size_t O_NRP = O_NCP + 2 * 4 * 30 * 512;
constexpr size_t O_NIP = O_NRP + 2 * 4 * 32 * 64;
constexpr size_t O_NKS = O_NIP + 2 * 4 * 32 * 64;
constexpr size_t O_NVS = O_NKS + (size_t)2 * 128 * 128 * 256;
constexpr size_t O_NCS = O_NVS + (size_t)2 * 128 * 128 * 256;
constexpr size_t O_NRS = O_NCS + (size_t)2 * 128 * 30 * 512;
constexpr size_t O_NIS = O_NRS + (size_t)2 * 128 * 32 * 64;
constexpr size_t O_END = O_NIS + (size_t)2 * 128 * 32 * 64;

constexpr int LDS_BYTES = 135168;

struct Args { const float* in[36]; float* out; unsigned char* ws; int ph_lo, ph_hi; };

enum { I_XP = 0, I_XS, I_CP, I_CS, I_CK, I_CV, I_SCONV, I_SRE, I_SIM, I_WADA, I_BADA, I_NORM1, I_WIN, I_QN, I_KN, I_SINK, I_WO, I_CW, I_CB, I_CLG, I_CLB, I_WCO,
       I_ARE, I_AIM, I_LDT, I_BRE, I_BIM, I_CRE, I_CIM, I_SD, I_WGA, I_WGB, I_WOUT, I_NORM2, I_WF1, I_WF2 };

__device__ __forceinline__ float bf2f(unsigned b) { return __uint_as_float(b << 16); }
__device__ __forceinline__ unsigned f2bf(float f) { unsigned u = __float_as_uint(f); return (u + 0x7fffu + ((u >> 16) & 1u)) >> 16; }
__device__ __forceinline__ unsigned pk2(float lo, float hi) { return f2bf(lo) | (f2bf(hi) << 16); }
__device__ __forceinline__ float lo16(unsigned w) { return __uint_as_float(w << 16); }
__device__ __forceinline__ float hi16(unsigned w) { return __uint_as_float(w & 0xffff0000u); }
__device__ __forceinline__ float sigm(float x) { return 1.f / (1.f + __expf(-x)); }
__device__ __forceinline__ float wave_sum(float v) {
#pragma unroll
    for (int o = 1; o < 64; o <<= 1) v += __shfl_xor(v, o);
    return v;
}
#define LDS_WAIT() asm volatile("s_waitcnt lgkmcnt(0)" ::: "memory")
#define WAVE_SYNC() do { asm volatile("s_waitcnt lgkmcnt(0)" ::: "memory"); __builtin_amdgcn_wave_barrier(); asm volatile("" ::: "memory"); } while (0)

__device__ __forceinline__ double dexp_(double x) {
    const double kf = rint(x * 1.4426950408889634);
    double r = fma(-kf, 6.93147180369123816490e-01, x); r = fma(-kf, 1.90821492927058770002e-10, r);
    double p = 1.0 / 6227020800.0;
    p = fma(p, r, 1.0 / 479001600.0); p = fma(p, r, 1.0 / 39916800.0); p = fma(p, r, 1.0 / 3628800.0); p = fma(p, r, 1.0 / 362880.0);
    p = fma(p, r, 1.0 / 40320.0); p = fma(p, r, 1.0 / 5040.0); p = fma(p, r, 1.0 / 720.0); p = fma(p, r, 1.0 / 120.0);
    p = fma(p, r, 1.0 / 24.0); p = fma(p, r, 1.0 / 6.0); p = fma(p, r, 0.5); p = fma(p, r, 1.0); p = fma(p, r, 1.0);
    const long long k = (long long)kf;
    return p * __longlong_as_double((1023ll + k) << 52);
}
__device__ __forceinline__ void dsincos_(double x, double& sn, double& cs) {
    const double kf = rint(x * 0.15915494309189535);
    double r = fma(-kf, 6.283185307179586, x); r = fma(-kf, 2.4492935982947064e-16, r);
    const double s = r * 0.125, z = s * s;
    double ps = -1.0 / 355687428096000.0;
    ps = fma(ps, z, 1.0 / 1307674368000.0); ps = fma(ps, z, -1.0 / 6227020800.0); ps = fma(ps, z, 1.0 / 39916800.0); ps = fma(ps, z, -1.0 / 362880.0);
    ps = fma(ps, z, 1.0 / 5040.0); ps = fma(ps, z, -1.0 / 120.0); ps = fma(ps, z, 1.0 / 6.0);
    double a = s - s * z * ps;
    double pc = 1.0 / 20922789888000.0;
    pc = fma(pc, z, -1.0 / 87178291200.0); pc = fma(pc, z, 1.0 / 479001600.0); pc = fma(pc, z, -1.0 / 3628800.0); pc = fma(pc, z, 1.0 / 40320.0);
    pc = fma(pc, z, -1.0 / 720.0); pc = fma(pc, z, 1.0 / 24.0); pc = fma(pc, z, -0.5);
    double b = fma(pc, z, 1.0);
#pragma unroll
    for (int i = 0; i < 3; ++i) { const double a2 = 2.0 * a * b, b2 = 1.0 - 2.0 * a * a; a = a2; b = b2; }
    sn = a; cs = b;
}

namespace pg8 {
#define EPI_FOREACH4(...) \
    _Pragma("unroll") for (int ai = 0; ai < 2; ++ai) _Pragma("unroll") for (int m = 0; m < 4; ++m) { const int row = u.pm * BM + ai * HALF + wr * 64 + m * 16 + fr; \
    _Pragma("unroll") for (int bj = 0; bj < 2; ++bj) _Pragma("unroll") for (int n = 0; n < 2; ++n) { const int col = u.pn * BM + bj * HALF + wc * 32 + n * 16 + 4 * fq; const f32x4 v = acc[ai][bj][m][n]; __VA_ARGS__ } asm volatile("" ::: "memory"); __builtin_amdgcn_sched_barrier(0); }
#define EPI_FOREACH8(...) \
    _Pragma("unroll") for (int ai = 0; ai < 2; ++ai) _Pragma("unroll") for (int m = 0; m < 4; ++m) { const int row = u.pm * BM + ai * HALF + wr * 64 + m * 16 + fr; \
    _Pragma("unroll") for (int bj = 0; bj < 2; ++bj) { const int col = u.pn * BM + bj * HALF + wc * 32 + 8 * fq; const f32x4 v0 = acc[ai][bj][m][0], v1 = acc[ai][bj][m][1]; __VA_ARGS__ } asm volatile("" ::: "memory"); __builtin_amdgcn_sched_barrier(0); }
#define EPI_SIG const f32x4 (&acc)[2][2][4][2], const Unit& u, int wr, int wc, int fr, int fq

__device__ __forceinline__ int mod_row(int row) { return row < NPTOK ? (row >> 11) : 4 + ((row - NPTOK) >> 3); }
__device__ __forceinline__ v4u pack8(const f32x4 a, const f32x4 b) { v4u w; w.x = cvt_pk_bf16(a[0], a[1]); w.y = cvt_pk_bf16(a[2], a[3]); w.z = cvt_pk_bf16(b[0], b[1]); w.w = cvt_pk_bf16(b[2], b[3]); return w; }

struct EpiAda {
    static constexpr bool PERM = false, AFTER_DRAIN = false; float* mod; const float* bias;
    __device__ __forceinline__ void operator()(EPI_SIG) const {
        EPI_FOREACH4( if (row < NMODROW) { const f32x4 bv = *(const f32x4*)(bias + col); *(f32x4*)(mod + row * (2 * ADA_N) + col) = v + bv; } )
    }
};
struct EpiP {
    static constexpr bool PERM = true, AFTER_DRAIN = false; bf16_t* P;
    __device__ __forceinline__ void operator()(EPI_SIG) const {
        const bool sg = (u.pn * BM) >= C_G;
        EPI_FOREACH8( f32x4 a = v0, b = v1; if (sg) {
            _Pragma("unroll") for (int i = 0; i < 4; ++i) { a[i] = sigm(a[i]); b[i] = sigm(b[i]); } }
            *(v4u*)(P + (unsigned)(row * IN_DIM + col)) = pack8(a, b); )
    }
};
struct EpiStoreF32 {
    static constexpr bool PERM = false, AFTER_DRAIN = false; float* MG;
    __device__ __forceinline__ void operator()(EPI_SIG) const { EPI_FOREACH4( *(f32x4*)(MG + (unsigned)(row * DM + col)) = v; ) }
};
__device__ __forceinline__ f32x4 gate4(const bf16_t* P, int row, int col, int br) {
    const v2u g = *(const v2u*)(P + (unsigned)(row * IN_DIM + C_G + br * DM + col)); return (f32x4){lo16(g.x), hi16(g.x), lo16(g.y), hi16(g.y)};
}
struct EpiGluB {
    static constexpr bool PERM = false, AFTER_DRAIN = false; float* MG; const bf16_t* P;
    __device__ __forceinline__ void operator()(EPI_SIG) const {
        EPI_FOREACH4( float* p = MG + (unsigned)(row * DM + col); const f32x4 a = *(const f32x4*)p; const f32x4 g = gate4(P, row, col, 2); f32x4 o;
            _Pragma("unroll") for (int i = 0; i < 4; ++i) o[i] = g[i] * a[i] * sigm(v[i]);
            *(f32x4*)p = o; )
    }
};
struct EpiAccG {
    static constexpr bool PERM = false, AFTER_DRAIN = false; float* MG; const bf16_t* P; int br;
    __device__ __forceinline__ void operator()(EPI_SIG) const {
        EPI_FOREACH4( float* p = MG + (unsigned)(row * DM + col); const f32x4 a = *(const f32x4*)p; const f32x4 g = gate4(P, row, col, br); *(f32x4*)p = a + g * v; )
    }
};
struct EpiMergeFinal {
    static constexpr bool PERM = false, AFTER_DRAIN = false; const float* MG; const bf16_t* P; bf16_t* MGb; int br;
    __device__ __forceinline__ void operator()(EPI_SIG) const {
        EPI_FOREACH4( const f32x4 a = *(const f32x4*)(MG + (unsigned)(row * DM + col)); const f32x4 g = gate4(P, row, col, br); const f32x4 o = a + g * v;
            v2u w; w.x = cvt_pk_bf16(o[0], o[1]); w.y = cvt_pk_bf16(o[2], o[3]); *(v2u*)(MGb + (unsigned)(row * DM + col)) = w; )
    }
};
struct EpiResid {
    static constexpr bool PERM = false, AFTER_DRAIN = false; const float* xp; const float* xs; const float* gate; float* out;
    __device__ __forceinline__ void operator()(EPI_SIG) const {
        const bool smp = u.pm * BM >= NPTOK; const float* xb = smp ? xs : xp; const int rb = smp ? NPTOK : 0;
        EPI_FOREACH4( const f32x4 x = *(const f32x4*)(xb + (unsigned)((row - rb) * DM + col));
            const int mr = smp ? 4 + ((row - NPTOK) >> 3) : (row >> 11);
            const f32x4 g = *(const f32x4*)(gate + (unsigned)(mr * (2 * ADA_N) + col)); *(f32x4*)(out + (unsigned)(row * DM + col)) = x + g * v; )
    }
};
struct EpiRelu2 {
    static constexpr bool PERM = true, AFTER_DRAIN = false; bf16_t* F;
    __device__ __forceinline__ void operator()(EPI_SIG) const {
        EPI_FOREACH8( f32x4 a = v0, b = v1;
            _Pragma("unroll") for (int i = 0; i < 4; ++i) { const float x = fmaxf(a[i], 0.f), y = fmaxf(b[i], 0.f); a[i] = x * x; b[i] = y * y; }
            *(v4u*)(F + (unsigned)(row * FF + col)) = pack8(a, b); )
    }
};
}

__device__ __forceinline__ void p0_transpose_item(const float* W, int K, int N, bf16* WT, int row_off, LAS float* scr, int item, int lane) {
    const int nblk = N / 32, kb = item / nblk, nb = item % nblk, k0 = 64 * kb, n0 = 32 * nb;
#pragma unroll 8
    for (int i = 0; i < 32; ++i) { const int kk = 2 * i + (lane >> 5); scr[kk * 33 + (lane & 31)] = W[(size_t)(k0 + kk) * N + n0 + (lane & 31)]; }
    LDS_WAIT(); asm volatile("" ::: "memory");
    const int c = lane & 7;
#pragma unroll
    for (int j = 0; j < 4; ++j) { const int n = (lane >> 3) + 8 * j; const LAS float* s = scr + (8 * c) * 33 + n;
        v4u o; o.x = pk2(s[0 * 33], s[1 * 33]); o.y = pk2(s[2 * 33], s[3 * 33]); o.z = pk2(s[4 * 33], s[5 * 33]); o.w = pk2(s[6 * 33], s[7 * 33]);
        *(v4u*)(WT + (size_t)(row_off + n0 + n) * K + k0 + 8 * c) = o; }
    LDS_WAIT(); asm volatile("" ::: "memory");
}

__device__ __forceinline__ void p0_prologue(const Args& a, LAS unsigned char* lds, int gw, int NGW, int lane, int wave, int gtid, int NGT) {
    LAS float* scr = (LAS float*)(lds + wave * 16384);
    unsigned char* ws = a.ws;
    constexpr int I_ADA = (DM / 64) * (ADA_N / 32), I_IN = (DM / 64) * (IN_DIM / 32), I_O = (1024 / 64) * (DM / 32), I_CO = (512 / 64) * (DM / 32), I_G = I_CO,
                  I_OUT = (DM / 64) * (DM / 32), I_F1 = (DM / 64) * (FF / 32), I_F2 = (FF / 64) * (DM / 32);
    constexpr int PER_LAYER = I_ADA + I_IN + I_O + I_CO + 2 * I_G + I_OUT + I_F1 + I_F2;
    for (int it = gw; it < 2 * PER_LAYER; it += NGW) {
        const int l = it / PER_LAYER; int r = it - l * PER_LAYER;
        bf16* wl = (bf16*)(ws + WS_WL + (size_t)l * WL_STRIDE);
        if (r < I_ADA) { p0_transpose_item(a.in[I_WADA] + (size_t)l * DM * ADA_N, DM, ADA_N, (bf16*)(ws + WS_WADA), l * ADA_N, scr, r, lane); continue; } r -= I_ADA;
        if (r < I_IN) { p0_transpose_item(a.in[I_WIN] + (size_t)l * DM * IN_DIM, DM, IN_DIM, wl + WL_IN / 2, 0, scr, r, lane); continue; } r -= I_IN;
        if (r < I_O) { p0_transpose_item(a.in[I_WO] + (size_t)l * 1024 * DM, 1024, DM, wl + WL_O / 2, 0, scr, r, lane); continue; } r -= I_O;
        if (r < I_CO) { p0_transpose_item(a.in[I_WCO] + (size_t)l * 512 * DM, 512, DM, wl + WL_CO / 2, 0, scr, r, lane); continue; } r -= I_CO;
        if (r < I_G) { p0_transpose_item(a.in[I_WGA] + (size_t)l * 512 * DM, 512, DM, wl + WL_GA / 2, 0, scr, r, lane); continue; } r -= I_G;
        if (r < I_G) { p0_transpose_item(a.in[I_WGB] + (size_t)l * 512 * DM, 512, DM, wl + WL_GB / 2, 0, scr, r, lane); continue; } r -= I_G;
        if (r < I_OUT) { p0_transpose_item(a.in[I_WOUT] + (size_t)l * DM * DM, DM, DM, wl + WL_OUT / 2, 0, scr, r, lane); continue; } r -= I_OUT;
        if (r < I_F1) { p0_transpose_item(a.in[I_WF1] + (size_t)l * DM * FF, DM, FF, wl + WL_F1 / 2, 0, scr, r, lane); continue; } r -= I_F1;
        p0_transpose_item(a.in[I_WF2] + (size_t)l * FF * DM, FF, DM, wl + WL_F2 / 2, 0, scr, r, lane);
    }
    unsigned* AC = (unsigned*)(ws + WS_AC);
    for (int i = gtid; i < 256 * DM / 2; i += NGT) {
        const int row = i / (DM / 2), c2 = (i % (DM / 2)) * 2; unsigned w = 0u;
        if (row < NMODROW) { const float* src = row < 4 ? a.in[I_CP] + row * DM + c2 : a.in[I_CS] + (row - 4) * DM + c2; const float x = src[0], y = src[1]; w = pk2(x * sigm(x), y * sigm(y)); }
        AC[i] = w;
    }
    f32x2* RT = (f32x2*)(ws + WS_ROPE);
    for (int i = gtid; i < 2056 * 8; i += NGT) {
        const int pi = i >> 3, fi = i & 7; const double pos = pi < 2048 ? (double)pi : (double)(8192 + pi - 2048);
        const double invf = dexp_(-(double)fi * 0.125 * 13.122363377404328);
        double sn, cs; dsincos_(pos * invf, sn, cs); RT[i] = (f32x2){(float)cs, (float)sn};
    }
}

__device__ __forceinline__ void norm_mod_phase(const float* xp, const float* xs, const float* normw, const float* mod, int l, int second, bf16* H) {
    int tid_o = threadIdx.x; asm volatile("" : "+v"(tid_o)); const int tid = tid_o, lane = tid & 63, wave = __builtin_amdgcn_readfirstlane(tid >> 6); (void)lane; (void)wave;
    const int NGW = gridDim.x * 8, gw = blockIdx.x * 8 + wave;
    for (int row = gw; row < NTOK; row += NGW) {
        const float* xr = row < NPTOK ? xp + (size_t)row * DM : xs + (size_t)(row - NPTOK) * DM;
        const float* shift = mod + (size_t)pg8::mod_row(row) * (2 * ADA_N) + l * ADA_N + (second ? 3 : 0) * DM; const float* scale = shift + DM;
        f32x4 v[8]; float ss = 0.f;
#pragma unroll
        for (int j = 0; j < 8; ++j) { v[j] = *(const f32x4*)(xr + 4 * (lane + 64 * j)); ss += (v[j][0] * v[j][0] + v[j][1] * v[j][1]) + (v[j][2] * v[j][2] + v[j][3] * v[j][3]); }
        ss = wave_sum(ss); const float rstd = rsqrtf(ss * (1.f / DM) + 1e-6f);
#pragma unroll
        for (int j = 0; j < 8; ++j) { const int c = 4 * (lane + 64 * j); const f32x4 nw = *(const f32x4*)(normw + c), sc = *(const f32x4*)(scale + c), sh = *(const f32x4*)(shift + c);
            const f32x4 y = (v[j] * rstd) * nw * (sc + 1.f) + sh; v2u w; w.x = pk2(y[0], y[1]); w.y = pk2(y[2], y[3]); *(v2u*)(H + (size_t)row * DM + c) = w; }
    }
}

__device__ __forceinline__ void qk_prep_phase(const Args& a, int l) {
    int tid_o = threadIdx.x; asm volatile("" : "+v"(tid_o)); const int tid = tid_o, lane = tid & 63, wave = __builtin_amdgcn_readfirstlane(tid >> 6); (void)lane; (void)wave;
    const int NGW = gridDim.x * 8, NGT = gridDim.x * 512, gw = blockIdx.x * 8 + wave, gtid = blockIdx.x * 512 + tid;
    unsigned char* ws = a.ws; asm volatile("" : "+s"(ws)); const bf16* P = (const bf16*)(ws + WS_P); bf16* QN = (bf16*)(ws + WS_QN); bf16* KN = (bf16*)(ws + WS_KN);
    const f32x2* RT = (const f32x2*)(ws + WS_ROPE); float* out = a.out;
    const float* qg = a.in[I_QN] + l * 64; const float* kg = a.in[I_KN] + l * 64;
    for (int wi = gw; wi < NTOK * 20 / 16; wi += NGW) {
        const int unit = wi * 16 + (lane >> 2), tok = unit / 20, hh = unit - tok * 20, j = lane & 3;
        const bf16* src = P + (size_t)tok * IN_DIM + hh * 64 + j * 16;
        const v4u r0 = *(const v4u*)src, r1 = *(const v4u*)(src + 8);
        float x[16];
        x[0] = lo16(r0.x); x[1] = hi16(r0.x); x[2] = lo16(r0.y); x[3] = hi16(r0.y); x[4] = lo16(r0.z); x[5] = hi16(r0.z); x[6] = lo16(r0.w); x[7] = hi16(r0.w);
        x[8] = lo16(r1.x); x[9] = hi16(r1.x); x[10] = lo16(r1.y); x[11] = hi16(r1.y); x[12] = lo16(r1.z); x[13] = hi16(r1.z); x[14] = lo16(r1.w); x[15] = hi16(r1.w);
        float ss = 0.f;
#pragma unroll
        for (int e = 0; e < 16; ++e) ss += x[e] * x[e];
        ss += __shfl_xor(ss, 1); ss += __shfl_xor(ss, 2);
        const float rstd = rsqrtf(ss * (1.f / 64.f) + 1e-6f);
        const float* gn = (hh < 16 ? qg : kg) + j * 16;
#pragma unroll
        for (int e = 0; e < 16; ++e) x[e] = x[e] * rstd * gn[e];
        if (j == 0) {
            const int pi = tok < NPTOK ? (tok & 2047) : 2048 + ((tok - NPTOK) & 7);
#pragma unroll
            for (int i = 0; i < 8; ++i) { const f32x2 cs = RT[pi * 8 + i]; const float p = x[i], q = x[8 + i]; x[i] = p * cs.x - q * cs.y; x[8 + i] = q * cs.x + p * cs.y; }
        }
        if (hh < 16) {
            v4u w0, w1;
            w0.x = pk2(x[0] * 0.125f, x[1] * 0.125f); w0.y = pk2(x[2] * 0.125f, x[3] * 0.125f); w0.z = pk2(x[4] * 0.125f, x[5] * 0.125f); w0.w = pk2(x[6] * 0.125f, x[7] * 0.125f);
            w1.x = pk2(x[8] * 0.125f, x[9] * 0.125f); w1.y = pk2(x[10] * 0.125f, x[11] * 0.125f); w1.z = pk2(x[12] * 0.125f, x[13] * 0.125f); w1.w = pk2(x[14] * 0.125f, x[15] * 0.125f);
            bf16* dst = QN + (size_t)tok * 1024 + hh * 64 + j * 16; *(v4u*)dst = w0; *(v4u*)(dst + 8) = w1;
        } else {
            const int kh = hh - 16;
            v4u w0, w1;
            w0.x = pk2(x[0], x[1]); w0.y = pk2(x[2], x[3]); w0.z = pk2(x[4], x[5]); w0.w = pk2(x[6], x[7]);
            w1.x = pk2(x[8], x[9]); w1.y = pk2(x[10], x[11]); w1.z = pk2(x[12], x[13]); w1.w = pk2(x[14], x[15]);
            bf16* dst = KN + (size_t)tok * 256 + kh * 64 + j * 16; *(v4u*)dst = w0; *(v4u*)(dst + 8) = w1;
            float* o = nullptr;
            if (tok < NPTOK) { const int t = tok & 2047, b = tok >> 11; if (t >= SEQ - 128) o = out + O_NKP + ((size_t)(l * NB + b) * 128 + (t - (SEQ - 128))) * 256 + kh * 64 + j * 16; }
            else { const int bs = (tok - NPTOK) >> 3, t = (tok - NPTOK) & 7; o = out + O_NKS + ((size_t)(l * DECB + bs) * 128 + 120 + t) * 256 + kh * 64 + j * 16; }
            if (o) {
#pragma unroll
                for (int e = 0; e < 4; ++e) *(f32x4*)(o + 4 * e) = (f32x4){x[4 * e], x[4 * e + 1], x[4 * e + 2], x[4 * e + 3]};
            }
        }
    }
    for (int i = gtid; i < (NB * 128 + DECB * DECT) * 64; i += NGT) {
        const int rowi = i >> 6, c4 = (i & 63) * 4; int tok; float* o;
        if (rowi < NB * 128) { const int b = rowi >> 7, t = rowi & 127; tok = b * SEQ + (SEQ - 128) + t; o = out + O_NVP + ((size_t)(l * NB + b) * 128 + t) * 256 + c4; }
        else { const int r2 = rowi - NB * 128, bs = r2 >> 3, t = r2 & 7; tok = NPTOK + r2; o = out + O_NVS + ((size_t)(l * DECB + bs) * 128 + 120 + t) * 256 + c4; }
        const v2u w = *(const v2u*)(P + (size_t)tok * IN_DIM + C_V + c4);
        *(f32x4*)o = (f32x4){lo16(w.x), hi16(w.x), lo16(w.y), hi16(w.y)};
    }
    for (int i = gtid; i < DECB * 120 * 64; i += NGT) {
        const int bs = i / (120 * 64), rem = i - bs * (120 * 64);
        const size_t so = ((size_t)(l * DECB + bs) * 128 + 8) * 256 + (size_t)rem * 4, dofs = ((size_t)(l * DECB + bs) * 128) * 256 + (size_t)rem * 4;
        *(f32x4*)(out + O_NKS + dofs) = *(const f32x4*)(a.in[I_CK] + so);
        *(f32x4*)(out + O_NVS + dofs) = *(const f32x4*)(a.in[I_CV] + so);
    }
}

template <int NKT>
__device__ __forceinline__ void attn_qgroup(const LAS bf16* Ks, int kst, const LAS bf16* Vt, int vst, const bf16* qrow, int qi, bool hasprev, float sink, bf16* orow, bool store_ok, int lane) {
    static_assert(NKT % 2 == 0, "key tiles come in pairs");
    const int lr = lane & 15, q4 = lane >> 4;
    const bf16x8 qf0 = *(const bf16x8*)(qrow + 8 * q4), qf1 = *(const bf16x8*)(qrow + 32 + 8 * q4);
    f32x4 s[NKT];
#pragma unroll
    for (int kt = 0; kt < NKT; ++kt) {
        const LAS bf16* kp = Ks + (16 * kt + lr) * kst + 8 * q4;
        const bf16x8 k0 = *(const LAS bf16x8*)kp, k1 = *(const LAS bf16x8*)(kp + 32);
        f32x4 z = (f32x4){0.f, 0.f, 0.f, 0.f};
        z = __builtin_amdgcn_mfma_f32_16x16x32_bf16(k0, qf0, z, 0, 0, 0);
        z = __builtin_amdgcn_mfma_f32_16x16x32_bf16(k1, qf1, z, 0, 0, 0);
        s[kt] = z;
        if ((kt & 3) == 3) __builtin_amdgcn_sched_barrier(0);
    }
    float m = sink;
#pragma unroll
    for (int kt = 0; kt < NKT; ++kt)
#pragma unroll
        for (int i = 0; i < 4; ++i) { const int kj = 16 * kt + 4 * q4 + i; const bool ok = (kj > qi) && (kj <= qi + 128) && (hasprev || kj >= 128);
            const float v = ok ? s[kt][i] : -INFINITY; s[kt][i] = v; m = fmaxf(m, v); }
    m = fmaxf(m, __shfl_xor(m, 16)); m = fmaxf(m, __shfl_xor(m, 32));
    float sum = 0.f;
#pragma unroll
    for (int kt = 0; kt < NKT; ++kt)
#pragma unroll
        for (int i = 0; i < 4; ++i) { const float p = __expf(s[kt][i] - m); s[kt][i] = p; sum += p; }
    sum += __shfl_xor(sum, 16); sum += __shfl_xor(sum, 32);
    const float inv = 1.f / (sum + __expf(sink - m));
    f32x4 o[4];
#pragma unroll
    for (int dt = 0; dt < 4; ++dt) o[dt] = (f32x4){0.f, 0.f, 0.f, 0.f};
#pragma unroll
    for (int kp = 0; kp < NKT / 2; ++kp) {
        v4u pw; pw.x = pk2(s[2 * kp][0], s[2 * kp][1]); pw.y = pk2(s[2 * kp][2], s[2 * kp][3]); pw.z = pk2(s[2 * kp + 1][0], s[2 * kp + 1][1]); pw.w = pk2(s[2 * kp + 1][2], s[2 * kp + 1][3]);
        const bf16x8 pb = __builtin_bit_cast(bf16x8, pw);
#pragma unroll
        for (int dt = 0; dt < 4; ++dt) {
            const LAS bf16* vp = Vt + (16 * dt + lr) * vst + 32 * kp + 4 * q4;
            const v2u lo = *(const LAS v2u*)vp, hi = *(const LAS v2u*)(vp + 16);
            v4u vw; vw.x = lo.x; vw.y = lo.y; vw.z = hi.x; vw.w = hi.y;
            o[dt] = __builtin_amdgcn_mfma_f32_16x16x32_bf16(__builtin_bit_cast(bf16x8, vw), pb, o[dt], 0, 0, 0);
        }
    }
    if (store_ok) {
#pragma unroll
        for (int dt = 0; dt < 4; ++dt) { v2u w; w.x = pk2(o[dt][0] * inv, o[dt][1] * inv); w.y = pk2(o[dt][2] * inv, o[dt][3] * inv); *(v2u*)(orow + 16 * dt + 4 * q4) = w; }
    }
}

constexpr int AP_KST = 72, AP_VST = 264;
constexpr int AS_KST = 72, AS_VST = 168, AS_NK = 160;

__device__ __forceinline__ void attn_prompt_item(const Args& a, int l, int item, LAS unsigned char* lds) {
    int tid_o = threadIdx.x; asm volatile("" : "+v"(tid_o)); const int tid = tid_o, lane = tid & 63, wave = __builtin_amdgcn_readfirstlane(tid >> 6); (void)lane; (void)wave;
    unsigned char* ws = a.ws; asm volatile("" : "+s"(ws)); const bf16* P = (const bf16*)(ws + WS_P); const bf16* QN = (const bf16*)(ws + WS_QN); const bf16* KN = (const bf16*)(ws + WS_KN); bf16* O = (bf16*)(ws + WS_O);
    const int kvh = item & 3, n = (item >> 2) & 15, b = item >> 6;
    LAS bf16* Ks = (LAS bf16*)lds; LAS bf16* Vt = (LAS bf16*)(lds + 256 * AP_KST * 2);
#pragma unroll
    for (int i = 0; i < 4; ++i) { const int c = tid + 512 * i, r = c >> 3, ch = c & 7, pos = 128 * (n - 1) + r;
        v4u val = (v4u){0u, 0u, 0u, 0u}; if (pos >= 0) val = *(const v4u*)(KN + (size_t)(b * SEQ + pos) * 256 + kvh * 64 + ch * 8);
        *(LAS v4u*)(Ks + r * AP_KST + ch * 8) = val; }
#pragma unroll
    for (int i = 0; i < 4; ++i) { const int c = tid + 512 * i, key = c & 255, ch = c >> 8, pos = 128 * (n - 1) + key;
        v4u val = (v4u){0u, 0u, 0u, 0u}; if (pos >= 0) val = *(const v4u*)(P + (size_t)(b * SEQ + pos) * IN_DIM + C_V + kvh * 64 + ch * 8);
        LAS bf16* d = Vt + (ch * 8) * AP_VST + key;
        d[0 * AP_VST] = (bf16)(val.x & 0xffffu); d[1 * AP_VST] = (bf16)(val.x >> 16); d[2 * AP_VST] = (bf16)(val.y & 0xffffu); d[3 * AP_VST] = (bf16)(val.y >> 16);
        d[4 * AP_VST] = (bf16)(val.z & 0xffffu); d[5 * AP_VST] = (bf16)(val.z >> 16); d[6 * AP_VST] = (bf16)(val.w & 0xffffu); d[7 * AP_VST] = (bf16)(val.w >> 16); }
    __syncthreads();
    const int g = wave >> 1, half = wave & 1, head = kvh * 4 + g; const float sink = a.in[I_SINK][l * 16 + head];
#pragma nounroll
    for (int qg = 0; qg < 4; ++qg) {
        const int qi = 64 * half + 16 * qg + (lane & 15); const size_t tok = (size_t)b * SEQ + 128 * n + qi;
        attn_qgroup<16>(Ks, AP_KST, Vt, AP_VST, QN + tok * 1024 + head * 64, qi, n > 0, sink, O + tok * 1024 + head * 64, true, lane);
    }
    __syncthreads();
}

__device__ __forceinline__ void attn_sample_item(const Args& a, int l, int item, LAS unsigned char* lds) {
    int tid_o = threadIdx.x; asm volatile("" : "+v"(tid_o)); const int tid = tid_o, lane = tid & 63, wave = __builtin_amdgcn_readfirstlane(tid >> 6); (void)lane; (void)wave;
    unsigned char* ws = a.ws; asm volatile("" : "+s"(ws)); const bf16* P = (const bf16*)(ws + WS_P); const bf16* QN = (const bf16*)(ws + WS_QN); const bf16* KN = (const bf16*)(ws + WS_KN); bf16* O = (bf16*)(ws + WS_O);
    const int pair = item & 1, b = item >> 1;
    LAS bf16* Ks = (LAS bf16*)lds; LAS bf16* Vt = (LAS bf16*)(lds + 2 * AS_NK * AS_KST * 2);
    const float* ck = a.in[I_CK] + (size_t)(l * DECB + b) * 128 * 256; const float* cv = a.in[I_CV] + (size_t)(l * DECB + b) * 128 * 256;
#pragma unroll
    for (int i = 0; i < 8; ++i) { const int c = tid + 512 * i, kk = c >> 11, rem = c & 2047, r = rem >> 4, ch4 = rem & 15;
        const f32x4 v = *(const f32x4*)(ck + (size_t)r * 256 + (2 * pair + kk) * 64 + ch4 * 4); v2u w; w.x = pk2(v[0], v[1]); w.y = pk2(v[2], v[3]);
        *(LAS v2u*)(Ks + (kk * AS_NK + r) * AS_KST + ch4 * 4) = w; }
    { const int kk = tid >> 8, rem = tid & 255, r = 128 + (rem >> 3), ch = rem & 7;
      v4u val = (v4u){0u, 0u, 0u, 0u}; if (r < 136) val = *(const v4u*)(KN + (size_t)(NPTOK + b * DECT + (r - 128)) * 256 + (2 * pair + kk) * 64 + ch * 8);
      *(LAS v4u*)(Ks + (kk * AS_NK + r) * AS_KST + ch * 8) = val; }
#pragma unroll
    for (int i = 0; i < 8; ++i) { const int c = tid + 512 * i, key = c & 127, kk = (c >> 7) & 1, ch4 = c >> 8;
        const f32x4 v = *(const f32x4*)(cv + (size_t)key * 256 + (2 * pair + kk) * 64 + ch4 * 4);
        LAS bf16* d = Vt + (kk * 64 + ch4 * 4) * AS_VST + key;
        d[0] = (bf16)f2bf(v[0]); d[AS_VST] = (bf16)f2bf(v[1]); d[2 * AS_VST] = (bf16)f2bf(v[2]); d[3 * AS_VST] = (bf16)f2bf(v[3]); }
#pragma unroll
    for (int i = 0; i < 8; ++i) { const int c = tid + 512 * i, col = 128 + (c & 31), d = (c >> 5) & 63, kk = c >> 11; bf16 val = 0;
        if (col < 136) val = P[(size_t)(NPTOK + b * DECT + (col - 128)) * IN_DIM + C_V + (2 * pair + kk) * 64 + d];
        Vt[(kk * 64 + d) * AS_VST + col] = val; }
    __syncthreads();
    const int kk = wave >> 2, g = wave & 3, kvh = 2 * pair + kk, head = kvh * 4 + g; const float sink = a.in[I_SINK][l * 16 + head];
    const int qi = lane & 15, qld = qi < 8 ? qi : 7; const size_t tok = (size_t)NPTOK + b * DECT + qld;
    attn_qgroup<10>(Ks + kk * AS_NK * AS_KST, AS_KST, Vt + kk * 64 * AS_VST, AS_VST, QN + tok * 1024 + head * 64, qi, true, sink, O + tok * 1024 + head * 64, qi < 8, lane);
    __syncthreads();
}

template <int TT>
__device__ __forceinline__ void conv_compute(const Args& a, int l, LAS float* U, LAS float* red, LAS float* stat, size_t tok0, int tid, int wave, int lane) {
    const int c = tid;
    float w[31];
#pragma unroll
    for (int j = 0; j < 31; ++j) w[j] = a.in[I_CW][(size_t)(l * 31 + j) * 512 + c];
    const float bias = a.in[I_CB][l * 512 + c];
    float y[TT];
#pragma unroll
    for (int tb = 0; tb < TT / 8; ++tb) {
        float win[38];
#pragma unroll
        for (int r = 0; r < 38; ++r) win[r] = U[(tb * 8 + r) * 512 + c];
#pragma unroll
        for (int t = 0; t < 8; ++t) { float acc = bias;
#pragma unroll
            for (int j = 0; j < 31; ++j) acc = fmaf(w[j], win[t + j], acc);
            y[tb * 8 + t] = acc; }
    }
#pragma unroll
    for (int t = 0; t < TT; ++t) { const float s1 = wave_sum(y[t]), s2 = wave_sum(y[t] * y[t]); if (lane == 0) { red[(wave * 32 + t) * 2] = s1; red[(wave * 32 + t) * 2 + 1] = s2; } }
    __syncthreads();
    if (tid < TT * 2) { const int t = tid >> 1, k = tid & 1; float s = 0.f;
#pragma unroll
        for (int ww = 0; ww < 8; ++ww) s += red[(ww * 32 + t) * 2 + k];
        stat[t * 2 + k] = s; }
    __syncthreads();
    const float lg = a.in[I_CLG][l * 512 + c], lb = a.in[I_CLB][l * 512 + c];
    bf16* YC = (bf16*)(a.ws + WS_YC);
#pragma unroll
    for (int t = 0; t < TT; ++t) { const float mean = stat[t * 2] * (1.f / 512.f), var = stat[t * 2 + 1] * (1.f / 512.f) - mean * mean, rstd = rsqrtf(fmaxf(var, 0.f) + 1e-6f);
        const float v = (y[t] - mean) * rstd * lg + lb; YC[(tok0 + t) * 512 + c] = (bf16)f2bf(v * sigm(v)); }
}
__device__ __forceinline__ void glu8(const bf16* P, size_t tok, int ch, float (&u)[8]) {
    const v4u av = *(const v4u*)(P + tok * IN_DIM + C_XA + ch * 8), bv = *(const v4u*)(P + tok * IN_DIM + C_XB + ch * 8);
    u[0] = lo16(av.x) * sigm(lo16(bv.x)); u[1] = hi16(av.x) * sigm(hi16(bv.x)); u[2] = lo16(av.y) * sigm(lo16(bv.y)); u[3] = hi16(av.y) * sigm(hi16(bv.y));
    u[4] = lo16(av.z) * sigm(lo16(bv.z)); u[5] = hi16(av.z) * sigm(hi16(bv.z)); u[6] = lo16(av.w) * sigm(lo16(bv.w)); u[7] = hi16(av.w) * sigm(hi16(bv.w));
}
__device__ __forceinline__ void conv_prompt_item(const Args& a, int l, int item, LAS unsigned char* lds) {
    int tid_o = threadIdx.x; asm volatile("" : "+v"(tid_o)); const int tid = tid_o, lane = tid & 63, wave = __builtin_amdgcn_readfirstlane(tid >> 6); (void)lane; (void)wave;
    const bf16* P = (const bf16*)(a.ws + WS_P);
    LAS float* U = (LAS float*)lds; LAS float* red = U + 62 * 512; LAS float* stat = red + 512;
    const int b = item >> 6, tile = item & 63, t0 = tile * 32;
    for (int c = tid; c < 62 * 64; c += 512) { const int r = c >> 6, ch = c & 63, t = t0 - 30 + r; float u[8];
        if (t >= 0) glu8(P, (size_t)b * SEQ + t, ch, u); else {
#pragma unroll
            for (int e = 0; e < 8; ++e) u[e] = 0.f; }
        *(LAS f32x4*)(U + r * 512 + ch * 8) = (f32x4){u[0], u[1], u[2], u[3]}; *(LAS f32x4*)(U + r * 512 + ch * 8 + 4) = (f32x4){u[4], u[5], u[6], u[7]};
        if (tile == 63 && t >= SEQ - 30) { float* o = a.out + O_NCP + ((size_t)(l * NB + b) * 30 + (t - (SEQ - 30))) * 512 + ch * 8;
            *(f32x4*)o = (f32x4){u[0], u[1], u[2], u[3]}; *(f32x4*)(o + 4) = (f32x4){u[4], u[5], u[6], u[7]}; } }
    __syncthreads();
    conv_compute<32>(a, l, U, red, stat, (size_t)b * SEQ + t0, tid, wave, lane);
    __syncthreads();
}
__device__ __forceinline__ void conv_sample_item(const Args& a, int l, int item, LAS unsigned char* lds) {
    int tid_o = threadIdx.x; asm volatile("" : "+v"(tid_o)); const int tid = tid_o, lane = tid & 63, wave = __builtin_amdgcn_readfirstlane(tid >> 6); (void)lane; (void)wave;
    const bf16* P = (const bf16*)(a.ws + WS_P);
    LAS float* U = (LAS float*)lds; LAS float* red = U + 62 * 512; LAS float* stat = red + 512;
    const int b = item; const float* sc = a.in[I_SCONV] + (size_t)(l * DECB + b) * 30 * 512;
    for (int c = tid; c < 38 * 64; c += 512) { const int r = c >> 6, ch = c & 63; float u[8];
        if (r < 30) { const f32x4 x0 = *(const f32x4*)(sc + r * 512 + ch * 8), x1 = *(const f32x4*)(sc + r * 512 + ch * 8 + 4);
            u[0] = x0[0]; u[1] = x0[1]; u[2] = x0[2]; u[3] = x0[3]; u[4] = x1[0]; u[5] = x1[1]; u[6] = x1[2]; u[7] = x1[3]; }
        else glu8(P, (size_t)NPTOK + b * DECT + (r - 30), ch, u);
        *(LAS f32x4*)(U + r * 512 + ch * 8) = (f32x4){u[0], u[1], u[2], u[3]}; *(LAS f32x4*)(U + r * 512 + ch * 8 + 4) = (f32x4){u[4], u[5], u[6], u[7]};
        if (r >= 8) { float* o = a.out + O_NCS + ((size_t)(l * DECB + b) * 30 + (r - 8)) * 512 + ch * 8;
            *(f32x4*)o = (f32x4){u[0], u[1], u[2], u[3]}; *(f32x4*)(o + 4) = (f32x4){u[4], u[5], u[6], u[7]}; } }
    __syncthreads();
    conv_compute<8>(a, l, U, red, stat, (size_t)NPTOK + b * DECT, tid, wave, lane);
    __syncthreads();
}

struct SsmLane { float ar, ai; float bzr[16], bzi[16]; bf16x8 cf[4]; f32x4 dv; float a256r, a256i; };
__device__ __forceinline__ void ssm_setup(const Args& a, int l, int g, int lane, SsmLane& S) {
    const int p = lane, lg = l * 32 + g;
    const double are = (double)a.in[I_ARE][lg * 64 + p], aim = (double)a.in[I_AIM][lg * 64 + p], dt = dexp_((double)a.in[I_LDT][lg]);
    const double mag = dexp_(are * dt); double sn, cs; dsincos_(aim * dt, sn, cs);
    const double abr = mag * cs, abi = mag * sn, den = are * are + aim * aim;
    const double zr = ((abr - 1.0) * are + abi * aim) / den, zi = (abi * are - (abr - 1.0) * aim) / den;
    S.ar = (float)abr; S.ai = (float)abi;
    double pr = abr, pi = abi;
#pragma unroll
    for (int i = 0; i < 8; ++i) { const double nr = pr * pr - pi * pi, ni = 2.0 * pr * pi; pr = nr; pi = ni; }
    S.a256r = (float)pr; S.a256i = (float)pi;
    const float* br = a.in[I_BRE] + (size_t)(lg * 64 + p) * 16; const float* bi = a.in[I_BIM] + (size_t)(lg * 64 + p) * 16;
    const float zrf = (float)zr, zif = (float)zi;
#pragma unroll
    for (int c = 0; c < 16; ++c) { const float x = br[c], y = bi[c]; S.bzr[c] = zrf * x - zif * y; S.bzi[c] = zrf * y + zif * x; }
    const int lr = lane & 15, q4 = lane >> 4;
#pragma unroll
    for (int ks = 0; ks < 4; ++ks) { const int k0 = (ks & 1) * 32 + 8 * q4; const float* src = (ks < 2 ? a.in[I_CRE] : a.in[I_CIM]) + (size_t)(lg * 16 + lr) * 64 + k0; const float sg = ks < 2 ? 1.f : -1.f;
        const f32x4 x0 = *(const f32x4*)src, x1 = *(const f32x4*)(src + 4);
        v4u w; w.x = pk2(sg * x0[0], sg * x0[1]); w.y = pk2(sg * x0[2], sg * x0[3]); w.z = pk2(sg * x1[0], sg * x1[1]); w.w = pk2(sg * x1[2], sg * x1[3]);
        S.cf[ks] = __builtin_bit_cast(bf16x8, w); }
    S.dv = *(const f32x4*)(a.in[I_SD] + l * 512 + g * 16 + 4 * q4);
}
__device__ __forceinline__ float gelu_tanh(float x) { const float z = 0.7978845608028654f * (x + 0.044715f * x * x * x); const float t = 1.f - 2.f / (__expf(2.f * z) + 1.f); return 0.5f * x * (1.f + t); }

template <bool PASS2>
__device__ __forceinline__ void ssm_run(const Args& a, const SsmLane& S, int g, size_t tok0, int nsub, int nvalid, float& hr, float& hi, LAS float* ubuf, LAS bf16* hbuf, int lane) {
    const bf16* P = (const bf16*)(a.ws + WS_P); bf16* YS = (bf16*)(a.ws + WS_YS);
    const int lr = lane & 15, q4 = lane >> 4, st_l = lane >> 2, c4 = (lane & 3) * 4;
#pragma nounroll
    for (int sub = 0; sub < nsub; ++sub) {
        { f32x4 uv = (f32x4){0.f, 0.f, 0.f, 0.f};
          if (st_l < nvalid) { const v2u w = *(const v2u*)(P + (tok0 + sub * 16 + st_l) * IN_DIM + C_XS + g * 16 + c4); uv = (f32x4){lo16(w.x), hi16(w.x), lo16(w.y), hi16(w.y)}; }
          *(LAS f32x4*)(ubuf + st_l * 16 + c4) = uv; }
        WAVE_SYNC();
#pragma unroll
        for (int st = 0; st < 16; ++st) {
            if (st < nvalid) {
                const f32x4 u0 = *(const LAS f32x4*)(ubuf + st * 16), u1 = *(const LAS f32x4*)(ubuf + st * 16 + 4), u2 = *(const LAS f32x4*)(ubuf + st * 16 + 8), u3 = *(const LAS f32x4*)(ubuf + st * 16 + 12);
                float xr = 0.f, xi = 0.f;
#pragma unroll
                for (int c = 0; c < 4; ++c) { xr = fmaf(S.bzr[c], u0[c], xr); xi = fmaf(S.bzi[c], u0[c], xi); }
#pragma unroll
                for (int c = 0; c < 4; ++c) { xr = fmaf(S.bzr[4 + c], u1[c], xr); xi = fmaf(S.bzi[4 + c], u1[c], xi); }
#pragma unroll
                for (int c = 0; c < 4; ++c) { xr = fmaf(S.bzr[8 + c], u2[c], xr); xi = fmaf(S.bzi[8 + c], u2[c], xi); }
#pragma unroll
                for (int c = 0; c < 4; ++c) { xr = fmaf(S.bzr[12 + c], u3[c], xr); xi = fmaf(S.bzi[12 + c], u3[c], xi); }
                const float nr = fmaf(S.ar, hr, fmaf(-S.ai, hi, xr)), ni = fmaf(S.ar, hi, fmaf(S.ai, hr, xi));
                hr = nr; hi = ni;
            }
            if (PASS2) { hbuf[st * 136 + lane] = (bf16)f2bf(hr); hbuf[st * 136 + 64 + lane] = (bf16)f2bf(hi); }
            if ((st & 3) == 3) __builtin_amdgcn_sched_barrier(0);
        }
        if (PASS2) {
            WAVE_SYNC();
            f32x4 acc = (f32x4){0.f, 0.f, 0.f, 0.f};
#pragma unroll
            for (int ks = 0; ks < 4; ++ks) { const bf16x8 hb = *(const LAS bf16x8*)(hbuf + lr * 136 + 32 * ks + 8 * q4); acc = __builtin_amdgcn_mfma_f32_16x16x32_bf16(S.cf[ks], hb, acc, 0, 0, 0); }
            const f32x4 uv = *(const LAS f32x4*)(ubuf + lr * 16 + 4 * q4);
            if (lr < nvalid) { f32x4 yv = acc + S.dv * uv; v2u w; w.x = pk2(gelu_tanh(yv[0]), gelu_tanh(yv[1])); w.y = pk2(gelu_tanh(yv[2]), gelu_tanh(yv[3]));
                *(v2u*)(YS + (tok0 + sub * 16 + lr) * 512 + g * 16 + 4 * q4) = w; }
        }
        WAVE_SYNC();
    }
}
__device__ __forceinline__ void ssm_prompt_item(const Args& a, int l, int item, LAS unsigned char* lds) {
    int tid_o = threadIdx.x; asm volatile("" : "+v"(tid_o)); const int tid = tid_o, lane = tid & 63, wave = __builtin_amdgcn_readfirstlane(tid >> 6); (void)lane; (void)wave;
    const int g = item & 31, b = item >> 5;
    LAS float* ubuf = (LAS float*)(lds + wave * 5632); LAS bf16* hbuf = (LAS bf16*)(lds + wave * 5632 + 1024); LAS float* ex = (LAS float*)(lds + 8 * 5632);
    SsmLane S; ssm_setup(a, l, g, lane, S);
    const size_t tok0 = (size_t)b * SEQ + 256 * wave;
    float hr = 0.f, hi = 0.f;
    ssm_run<false>(a, S, g, tok0, 16, 16, hr, hi, ubuf, hbuf, lane);
    ex[(wave * 64 + lane) * 2] = hr; ex[(wave * 64 + lane) * 2 + 1] = hi;
    __syncthreads();
    hr = 0.f; hi = 0.f;
    for (int j = 0; j < wave; ++j) { const float er = ex[(j * 64 + lane) * 2], ei = ex[(j * 64 + lane) * 2 + 1]; const float nr = S.a256r * hr - S.a256i * hi + er, ni = S.a256r * hi + S.a256i * hr + ei; hr = nr; hi = ni; }
    ssm_run<true>(a, S, g, tok0, 16, 16, hr, hi, ubuf, hbuf, lane);
    if (wave == 7) { a.out[O_NRP + (size_t)((l * NB + b) * 32 + g) * 64 + lane] = hr; a.out[O_NIP + (size_t)((l * NB + b) * 32 + g) * 64 + lane] = hi; }
    __syncthreads();
}
__device__ __forceinline__ void ssm_sample_item(const Args& a, int l, int item, LAS unsigned char* lds) {
    int tid_o = threadIdx.x; asm volatile("" : "+v"(tid_o)); const int tid = tid_o, lane = tid & 63, wave = __builtin_amdgcn_readfirstlane(tid >> 6); (void)lane; (void)wave;
    const int g = item & 31, bg = item >> 5;
    LAS float* ubuf = (LAS float*)(lds + wave * 5632); LAS bf16* hbuf = (LAS bf16*)(lds + wave * 5632 + 1024);
    SsmLane S; ssm_setup(a, l, g, lane, S);
    for (int bb = 0; bb < 2; ++bb) {
        const int bs = bg * 16 + wave * 2 + bb; const size_t so = (size_t)((l * DECB + bs) * 32 + g) * 64 + lane;
        float hr = a.in[I_SRE][so], hi = a.in[I_SIM][so];
        ssm_run<true>(a, S, g, (size_t)NPTOK + bs * DECT, 1, 8, hr, hi, ubuf, hbuf, lane);
        a.out[O_NRS + so] = hr; a.out[O_NIS + so] = hi;
    }
    __syncthreads();
}

__device__ __forceinline__ void mixer_phase(const Args& a, int l, LAS unsigned char* lds) {
    for (int it = blockIdx.x; it < 1280; it += gridDim.x) {
        if (0) {}
#ifndef NO_SSMP
        else if (it < 128) ssm_prompt_item(a, l, it, lds);
#endif
#ifndef NO_ATTP
        else if (it < 384) attn_prompt_item(a, l, it - 128, lds);
#endif
#ifndef NO_CONVP
        else if (it < 640) conv_prompt_item(a, l, it - 384, lds);
#endif
#ifndef NO_ATTS
        else if (it < 896) attn_sample_item(a, l, it - 640, lds);
#endif
#ifndef NO_SSMS
        else if (it < 1152) ssm_sample_item(a, l, it - 896, lds);
#endif
#ifndef NO_CONVS
        else if (it < 1280) conv_sample_item(a, l, it - 1152, lds);
#endif
    }
}

#define IN(k) (lo <= (k) && (k) < hi)
#define SEAM(k) do { if (IN(k) && IN((k) + 1)) grid.sync(); } while (0)
#define GEMM(EPI, E, Aptr, Bptr, M_, N_, K_) do { pg8::Gemm g_{(const pg8::bf16_t*)(Aptr), (const pg8::bf16_t*)(Bptr), M_, N_, K_}; pg8::StaticOrder S_; S_.init(M_, N_, G, (int)blockIdx.x); \
        pg8::gemm_phase<EPI, pg8::StaticOrder, true, true>(lds, g_, S_, E); } while (0)
template <int l>
__device__ __forceinline__ void layer_phases(const Args& a, LAS unsigned char* lds, cg::grid_group& grid, int lo, int hi) {
    const int G = gridDim.x; float* Y = a.out + O_Y;
        const int pb = 2 + 9 * l;
        int tid_l = threadIdx.x; asm volatile("" : "+v"(tid_l));
        unsigned char* ws = a.ws; asm volatile("" : "+s"(ws));
        const int tid = tid_l, lane = tid & 63, wave = __builtin_amdgcn_readfirstlane(tid >> 6), gw = blockIdx.x * 8 + wave, gtid = blockIdx.x * 512 + tid;
        float* mod = (float*)(ws + WS_MOD); bf16* Hb = (bf16*)(ws + WS_H); bf16* Pb = (bf16*)(ws + WS_P); float* MG = (float*)(ws + WS_MG); float* Xb = (float*)(ws + WS_X);
        const unsigned char* wl = ws + WS_WL + (size_t)l * WL_STRIDE;
        const float* xp = l == 0 ? a.in[I_XP] : Xb; const float* xs = l == 0 ? a.in[I_XS] : Xb + (size_t)NPTOK * DM;
        float* xout = l == 0 ? Xb : Y;
#ifndef NO_NORM
        if (IN(pb + 0)) norm_mod_phase(xp, xs, a.in[I_NORM1] + l * DM, mod, l, 0, Hb);
#endif
        SEAM(pb + 0);
#ifndef NO_G1
        if (IN(pb + 1)) { pg8::EpiP E{Pb}; GEMM(pg8::EpiP, E, Hb, wl + WL_IN, NTOK, IN_DIM, DM); }
#endif
        SEAM(pb + 1);
#ifndef NO_PREP
        if (IN(pb + 2)) qk_prep_phase(a, l);
#endif
        SEAM(pb + 2);
#ifndef NO_MIX
        if (IN(pb + 3)) mixer_phase(a, l, lds);
#endif
        SEAM(pb + 3);
#ifndef NO_MERGE
        if (IN(pb + 4)) {
            { pg8::EpiStoreF32 E{MG}; GEMM(pg8::EpiStoreF32, E, ws + WS_YS, wl + WL_GA, NTOK, DM, 512); }
            { pg8::EpiGluB E{MG, Pb}; GEMM(pg8::EpiGluB, E, ws + WS_YS, wl + WL_GB, NTOK, DM, 512); }
            { pg8::EpiAccG E{MG, Pb, 0}; GEMM(pg8::EpiAccG, E, ws + WS_O, wl + WL_O, NTOK, DM, 1024); }
            { pg8::EpiMergeFinal E{MG, Pb, Hb, 1}; GEMM(pg8::EpiMergeFinal, E, ws + WS_YC, wl + WL_CO, NTOK, DM, 512); }
        }
#endif
        SEAM(pb + 4);
#ifndef NO_REST
        if (IN(pb + 5)) { pg8::EpiResid E{xp, xs, mod + l * ADA_N + 2 * DM, Y}; GEMM(pg8::EpiResid, E, Hb, wl + WL_OUT, NTOK, DM, DM); }
        SEAM(pb + 5);
        if (IN(pb + 6)) norm_mod_phase(Y, Y + (size_t)NPTOK * DM, a.in[I_NORM2] + l * DM, mod, l, 1, Hb);
        SEAM(pb + 6);
        if (IN(pb + 7)) { pg8::EpiRelu2 E{Pb}; GEMM(pg8::EpiRelu2, E, Hb, wl + WL_F1, NTOK, FF, DM); }
        SEAM(pb + 7);
        if (IN(pb + 8)) { pg8::EpiResid E{Y, Y + (size_t)NPTOK * DM, mod + l * ADA_N + 5 * DM, xout}; GEMM(pg8::EpiResid, E, Pb, wl + WL_F2, NTOK, DM, FF); }
#endif
        SEAM(pb + 8);
}

__global__ void __launch_bounds__(512, 2) hybrid_fwd(Args a) {
    extern __shared__ __attribute__((aligned(16))) unsigned char lds_raw[];
    LAS unsigned char* lds = (LAS unsigned char*)lds_raw;
    cg::grid_group grid = cg::this_grid();
    const int tid = threadIdx.x, lane = tid & 63, wave = __builtin_amdgcn_readfirstlane(tid >> 6);
    const int G = gridDim.x, gw = blockIdx.x * 8 + wave, NGW = G * 8, gtid = blockIdx.x * 512 + tid, NGT = G * 512;
    unsigned char* ws = a.ws;
    const int lo = a.ph_lo, hi = a.ph_hi;
    float* mod = (float*)(ws + WS_MOD);
    bf16* Hb = (bf16*)(ws + WS_H); bf16* Pb = (bf16*)(ws + WS_P); float* MG = (float*)(ws + WS_MG); float* Xb = (float*)(ws + WS_X);
    float* Y = a.out + O_Y;
#ifndef NO_P0
    if (IN(0)) { p0_prologue(a, lds, gw, NGW, lane, wave, gtid, NGT); __syncthreads(); }
#endif
    SEAM(0);
#ifndef NO_ADA
    if (IN(1)) { pg8::EpiAda E{mod, a.in[I_BADA]}; GEMM(pg8::EpiAda, E, ws + WS_AC, ws + WS_WADA, 256, 2 * ADA_N, DM); }
#endif
    SEAM(1);
    layer_phases<0>(a, lds, grid, lo, hi);
    layer_phases<1>(a, lds, grid, lo, hi);
#undef IN
#undef SEAM
#undef GEMM
}

extern "C" void kernel_launch(void* const* d_in, const int* in_sizes, int n_in, void* d_out, int out_size, void* d_ws, size_t ws_size, hipStream_t stream) {
    static int grid = 0;
    if (grid == 0) {
        if (n_in != 36 || (size_t)out_size != O_END || ws_size < WS_END) { fprintf(stderr, "kernel_launch: unexpected sizes n_in %d out %d ws %zu (need %zu)\n", n_in, out_size, ws_size, (size_t)WS_END); grid = -1; return; }
        int dev = 0, cus = 0, per_cu = 0;
        (void)hipGetDevice(&dev); (void)hipDeviceGetAttribute(&cus, hipDeviceAttributeMultiprocessorCount, dev);
        if (hipFuncSetAttribute((const void*)hybrid_fwd, hipFuncAttributeMaxDynamicSharedMemorySize, LDS_BYTES) != hipSuccess) { fprintf(stderr, "kernel_launch: hipFuncSetAttribute failed\n"); grid = -1; return; }
        if (hipOccupancyMaxActiveBlocksPerMultiprocessor(&per_cu, (const void*)hybrid_fwd, 512, LDS_BYTES) != hipSuccess || per_cu < 1) { fprintf(stderr, "kernel_launch: occupancy query failed (%d)\n", per_cu); per_cu = 1; }
        (void)hipGetLastError();
        if (per_cu > 1) per_cu = 1;
        grid = cus * per_cu;
        fprintf(stderr, "kernel_launch: grid %d (cus %d)\n", grid, cus);
    }
    if (grid < 0) return;
    Args a{};
    for (int i = 0; i < 36; ++i) a.in[i] = (const float*)d_in[i];
    a.out = (float*)d_out; a.ws = (unsigned char*)d_ws;
#if MK_ONE_LAUNCH
    a.ph_lo = 0; a.ph_hi = NPHASE;
    void* args[] = {&a};
    hipError_t e = hipLaunchCooperativeKernel((const void*)hybrid_fwd, dim3(grid), dim3(512), args, LDS_BYTES, stream);
    if (e != hipSuccess) fprintf(stderr, "kernel_launch: cooperative launch failed: %s (grid %d)\n", hipGetErrorString(e), grid);
#else
    for (int k = 0; k < NPHASE; ++k) { a.ph_lo = k; a.ph_hi = k + 1; hipLaunchKernelGGL(hybrid_fwd, dim3(grid), dim3(512), LDS_BYTES, stream, a); }
#endif
}
```

```cpp
#include <hip/hip_runtime.h>
#include <hip/hip_cooperative_groups.h>
#include <cstdio>
#include <cstdint>
namespace cg = cooperative_groups;
namespace pg8 {
#define PG8_LAS __attribute__((address_space(3)))
typedef unsigned short bf16_t;
typedef short bf16x8 __attribute__((ext_vector_type(8)));
typedef float f32x4 __attribute__((ext_vector_type(4)));
typedef unsigned u32x4 __attribute__((ext_vector_type(4)));
constexpr int BM = 256, BK = 64, HALF = 128, HTB = HALF * BK * 2  , STAGE_BYTES = 8 * HTB, NXCD = 8, WGM = 8;

__host__ __device__ __forceinline__ int lds_byte(int r, int c) { const int st = (r >> 4) * 2 + (c >> 5), rr = r & 15, cc = c & 31, ob = rr * 64 + cc * 2; return st * 1024 + (ob ^ (((ob >> 9) & 1) << 5)); }
__host__ __device__ __forceinline__ void stage_rc(int b, int& R, int& C) { const int st = b / 1024, sb = b % 1024, swz = sb ^ (((sb >> 9) & 1) << 5); R = (st >> 1) * 16 + swz / 64; C = (st & 1) * 32 + (swz % 64) / 2; }
__host__ __device__ __forceinline__ int perm32(int rho) { const int n = rho >> 4, i = rho & 15; return 8 * (i >> 2) + 4 * n + (i & 3); }

struct Unit { int pm, pn; };
struct Gemm { const bf16_t* A; const bf16_t* Bt; int M, N, K; };

struct StaticOrder {
    int nM, nN, nwg, G, c;
    __host__ __device__ void init(int M, int N, int G_, int c_) { nM = M / BM; nN = N / BM; nwg = nM * nN; G = G_; c = c_; }
    __host__ __device__ bool next(int i, Unit& u) const {
        const long L = (long)i * G + c; if (L >= nwg) return false;
        int wgid = (int)L; { const int q = nwg / NXCD, r = nwg % NXCD, xcd = wgid % NXCD, off = wgid / NXCD; wgid = (xcd < r ? xcd * (q + 1) : r * (q + 1) + (xcd - r) * q) + off; }
        const int nig = WGM * nN, gid = wgid / nig, fm = gid * WGM, gsz = (nM - fm) < WGM ? (nM - fm) : WGM;
        u.pm = fm + ((wgid % nig) % gsz); u.pn = (wgid % nig) / gsz; return true;
    }
    __device__ __forceinline__ void a_ready(const Unit&) const {}
    __device__ __forceinline__ void done(const Unit&) const {}
};

__device__ __forceinline__ unsigned cvt_pk_bf16(float lo, float hi) { unsigned r; asm volatile("v_cvt_pk_bf16_f32 %0, %1, %2" : "=v"(r) : "v"(lo), "v"(hi)); return r; }
typedef float f32x2 __attribute__((ext_vector_type(2)));
template <class Epi, class Sched, bool ALIGN_EPI = false, bool SP2 = false>
__device__ __forceinline__ void gemm_phase(PG8_LAS unsigned char* lds, const Gemm g, const Sched& S, const Epi& E) {
    int tid_ = threadIdx.x; asm volatile("" : "+v"(tid_));
    const int tid = tid_, wid = __builtin_amdgcn_readfirstlane(tid >> 6), lane = tid & 63, wr = wid >> 2, wc = wid & 3, fr = lane & 15, fq = lane >> 4;
    const int K = g.K, nt = K / BK;
    unsigned voffA[2], voffB[2];
#pragma unroll
    for (int i = 0; i < 2; ++i) { int R, C; stage_rc(tid * 16 + i * 8192, R, C); const int Rb = Epi::PERM ? ((R & ~31) + perm32(R & 31)) : R;
        voffA[i] = (unsigned)(R * K + C) * 2u; voffB[i] = (unsigned)(Rb * K + C) * 2u; }
    const size_t kstep = (size_t)(BK * 2);
    const size_t hstep = (size_t)HALF * K * 2;
    const size_t tstep = 2 * hstep;
    const unsigned ldsw = (unsigned)wid * 1024u;
    const int aoff = lds_byte(wr * 64 + fr, fq * 8), boff = lds_byte(wc * 32 + fr, fq * 8);
#define PG8_SA(b, h) (((b) * 2 + (h)) * HTB)
#define PG8_SB(b, h) ((4 + (b) * 2 + (h)) * HTB)
#define PG8_STAGE(bufoff, gbase, voff) do { _Pragma("unroll") for (int _i = 0; _i < 2; ++_i) \
        __builtin_amdgcn_global_load_lds((const unsigned*)((const char*)(gbase) + (voff)[_i]), (PG8_LAS unsigned*)(lds + (bufoff) + ldsw + _i * 8192), 16, 0, 0); } while (0)
#define PG8_LDA(dst, b, h) do { _Pragma("unroll") for (int m = 0; m < 4; ++m) _Pragma("unroll") for (int k = 0; k < 2; ++k) dst[m][k] = *(const PG8_LAS bf16x8*)(lds + PG8_SA(b, h) + aoff + m * 2048 + k * 1024); } while (0)
#define PG8_LDB(dst, b, h) do { _Pragma("unroll") for (int n = 0; n < 2; ++n) _Pragma("unroll") for (int k = 0; k < 2; ++k) dst[n][k] = *(const PG8_LAS bf16x8*)(lds + PG8_SB(b, h) + boff + n * 2048 + k * 1024); } while (0)
#define PG8_MMA(ai, bj, At, Bt) do { __builtin_amdgcn_s_setprio(1); _Pragma("unroll") for (int m = 0; m < 4; ++m) _Pragma("unroll") for (int n = 0; n < 2; ++n) _Pragma("unroll") for (int k = 0; k < 2; ++k) \
        acc[ai][bj][m][n] = __builtin_amdgcn_mfma_f32_16x16x32_bf16(Bt[n][k], At[m][k], acc[ai][bj][m][n], 0, 0, 0); __builtin_amdgcn_s_setprio(0); } while (0)
#define PG8_WAIT_V(n) asm volatile("s_waitcnt vmcnt(" #n ")" ::: "memory")
#define PG8_WAIT_L(n) asm volatile("s_waitcnt lgkmcnt(" #n ")" ::: "memory")
#define PG8_BAR __builtin_amdgcn_s_barrier()
#define PG8_SCHED __builtin_amdgcn_sched_barrier(0)
    Unit cur, nxt; int ui = 0;
    if (!S.next(0, cur)) return;
    f32x4 acc[2][2][4][2];
#pragma unroll
    for (int a = 0; a < 2; ++a)
#pragma unroll
        for (int b = 0; b < 2; ++b)
#pragma unroll
            for (int m = 0; m < 4; ++m)
#pragma unroll
                for (int n = 0; n < 2; ++n) acc[a][b][m][n] = (f32x4){0.f, 0.f, 0.f, 0.f};
    bf16x8 At[4][2], B0[2][2], B1[2][2];
    const char* cA = (const char*)g.A + (size_t)cur.pm * tstep; const char* cB = (const char*)g.Bt + (size_t)cur.pn * tstep;
    S.a_ready(cur);
    if constexpr (SP2) {
        PG8_STAGE(PG8_SB(0, 0), cB, voffB); PG8_STAGE(PG8_SB(0, 1), cB + hstep, voffB); PG8_STAGE(PG8_SA(0, 0), cA, voffA); PG8_STAGE(PG8_SA(0, 1), cA + hstep, voffA);
        if (wr == 1) PG8_BAR;
        PG8_WAIT_V(2); PG8_BAR;
        PG8_STAGE(PG8_SB(1, 0), cB + kstep, voffB); PG8_STAGE(PG8_SA(1, 0), cA + kstep, voffA); PG8_STAGE(PG8_SB(1, 1), cB + hstep + kstep, voffB);
        PG8_WAIT_V(6); PG8_BAR;
    } else {
        PG8_STAGE(PG8_SB(0, 0), cB, voffB); PG8_STAGE(PG8_SA(0, 0), cA, voffA); PG8_STAGE(PG8_SB(0, 1), cB + hstep, voffB); PG8_STAGE(PG8_SA(0, 1), cA + hstep, voffA);
        if (wr == 1) PG8_BAR;
        PG8_WAIT_V(4); PG8_BAR;
        PG8_STAGE(PG8_SB(1, 0), cB + kstep, voffB); PG8_STAGE(PG8_SA(1, 0), cA + kstep, voffA); PG8_STAGE(PG8_SB(1, 1), cB + hstep + kstep, voffB);
        PG8_WAIT_V(6); PG8_BAR;
    }
    for (;;) {
        const bool has_next = S.next(ui + 1, nxt);
        const char* nA = has_next ? (const char*)g.A + (size_t)nxt.pm * tstep : cA; const char* nB = has_next ? (const char*)g.Bt + (size_t)nxt.pn * tstep : cB;
        for (int t = 0; t < nt; t += 2) {
            const bool last = (t == nt - 2);
            const char* a1 = cA + (size_t)(t + 1) * kstep;
            const char* a2 = last ? nA : cA + (size_t)(t + 2) * kstep; const char* b2 = last ? nB : cB + (size_t)(t + 2) * kstep;
            const char* a3 = a2 + kstep; const char* b3 = b2 + kstep;
            if (last && has_next) S.a_ready(nxt);
            if constexpr (SP2) {
            PG8_LDB(B0, 0, 0); PG8_LDB(B1, 0, 1); PG8_SCHED; PG8_LDA(At, 0, 0); PG8_STAGE(PG8_SA(1, 1), a1 + hstep, voffA);
            PG8_WAIT_V(8); PG8_WAIT_L(0); PG8_BAR; PG8_MMA(0, 0, At, B0); PG8_MMA(0, 1, At, B1); PG8_BAR; PG8_SCHED;
            PG8_LDA(At, 0, 1); PG8_STAGE(PG8_SB(0, 0), b2, voffB); PG8_STAGE(PG8_SB(0, 1), b2 + hstep, voffB); PG8_STAGE(PG8_SA(0, 0), a2, voffA);
            PG8_WAIT_V(8); PG8_WAIT_L(0); PG8_BAR; PG8_MMA(1, 0, At, B0); PG8_MMA(1, 1, At, B1); PG8_BAR; PG8_SCHED;
            PG8_LDB(B0, 1, 0); PG8_LDB(B1, 1, 1); PG8_SCHED; PG8_LDA(At, 1, 0); PG8_STAGE(PG8_SA(0, 1), a2 + hstep, voffA);
            PG8_WAIT_V(8); PG8_WAIT_L(0); PG8_BAR; PG8_MMA(0, 0, At, B0); PG8_MMA(0, 1, At, B1); PG8_BAR; PG8_SCHED;
            PG8_LDA(At, 1, 1); PG8_STAGE(PG8_SB(1, 0), b3, voffB); PG8_STAGE(PG8_SB(1, 1), b3 + hstep, voffB); PG8_STAGE(PG8_SA(1, 0), a3, voffA);
            PG8_WAIT_V(8); PG8_WAIT_L(0); PG8_BAR; PG8_MMA(1, 0, At, B0); PG8_MMA(1, 1, At, B1); PG8_BAR; PG8_SCHED;
            } else {
            PG8_LDB(B0, 0, 0); PG8_SCHED; PG8_LDA(At, 0, 0); PG8_STAGE(PG8_SA(1, 1), a1 + hstep, voffA);
            PG8_WAIT_L(8); PG8_BAR; PG8_WAIT_L(0); PG8_MMA(0, 0, At, B0); PG8_BAR; PG8_SCHED;
            PG8_LDB(B1, 0, 1); PG8_STAGE(PG8_SB(0, 0), b2, voffB);
            PG8_BAR; PG8_WAIT_L(0); PG8_MMA(0, 1, At, B1); PG8_BAR;
            PG8_LDA(At, 0, 1); PG8_STAGE(PG8_SA(0, 0), a2, voffA);
            PG8_BAR; PG8_WAIT_L(0); PG8_MMA(1, 0, At, B0); PG8_BAR; PG8_SCHED;
            PG8_STAGE(PG8_SB(0, 1), b2 + hstep, voffB);
            PG8_WAIT_V(6); PG8_BAR; PG8_MMA(1, 1, At, B1); PG8_BAR;
            PG8_LDB(B0, 1, 0); PG8_SCHED; PG8_LDA(At, 1, 0); PG8_STAGE(PG8_SA(0, 1), a2 + hstep, voffA);
            PG8_WAIT_L(8); PG8_BAR; PG8_WAIT_L(0); PG8_MMA(0, 0, At, B0); PG8_BAR; PG8_SCHED;
            PG8_LDB(B1, 1, 1); PG8_STAGE(PG8_SB(1, 0), b3, voffB);
            PG8_BAR; PG8_WAIT_L(0); PG8_MMA(0, 1, At, B1); PG8_BAR;
            PG8_LDA(At, 1, 1); PG8_STAGE(PG8_SA(1, 0), a3, voffA);
            PG8_BAR; PG8_WAIT_L(0); PG8_MMA(1, 0, At, B0); PG8_BAR; PG8_SCHED;
            PG8_STAGE(PG8_SB(1, 1), b3 + hstep, voffB);
            PG8_WAIT_V(6); PG8_BAR; PG8_MMA(1, 1, At, B1); PG8_BAR;
            }
        }
        if constexpr (ALIGN_EPI) { if (wr == 0) PG8_BAR; }
        if constexpr (!Epi::AFTER_DRAIN) { E(acc, cur, wr, wc, fr, fq); S.done(cur); }
        if (!has_next) break;
#pragma unroll
        for (int a = 0; a < 2; ++a)
#pragma unroll
            for (int b = 0; b < 2; ++b)
#pragma unroll
                for (int m = 0; m < 4; ++m)
#pragma unroll
                    for (int n = 0; n < 2; ++n) acc[a][b][m][n] = (f32x4){0.f, 0.f, 0.f, 0.f};
        cur = nxt; cA = nA; cB = nB; ++ui;
        if constexpr (ALIGN_EPI) { if (wr == 1) PG8_BAR; }
    }
    PG8_WAIT_V(0);
    if constexpr (!ALIGN_EPI) { if (wr == 0) PG8_BAR; }
    PG8_BAR;
    if constexpr (Epi::AFTER_DRAIN) { E.fused(acc, cur, wr, wc, fr, fq, lds, wid, lane); S.done(cur); }
#undef PG8_SA
#undef PG8_SB
#undef PG8_STAGE
#undef PG8_LDA
#undef PG8_LDB
#undef PG8_MMA
#undef PG8_WAIT_V
#undef PG8_WAIT_L
#undef PG8_BAR
#undef PG8_SCHED
}
}

#define LAS __attribute__((address_space(3)))
typedef unsigned short bf16;
typedef unsigned v4u __attribute__((ext_vector_type(4)));
typedef unsigned v2u __attribute__((ext_vector_type(2)));
typedef float f32x4 __attribute__((ext_vector_type(4)));
typedef float f32x2 __attribute__((ext_vector_type(2)));
typedef short bf16x8 __attribute__((ext_vector_type(8)));
typedef short s16x4 __attribute__((ext_vector_type(4)));

#ifndef MK_ONE_LAUNCH
#define MK_ONE_LAUNCH 1
#endif

constexpr int DM = 2048, NTOK = 9216, NPTOK = 8192, SEQ = 2048, NB = 4, DECB = 128, DECT = 8;
constexpr int IN_DIM = 9216, FF = 8192, ADA_N = 12288;
constexpr int C_K = 1024, C_V = 1280, C_XA = 1536, C_XB = 2048, C_XS = 2560, C_G = 3072;
constexpr int NMODROW = 132;
constexpr int NPHASE = 20;

constexpr size_t MiB = 1u << 20;
constexpr size_t WS_ROPE = 1 * MiB, WS_AC = 2 * MiB, WS_MOD = 3 * MiB, WS_WADA = 16 * MiB;
constexpr size_t WS_WL = 112 * MiB, WL_STRIDE = 118 * MiB;
constexpr size_t WL_IN = 0, WL_O = 36 * MiB, WL_CO = 40 * MiB, WL_GA = 42 * MiB, WL_GB = 44 * MiB, WL_OUT = 46 * MiB, WL_F1 = 54 * MiB, WL_F2 = 86 * MiB;
constexpr size_t WS_H = 348 * MiB;
constexpr size_t WS_P = 384 * MiB;
constexpr size_t WS_QN = 546 * MiB, WS_KN = 564 * MiB, WS_O = 569 * MiB, WS_YC = 587 * MiB, WS_YS = 596 * MiB;
constexpr size_t WS_MG = 605 * MiB;
constexpr size_t WS_X = 677 * MiB;
constexpr size_t WS_END = 749 * MiB;

constexpr size_t O_Y = 0;
constexpr size_t O_NKP = (size_t)NTOK * DM;
constexpr size_t O_NVP = O_NKP + 2 * 4 * 128 * 256;
constexpr size_t O_NCP = O_NVP + 2 * 4 * 128 * 256;
constexpr size_t O_NRP = O_NCP + 2 * 4 * 30 * 512;
constexpr size_t O_NIP = O_NRP + 2 * 4 * 32 * 64;
constexpr size_t O_NKS = O_NIP + 2 * 4 * 32 * 64;
constexpr size_t O_NVS = O_NKS + (size_t)2 * 128 * 128 * 256;
constexpr size_t O_NCS = O_NVS + (size_t)2 * 128 * 128 * 256;
constexpr size_t O_NRS = O_NCS + (size_t)2 * 128 * 30 * 512;
constexpr size_t O_NIS = O_NRS + (size_t)2 * 128 * 32 * 64;
constexpr size_t O_END = O_NIS + (size_t)2 * 128 * 32 * 64;

constexpr int LDS_BYTES = 135168;

struct Args { const float* in[36]; float* out; unsigned char* ws; int ph_lo, ph_hi; };

enum { I_XP = 0, I_XS, I_CP, I_CS, I_CK, I_CV, I_SCONV, I_SRE, I_SIM, I_WADA, I_BADA, I_NORM1, I_WIN, I_QN, I_KN, I_SINK, I_WO, I_CW, I_CB, I_CLG, I_CLB, I_WCO,
       I_ARE, I_AIM, I_LDT, I_BRE, I_BIM, I_CRE, I_CIM, I_SD, I_WGA, I_WGB, I_WOUT, I_NORM2, I_WF1, I_WF2 };

__device__ __forceinline__ float bf2f(unsigned b) { return __uint_as_float(b << 16); }
__device__ __forceinline__ unsigned f2bf(float f) { unsigned u = __float_as_uint(f); return (u + 0x7fffu + ((u >> 16) & 1u)) >> 16; }
__device__ __forceinline__ unsigned pk2(float lo, float hi) { return f2bf(lo) | (f2bf(hi) << 16); }
__device__ __forceinline__ float lo16(unsigned w) { return __uint_as_float(w << 16); }
__device__ __forceinline__ float hi16(unsigned w) { return __uint_as_float(w & 0xffff0000u); }
__device__ __forceinline__ float sigm(float x) { return 1.f / (1.f + __expf(-x)); }
__device__ __forceinline__ float wave_sum(float v) {
#pragma unroll
    for (int o = 1; o < 64; o <<= 1) v += __shfl_xor(v, o);
    return v;
}
#define LDS_WAIT() asm volatile("s_waitcnt lgkmcnt(0)" ::: "memory")
#define WAVE_SYNC() do { asm volatile("s_waitcnt lgkmcnt(0)" ::: "memory"); __builtin_amdgcn_wave_barrier(); asm volatile("" ::: "memory"); } while (0)

__device__ __forceinline__ double dexp_(double x) {
    const double kf = rint(x * 1.4426950408889634);
    double r = fma(-kf, 6.93147180369123816490e-01, x); r = fma(-kf, 1.90821492927058770002e-10, r);
    double p = 1.0 / 6227020800.0;
    p = fma(p, r, 1.0 / 479001600.0); p = fma(p, r, 1.0 / 39916800.0); p = fma(p, r, 1.0 / 3628800.0); p = fma(p, r, 1.0 / 362880.0);
    p = fma(p, r, 1.0 / 40320.0); p = fma(p, r, 1.0 / 5040.0); p = fma(p, r, 1.0 / 720.0); p = fma(p, r, 1.0 / 120.0);
    p = fma(p, r, 1.0 / 24.0); p = fma(p, r, 1.0 / 6.0); p = fma(p, r, 0.5); p = fma(p, r, 1.0); p = fma(p, r, 1.0);
    const long long k = (long long)kf;
    return p * __longlong_as_double((1023ll + k) << 52);
}
__device__ __forceinline__ void dsincos_(double x, double& sn, double& cs) {
    const double kf = rint(x * 0.15915494309189535);
    double r = fma(-kf, 6.283185307179586, x); r = fma(-kf, 2.4492935982947064e-16, r);
    const double s = r * 0.125, z = s * s;
    double ps = -1.0 / 355687428096000.0;
    ps = fma(ps, z, 1.0 / 1307674368000.0); ps = fma(ps, z, -1.0 / 6227020800.0); ps = fma(ps, z, 1.0 / 39916800.0); ps = fma(ps, z, -1.0 / 362880.0);
    ps = fma(ps, z, 1.0 / 5040.0); ps = fma(ps, z, -1.0 / 120.0); ps = fma(ps, z, 1.0 / 6.0);
    double a = s - s * z * ps;
    double pc = 1.0 / 20922789888000.0;
    pc = fma(pc, z, -1.0 / 87178291200.0); pc = fma(pc, z, 1.0 / 479001600.0); pc = fma(pc, z, -1.0 / 3628800.0); pc = fma(pc, z, 1.0 / 40320.0);
    pc = fma(pc, z, -1.0 / 720.0); pc = fma(pc, z, 1.0 / 24.0); pc = fma(pc, z, -0.5);
    double b = fma(pc, z, 1.0);
#pragma unroll
    for (int i = 0; i < 3; ++i) { const double a2 = 2.0 * a * b, b2 = 1.0 - 2.0 * a * a; a = a2; b = b2; }
    sn = a; cs = b;
}

namespace pg8 {
#define EPI_FOREACH4(...) \
    _Pragma("unroll") for (int ai = 0; ai < 2; ++ai) _Pragma("unroll") for (int m = 0; m < 4; ++m) { const int row = u.pm * BM + ai * HALF + wr * 64 + m * 16 + fr; \
    _Pragma("unroll") for (int bj = 0; bj < 2; ++bj) _Pragma("unroll") for (int n = 0; n < 2; ++n) { const int col = u.pn * BM + bj * HALF + wc * 32 + n * 16 + 4 * fq; const f32x4 v = acc[ai][bj][m][n]; __VA_ARGS__ } asm volatile("" ::: "memory"); __builtin_amdgcn_sched_barrier(0); }
#define EPI_FOREACH8(...) \
    _Pragma("unroll") for (int ai = 0; ai < 2; ++ai) _Pragma("unroll") for (int m = 0; m < 4; ++m) { const int row = u.pm * BM + ai * HALF + wr * 64 + m * 16 + fr; \
    _Pragma("unroll") for (int bj = 0; bj < 2; ++bj) { const int col = u.pn * BM + bj * HALF + wc * 32 + 8 * fq; const f32x4 v0 = acc[ai][bj][m][0], v1 = acc[ai][bj][m][1]; __VA_ARGS__ } asm volatile("" ::: "memory"); __builtin_amdgcn_sched_barrier(0); }
#define EPI_SIG const f32x4 (&acc)[2][2][4][2], const Unit& u, int wr, int wc, int fr, int fq

__device__ __forceinline__ int mod_row(int row) { return row < NPTOK ? (row >> 11) : 4 + ((row - NPTOK) >> 3); }
__device__ __forceinline__ v4u pack8(const f32x4 a, const f32x4 b) { v4u w; w.x = cvt_pk_bf16(a[0], a[1]); w.y = cvt_pk_bf16(a[2], a[3]); w.z = cvt_pk_bf16(b[0], b[1]); w.w = cvt_pk_bf16(b[2], b[3]); return w; }

struct EpiAda {
    static constexpr bool PERM = false, AFTER_DRAIN = false; float* mod; const float* bias;
    __device__ __forceinline__ void operator()(EPI_SIG) const {
        EPI_FOREACH4( if (row < NMODROW) { const f32x4 bv = *(const f32x4*)(bias + col); *(f32x4*)(mod + row * (2 * ADA_N) + col) = v + bv; } )
    }
};
struct EpiP {
    static constexpr bool PERM = true, AFTER_DRAIN = false; bf16_t* P;
    __device__ __forceinline__ void operator()(EPI_SIG) const {
        const bool sg = (u.pn * BM) >= C_G;
        EPI_FOREACH8( f32x4 a = v0, b = v1; if (sg) {
            _Pragma("unroll") for (int i = 0; i < 4; ++i) { a[i] = sigm(a[i]); b[i] = sigm(b[i]); } }
            *(v4u*)(P + (unsigned)(row * IN_DIM + col)) = pack8(a, b); )
    }
};
struct EpiStoreF32 {
    static constexpr bool PERM = false, AFTER_DRAIN = false; float* MG;
    __device__ __forceinline__ void operator()(EPI_SIG) const { EPI_FOREACH4( *(f32x4*)(MG + (unsigned)(row * DM + col)) = v; ) }
};
__device__ __forceinline__ f32x4 gate4(const bf16_t* P, int row, int col, int br) {
    const v2u g = *(const v2u*)(P + (unsigned)(row * IN_DIM + C_G + br * DM + col)); return (f32x4){lo16(g.x), hi16(g.x), lo16(g.y), hi16(g.y)};
}
struct EpiGluB {
    static constexpr bool PERM = false, AFTER_DRAIN = false; float* MG; const bf16_t* P;
    __device__ __forceinline__ void operator()(EPI_SIG) const {
        EPI_FOREACH4( float* p = MG + (unsigned)(row * DM + col); const f32x4 a = *(const f32x4*)p; const f32x4 g = gate4(P, row, col, 2); f32x4 o;
            _Pragma("unroll") for (int i = 0; i < 4; ++i) o[i] = g[i] * a[i] * sigm(v[i]);
            *(f32x4*)p = o; )
    }
};
struct EpiAccG {
    static constexpr bool PERM = false, AFTER_DRAIN = false; float* MG; const bf16_t* P; int br;
    __device__ __forceinline__ void operator()(EPI_SIG) const {
        EPI_FOREACH4( float* p = MG + (unsigned)(row * DM + col); const f32x4 a = *(const f32x4*)p; const f32x4 g = gate4(P, row, col, br); *(f32x4*)p = a + g * v; )
    }
};
struct EpiMergeFinal {
    static constexpr bool PERM = false, AFTER_DRAIN = false; const float* MG; const bf16_t* P; bf16_t* MGb; int br;
    __device__ __forceinline__ void operator()(EPI_SIG) const {
        EPI_FOREACH4( const f32x4 a = *(const f32x4*)(MG + (unsigned)(row * DM + col)); const f32x4 g = gate4(P, row, col, br); const f32x4 o = a + g * v;
            v2u w; w.x = cvt_pk_bf16(o[0], o[1]); w.y = cvt_pk_bf16(o[2], o[3]); *(v2u*)(MGb + (unsigned)(row * DM + col)) = w; )
    }
};
struct EpiResid {
    static constexpr bool PERM = false, AFTER_DRAIN = false; const float* xp; const float* xs; const float* gate; float* out;
    __device__ __forceinline__ void operator()(EPI_SIG) const {
        const bool smp = u.pm * BM >= NPTOK; const float* xb = smp ? xs : xp; const int rb = smp ? NPTOK : 0;
        EPI_FOREACH4( const f32x4 x = *(const f32x4*)(xb + (unsigned)((row - rb) * DM + col));
            const int mr = smp ? 4 + ((row - NPTOK) >> 3) : (row >> 11);
            const f32x4 g = *(const f32x4*)(gate + (unsigned)(mr * (2 * ADA_N) + col)); *(f32x4*)(out + (unsigned)(row * DM + col)) = x + g * v; )
    }
};
struct EpiRelu2 {
    static constexpr bool PERM = true, AFTER_DRAIN = false; bf16_t* F;
    __device__ __forceinline__ void operator()(EPI_SIG) const {
        EPI_FOREACH8( f32x4 a = v0, b = v1;
            _Pragma("unroll") for (int i = 0; i < 4; ++i) { const float x = fmaxf(a[i], 0.f), y = fmaxf(b[i], 0.f); a[i] = x * x; b[i] = y * y; }
            *(v4u*)(F + (unsigned)(row * FF + col)) = pack8(a, b); )
    }
};
}

__device__ __forceinline__ void p0_transpose_item(const float* W, int K, int N, bf16* WT, int row_off, LAS float* scr, int item, int lane) {
    const int nblk = N / 32, kb = item / nblk, nb = item % nblk, k0 = 64 * kb, n0 = 32 * nb;
#pragma unroll 8
    for (int i = 0; i < 32; ++i) { const int kk = 2 * i + (lane >> 5); scr[kk * 33 + (lane & 31)] = W[(size_t)(k0 + kk) * N + n0 + (lane & 31)]; }
    LDS_WAIT(); asm volatile("" ::: "memory");
    const int c = lane & 7;
#pragma unroll
    for (int j = 0; j < 4; ++j) { const int n = (lane >> 3) + 8 * j; const LAS float* s = scr + (8 * c) * 33 + n;
        v4u o; o.x = pk2(s[0 * 33], s[1 * 33]); o.y = pk2(s[2 * 33], s[3 * 33]); o.z = pk2(s[4 * 33], s[5 * 33]); o.w = pk2(s[6 * 33], s[7 * 33]);
        *(v4u*)(WT + (size_t)(row_off + n0 + n) * K + k0 + 8 * c) = o; }
    LDS_WAIT(); asm volatile("" ::: "memory");
}

__device__ __forceinline__ void p0_prologue(const Args& a, LAS unsigned char* lds, int gw, int NGW, int lane, int wave, int gtid, int NGT) {
    LAS float* scr = (LAS float*)(lds + wave * 16384);
    unsigned char* ws = a.ws;
    constexpr int I_ADA = (DM / 64) * (ADA_N / 32), I_IN = (DM / 64) * (IN_DIM / 32), I_O = (1024 / 64) * (DM / 32), I_CO = (512 / 64) * (DM / 32), I_G = I_CO,
                  I_OUT = (DM / 64) * (DM / 32), I_F1 = (DM / 64) * (FF / 32), I_F2 = (FF / 64) * (DM / 32);
    constexpr int PER_LAYER = I_ADA + I_IN + I_O + I_CO + 2 * I_G + I_OUT + I_F1 + I_F2;
    for (int it = gw; it < 2 * PER_LAYER; it += NGW) {
        const int l = it / PER_LAYER; int r = it - l * PER_LAYER;
        bf16* wl = (bf16*)(ws + WS_WL + (size_t)l * WL_STRIDE);
        if (r < I_ADA) { p0_transpose_item(a.in[I_WADA] + (size_t)l * DM * ADA_N, DM, ADA_N, (bf16*)(ws + WS_WADA), l * ADA_N, scr, r, lane); continue; } r -= I_ADA;
        if (r < I_IN) { p0_transpose_item(a.in[I_WIN] + (size_t)l * DM * IN_DIM, DM, IN_DIM, wl + WL_IN / 2, 0, scr, r, lane); continue; } r -= I_IN;
        if (r < I_O) { p0_transpose_item(a.in[I_WO] + (size_t)l * 1024 * DM, 1024, DM, wl + WL_O / 2, 0, scr, r, lane); continue; } r -= I_O;
        if (r < I_CO) { p0_transpose_item(a.in[I_WCO] + (size_t)l * 512 * DM, 512, DM, wl + WL_CO / 2, 0, scr, r, lane); continue; } r -= I_CO;
        if (r < I_G) { p0_transpose_item(a.in[I_WGA] + (size_t)l * 512 * DM, 512, DM, wl + WL_GA / 2, 0, scr, r, lane); continue; } r -= I_G;
        if (r < I_G) { p0_transpose_item(a.in[I_WGB] + (size_t)l * 512 * DM, 512, DM, wl + WL_GB / 2, 0, scr, r, lane); continue; } r -= I_G;
        if (r < I_OUT) { p0_transpose_item(a.in[I_WOUT] + (size_t)l * DM * DM, DM, DM, wl + WL_OUT / 2, 0, scr, r, lane); continue; } r -= I_OUT;
        if (r < I_F1) { p0_transpose_item(a.in[I_WF1] + (size_t)l * DM * FF, DM, FF, wl + WL_F1 / 2, 0, scr, r, lane); continue; } r -= I_F1;
        p0_transpose_item(a.in[I_WF2] + (size_t)l * FF * DM, FF, DM, wl + WL_F2 / 2, 0, scr, r, lane);
    }
    unsigned* AC = (unsigned*)(ws + WS_AC);
    for (int i = gtid; i < 256 * DM / 2; i += NGT) {
        const int row = i / (DM / 2), c2 = (i % (DM / 2)) * 2; unsigned w = 0u;
        if (row < NMODROW) { const float* src = row < 4 ? a.in[I_CP] + row * DM + c2 : a.in[I_CS] + (row - 4) * DM + c2; const float x = src[0], y = src[1]; w = pk2(x * sigm(x), y * sigm(y)); }
        AC[i] = w;
    }
    f32x2* RT = (f32x2*)(ws + WS_ROPE);
    for (int i = gtid; i < 2056 * 8; i += NGT) {
        const int pi = i >> 3, fi = i & 7; const double pos = pi < 2048 ? (double)pi : (double)(8192 + pi - 2048);
        const double invf = dexp_(-(double)fi * 0.125 * 13.122363377404328);
        double sn, cs; dsincos_(pos * invf, sn, cs); RT[i] = (f32x2){(float)cs, (float)sn};
    }
}

__device__ __forceinline__ void norm_mod_phase(const float* xp, const float* xs, const float* normw, const float* mod, int l, int second, bf16* H) {
    int tid_o = threadIdx.x; asm volatile("" : "+v"(tid_o)); const int tid = tid_o, lane = tid & 63, wave = __builtin_amdgcn_readfirstlane(tid >> 6); (void)lane; (void)wave;
    const int NGW = gridDim.x * 8, gw = blockIdx.x * 8 + wave;
    for (int row = gw; row < NTOK; row += NGW) {
        const float* xr = row < NPTOK ? xp + (size_t)row * DM : xs + (size_t)(row - NPTOK) * DM;
        const float* shift = mod + (size_t)pg8::mod_row(row) * (2 * ADA_N) + l * ADA_N + (second ? 3 : 0) * DM; const float* scale = shift + DM;
        f32x4 v[8]; float ss = 0.f;
#pragma unroll
        for (int j = 0; j < 8; ++j) { v[j] = *(const f32x4*)(xr + 4 * (lane + 64 * j)); ss += (v[j][0] * v[j][0] + v[j][1] * v[j][1]) + (v[j][2] * v[j][2] + v[j][3] * v[j][3]); }
        ss = wave_sum(ss); const float rstd = rsqrtf(ss * (1.f / DM) + 1e-6f);
#pragma unroll
        for (int j = 0; j < 8; ++j) { const int c = 4 * (lane + 64 * j); const f32x4 nw = *(const f32x4*)(normw + c), sc = *(const f32x4*)(scale + c), sh = *(const f32x4*)(shift + c);
            const f32x4 y = (v[j] * rstd) * nw * (sc + 1.f) + sh; v2u w; w.x = pk2(y[0], y[1]); w.y = pk2(y[2], y[3]); *(v2u*)(H + (size_t)row * DM + c) = w; }
    }
}

__device__ __forceinline__ void qk_prep_phase(const Args& a, int l) {
    int tid_o = threadIdx.x; asm volatile("" : "+v"(tid_o)); const int tid = tid_o, lane = tid & 63, wave = __builtin_amdgcn_readfirstlane(tid >> 6); (void)lane; (void)wave;
    const int NGW = gridDim.x * 8, NGT = gridDim.x * 512, gw = blockIdx.x * 8 + wave, gtid = blockIdx.x * 512 + tid;
    unsigned char* ws = a.ws; asm volatile("" : "+s"(ws)); const bf16* P = (const bf16*)(ws + WS_P); bf16* QN = (bf16*)(ws + WS_QN); bf16* KN = (bf16*)(ws + WS_KN);
    const f32x2* RT = (const f32x2*)(ws + WS_ROPE); float* out = a.out;
    const float* qg = a.in[I_QN] + l * 64; const float* kg = a.in[I_KN] + l * 64;
    for (int wi = gw; wi < NTOK * 20 / 16; wi += NGW) {
        const int unit = wi * 16 + (lane >> 2), tok = unit / 20, hh = unit - tok * 20, j = lane & 3;
        const bf16* src = P + (size_t)tok * IN_DIM + hh * 64 + j * 16;
        const v4u r0 = *(const v4u*)src, r1 = *(const v4u*)(src + 8);
        float x[16];
        x[0] = lo16(r0.x); x[1] = hi16(r0.x); x[2] = lo16(r0.y); x[3] = hi16(r0.y); x[4] = lo16(r0.z); x[5] = hi16(r0.z); x[6] = lo16(r0.w); x[7] = hi16(r0.w);
        x[8] = lo16(r1.x); x[9] = hi16(r1.x); x[10] = lo16(r1.y); x[11] = hi16(r1.y); x[12] = lo16(r1.z); x[13] = hi16(r1.z); x[14] = lo16(r1.w); x[15] = hi16(r1.w);
        float ss = 0.f;
#pragma unroll
        for (int e = 0; e < 16; ++e) ss += x[e] * x[e];
        ss += __shfl_xor(ss, 1); ss += __shfl_xor(ss, 2);
        const float rstd = rsqrtf(ss * (1.f / 64.f) + 1e-6f);
        const float* gn = (hh < 16 ? qg : kg) + j * 16;
#pragma unroll
        for (int e = 0; e < 16; ++e) x[e] = x[e] * rstd * gn[e];
        if (j == 0) {
            const int pi = tok < NPTOK ? (tok & 2047) : 2048 + ((tok - NPTOK) & 7);
#pragma unroll
            for (int i = 0; i < 8; ++i) { const f32x2 cs = RT[pi * 8 + i]; const float p = x[i], q = x[8 + i]; x[i] = p * cs.x - q * cs.y; x[8 + i] = q * cs.x + p * cs.y; }
        }
        if (hh < 16) {
            v4u w0, w1;
            w0.x = pk2(x[0] * 0.125f, x[1] * 0.125f); w0.y = pk2(x[2] * 0.125f, x[3] * 0.125f); w0.z = pk2(x[4] * 0.125f, x[5] * 0.125f); w0.w = pk2(x[6] * 0.125f, x[7] * 0.125f);
            w1.x = pk2(x[8] * 0.125f, x[9] * 0.125f); w1.y = pk2(x[10] * 0.125f, x[11] * 0.125f); w1.z = pk2(x[12] * 0.125f, x[13] * 0.125f); w1.w = pk2(x[14] * 0.125f, x[15] * 0.125f);
            bf16* dst = QN + (size_t)tok * 1024 + hh * 64 + j * 16; *(v4u*)dst = w0; *(v4u*)(dst + 8) = w1;
        } else {
            const int kh = hh - 16;
            v4u w0, w1;
            w0.x = pk2(x[0], x[1]); w0.y = pk2(x[2], x[3]); w0.z = pk2(x[4], x[5]); w0.w = pk2(x[6], x[7]);
            w1.x = pk2(x[8], x[9]); w1.y = pk2(x[10], x[11]); w1.z = pk2(x[12], x[13]); w1.w = pk2(x[14], x[15]);
            bf16* dst = KN + (size_t)tok * 256 + kh * 64 + j * 16; *(v4u*)dst = w0; *(v4u*)(dst + 8) = w1;
            float* o = nullptr;
            if (tok < NPTOK) { const int t = tok & 2047, b = tok >> 11; if (t >= SEQ - 128) o = out + O_NKP + ((size_t)(l * NB + b) * 128 + (t - (SEQ - 128))) * 256 + kh * 64 + j * 16; }
            else { const int bs = (tok - NPTOK) >> 3, t = (tok - NPTOK) & 7; o = out + O_NKS + ((size_t)(l * DECB + bs) * 128 + 120 + t) * 256 + kh * 64 + j * 16; }
            if (o) {
#pragma unroll
                for (int e = 0; e < 4; ++e) *(f32x4*)(o + 4 * e) = (f32x4){x[4 * e], x[4 * e + 1], x[4 * e + 2], x[4 * e + 3]};
            }
        }
    }
    for (int i = gtid; i < (NB * 128 + DECB * DECT) * 64; i += NGT) {
        const int rowi = i >> 6, c4 = (i & 63) * 4; int tok; float* o;
        if (rowi < NB * 128) { const int b = rowi >> 7, t = rowi & 127; tok = b * SEQ + (SEQ - 128) + t; o = out + O_NVP + ((size_t)(l * NB + b) * 128 + t) * 256 + c4; }
        else { const int r2 = rowi - NB * 128, bs = r2 >> 3, t = r2 & 7; tok = NPTOK + r2; o = out + O_NVS + ((size_t)(l * DECB + bs) * 128 + 120 + t) * 256 + c4; }
        const v2u w = *(const v2u*)(P + (size_t)tok * IN_DIM + C_V + c4);
        *(f32x4*)o = (f32x4){lo16(w.x), hi16(w.x), lo16(w.y), hi16(w.y)};
    }
    for (int i = gtid; i < DECB * 120 * 64; i += NGT) {
        const int bs = i / (120 * 64), rem = i - bs * (120 * 64);
        const size_t so = ((size_t)(l * DECB + bs) * 128 + 8) * 256 + (size_t)rem * 4, dofs = ((size_t)(l * DECB + bs) * 128) * 256 + (size_t)rem * 4;
        *(f32x4*)(out + O_NKS + dofs) = *(const f32x4*)(a.in[I_CK] + so);
        *(f32x4*)(out + O_NVS + dofs) = *(const f32x4*)(a.in[I_CV] + so);
    }
}

template <int NKT>
__device__ __forceinline__ void attn_qgroup(const LAS bf16* Ks, int kst, const LAS bf16* Vt, int vst, const bf16* qrow, int qi, bool hasprev, float sink, bf16* orow, bool store_ok, int lane) {
    static_assert(NKT % 2 == 0, "key tiles come in pairs");
    const int lr = lane & 15, q4 = lane >> 4;
    const bf16x8 qf0 = *(const bf16x8*)(qrow + 8 * q4), qf1 = *(const bf16x8*)(qrow + 32 + 8 * q4);
    f32x4 s[NKT];
#pragma unroll
    for (int kt = 0; kt < NKT; ++kt) {
        const LAS bf16* kp = Ks + (16 * kt + lr) * kst + 8 * q4;
        const bf16x8 k0 = *(const LAS bf16x8*)kp, k1 = *(const LAS bf16x8*)(kp + 32);
        f32x4 z = (f32x4){0.f, 0.f, 0.f, 0.f};
        z = __builtin_amdgcn_mfma_f32_16x16x32_bf16(k0, qf0, z, 0, 0, 0);
        z = __builtin_amdgcn_mfma_f32_16x16x32_bf16(k1, qf1, z, 0, 0, 0);
        s[kt] = z;
        if ((kt & 3) == 3) __builtin_amdgcn_sched_barrier(0);
    }
    float m = sink;
#pragma unroll
    for (int kt = 0; kt < NKT; ++kt)
#pragma unroll
        for (int i = 0; i < 4; ++i) { const int kj = 16 * kt + 4 * q4 + i; const bool ok = (kj > qi) && (kj <= qi + 128) && (hasprev || kj >= 128);
            const float v = ok ? s[kt][i] : -INFINITY; s[kt][i] = v; m = fmaxf(m, v); }
    m = fmaxf(m, __shfl_xor(m, 16)); m = fmaxf(m, __shfl_xor(m, 32));
    float sum = 0.f;
#pragma unroll
    for (int kt = 0; kt < NKT; ++kt)
#pragma unroll
        for (int i = 0; i < 4; ++i) { const float p = __expf(s[kt][i] - m); s[kt][i] = p; sum += p; }
    sum += __shfl_xor(sum, 16); sum += __shfl_xor(sum, 32);
    const float inv = 1.f / (sum + __expf(sink - m));
    f32x4 o[4];
#pragma unroll
    for (int dt = 0; dt < 4; ++dt) o[dt] = (f32x4){0.f, 0.f, 0.f, 0.f};
#pragma unroll
    for (int kp = 0; kp < NKT / 2; ++kp) {
        v4u pw; pw.x = pk2(s[2 * kp][0], s[2 * kp][1]); pw.y = pk2(s[2 * kp][2], s[2 * kp][3]); pw.z = pk2(s[2 * kp + 1][0], s[2 * kp + 1][1]); pw.w = pk2(s[2 * kp + 1][2], s[2 * kp + 1][3]);
        const bf16x8 pb = __builtin_bit_cast(bf16x8, pw);
#pragma unroll
        for (int dt = 0; dt < 4; ++dt) {
            const LAS bf16* vp = Vt + (16 * dt + lr) * vst + 32 * kp + 4 * q4;
            const v2u lo = *(const LAS v2u*)vp, hi = *(const LAS v2u*)(vp + 16);
            v4u vw; vw.x = lo.x; vw.y = lo.y; vw.z = hi.x; vw.w = hi.y;
            o[dt] = __builtin_amdgcn_mfma_f32_16x16x32_bf16(__builtin_bit_cast(bf16x8, vw), pb, o[dt], 0, 0, 0);
        }
    }
    if (store_ok) {
#pragma unroll
        for (int dt = 0; dt < 4; ++dt) { v2u w; w.x = pk2(o[dt][0] * inv, o[dt][1] * inv); w.y = pk2(o[dt][2] * inv, o[dt][3] * inv); *(v2u*)(orow + 16 * dt + 4 * q4) = w; }
    }
}

constexpr int AP_KST = 72, AP_VST = 264;
constexpr int AS_KST = 72, AS_VST = 168, AS_NK = 160;

__device__ __forceinline__ void attn_prompt_item(const Args& a, int l, int item, LAS unsigned char* lds) {
    int tid_o = threadIdx.x; asm volatile("" : "+v"(tid_o)); const int tid = tid_o, lane = tid & 63, wave = __builtin_amdgcn_readfirstlane(tid >> 6); (void)lane; (void)wave;
    unsigned char* ws = a.ws; asm volatile("" : "+s"(ws)); const bf16* P = (const bf16*)(ws + WS_P); const bf16* QN = (const bf16*)(ws + WS_QN); const bf16* KN = (const bf16*)(ws + WS_KN); bf16* O = (bf16*)(ws + WS_O);
    const int kvh = item & 3, n = (item >> 2) & 15, b = item >> 6;
    LAS bf16* Ks = (LAS bf16*)lds; LAS bf16* Vt = (LAS bf16*)(lds + 256 * AP_KST * 2);
#pragma unroll
    for (int i = 0; i < 4; ++i) { const int c = tid + 512 * i, r = c >> 3, ch = c & 7, pos = 128 * (n - 1) + r;
        v4u val = (v4u){0u, 0u, 0u, 0u}; if (pos >= 0) val = *(const v4u*)(KN + (size_t)(b * SEQ + pos) * 256 + kvh * 64 + ch * 8);
        *(LAS v4u*)(Ks + r * AP_KST + ch * 8) = val; }
#pragma unroll
    for (int i = 0; i < 4; ++i) { const int c = tid + 512 * i, key = c & 255, ch = c >> 8, pos = 128 * (n - 1) + key;
        v4u val = (v4u){0u, 0u, 0u, 0u}; if (pos >= 0) val = *(const v4u*)(P + (size_t)(b * SEQ + pos) * IN_DIM + C_V + kvh * 64 + ch * 8);
        LAS bf16* d = Vt + (ch * 8) * AP_VST + key;
        d[0 * AP_VST] = (bf16)(val.x & 0xffffu); d[1 * AP_VST] = (bf16)(val.x >> 16); d[2 * AP_VST] = (bf16)(val.y & 0xffffu); d[3 * AP_VST] = (bf16)(val.y >> 16);
        d[4 * AP_VST] = (bf16)(val.z & 0xffffu); d[5 * AP_VST] = (bf16)(val.z >> 16); d[6 * AP_VST] = (bf16)(val.w & 0xffffu); d[7 * AP_VST] = (bf16)(val.w >> 16); }
    __syncthreads();
    const int g = wave >> 1, half = wave & 1, head = kvh * 4 + g; const float sink = a.in[I_SINK][l * 16 + head];
#pragma nounroll
    for (int qg = 0; qg < 4; ++qg) {
        const int qi = 64 * half + 16 * qg + (lane & 15); const size_t tok = (size_t)b * SEQ + 128 * n + qi;
        attn_qgroup<16>(Ks, AP_KST, Vt, AP_VST, QN + tok * 1024 + head * 64, qi, n > 0, sink, O + tok * 1024 + head * 64, true, lane);
    }
    __syncthreads();
}

__device__ __forceinline__ void attn_sample_item(const Args& a, int l, int item, LAS unsigned char* lds) {
    int tid_o = threadIdx.x; asm volatile("" : "+v"(tid_o)); const int tid = tid_o, lane = tid & 63, wave = __builtin_amdgcn_readfirstlane(tid >> 6); (void)lane; (void)wave;
    unsigned char* ws = a.ws; asm volatile("" : "+s"(ws)); const bf16* P = (const bf16*)(ws + WS_P); const bf16* QN = (const bf16*)(ws + WS_QN); const bf16* KN = (const bf16*)(ws + WS_KN); bf16* O = (bf16*)(ws + WS_O);
    const int pair = item & 1, b = item >> 1;
    LAS bf16* Ks = (LAS bf16*)lds; LAS bf16* Vt = (LAS bf16*)(lds + 2 * AS_NK * AS_KST * 2);
    const float* ck = a.in[I_CK] + (size_t)(l * DECB + b) * 128 * 256; const float* cv = a.in[I_CV] + (size_t)(l * DECB + b) * 128 * 256;
#pragma unroll
    for (int i = 0; i < 8; ++i) { const int c = tid + 512 * i, kk = c >> 11, rem = c & 2047, r = rem >> 4, ch4 = rem & 15;
        const f32x4 v = *(const f32x4*)(ck + (size_t)r * 256 + (2 * pair + kk) * 64 + ch4 * 4); v2u w; w.x = pk2(v[0], v[1]); w.y = pk2(v[2], v[3]);
        *(LAS v2u*)(Ks + (kk * AS_NK + r) * AS_KST + ch4 * 4) = w; }
    { const int kk = tid >> 8, rem = tid & 255, r = 128 + (rem >> 3), ch = rem & 7;
      v4u val = (v4u){0u, 0u, 0u, 0u}; if (r < 136) val = *(const v4u*)(KN + (size_t)(NPTOK + b * DECT + (r - 128)) * 256 + (2 * pair + kk) * 64 + ch * 8);
      *(LAS v4u*)(Ks + (kk * AS_NK + r) * AS_KST + ch * 8) = val; }
#pragma unroll
    for (int i = 0; i < 8; ++i) { const int c = tid + 512 * i, key = c & 127, kk = (c >> 7) & 1, ch4 = c >> 8;
        const f32x4 v = *(const f32x4*)(cv + (size_t)key * 256 + (2 * pair + kk) * 64 + ch4 * 4);
        LAS bf16* d = Vt + (kk * 64 + ch4 * 4) * AS_VST + key;
        d[0] = (bf16)f2bf(v[0]); d[AS_VST] = (bf16)f2bf(v[1]); d[2 * AS_VST] = (bf16)f2bf(v[2]); d[3 * AS_VST] = (bf16)f2bf(v[3]); }
#pragma unroll
    for (int i = 0; i < 8; ++i) { const int c = tid + 512 * i, col = 128 + (c & 31), d = (c >> 5) & 63, kk = c >> 11; bf16 val = 0;
        if (col < 136) val = P[(size_t)(NPTOK + b * DECT + (col - 128)) * IN_DIM + C_V + (2 * pair + kk) * 64 + d];
        Vt[(kk * 64 + d) * AS_VST + col] = val; }
    __syncthreads();
    const int kk = wave >> 2, g = wave & 3, kvh = 2 * pair + kk, head = kvh * 4 + g; const float sink = a.in[I_SINK][l * 16 + head];
    const int qi = lane & 15, qld = qi < 8 ? qi : 7; const size_t tok = (size_t)NPTOK + b * DECT + qld;
    attn_qgroup<10>(Ks + kk * AS_NK * AS_KST, AS_KST, Vt + kk * 64 * AS_VST, AS_VST, QN + tok * 1024 + head * 64, qi, true, sink, O + tok * 1024 + head * 64, qi < 8, lane);
    __syncthreads();
}

template <int TT>
__device__ __forceinline__ void conv_compute(const Args& a, int l, LAS float* U, LAS float* red, LAS float* stat, size_t tok0, int tid, int wave, int lane) {
    const int c = tid;
    float w[31];
#pragma unroll
    for (int j = 0; j < 31; ++j) w[j] = a.in[I_CW][(size_t)(l * 31 + j) * 512 + c];
    const float bias = a.in[I_CB][l * 512 + c];
    float y[TT];
#pragma unroll
    for (int tb = 0; tb < TT / 8; ++tb) {
        float win[38];
#pragma unroll
        for (int r = 0; r < 38; ++r) win[r] = U[(tb * 8 + r) * 512 + c];
#pragma unroll
        for (int t = 0; t < 8; ++t) { float acc = bias;
#pragma unroll
            for (int j = 0; j < 31; ++j) acc = fmaf(w[j], win[t + j], acc);
            y[tb * 8 + t] = acc; }
    }
#pragma unroll
    for (int t = 0; t < TT; ++t) { const float s1 = wave_sum(y[t]), s2 = wave_sum(y[t] * y[t]); if (lane == 0) { red[(wave * 32 + t) * 2] = s1; red[(wave * 32 + t) * 2 + 1] = s2; } }
    __syncthreads();
    if (tid < TT * 2) { const int t = tid >> 1, k = tid & 1; float s = 0.f;
#pragma unroll
        for (int ww = 0; ww < 8; ++ww) s += red[(ww * 32 + t) * 2 + k];
        stat[t * 2 + k] = s; }
    __syncthreads();
    const float lg = a.in[I_CLG][l * 512 + c], lb = a.in[I_CLB][l * 512 + c];
    bf16* YC = (bf16*)(a.ws + WS_YC);
#pragma unroll
    for (int t = 0; t < TT; ++t) { const float mean = stat[t * 2] * (1.f / 512.f), var = stat[t * 2 + 1] * (1.f / 512.f) - mean * mean, rstd = rsqrtf(fmaxf(var, 0.f) + 1e-6f);
        const float v = (y[t] - mean) * rstd * lg + lb; YC[(tok0 + t) * 512 + c] = (bf16)f2bf(v * sigm(v)); }
}
__device__ __forceinline__ void glu8(const bf16* P, size_t tok, int ch, float (&u)[8]) {
    const v4u av = *(const v4u*)(P + tok * IN_DIM + C_XA + ch * 8), bv = *(const v4u*)(P + tok * IN_DIM + C_XB + ch * 8);
    u[0] = lo16(av.x) * sigm(lo16(bv.x)); u[1] = hi16(av.x) * sigm(hi16(bv.x)); u[2] = lo16(av.y) * sigm(lo16(bv.y)); u[3] = hi16(av.y) * sigm(hi16(bv.y));
    u[4] = lo16(av.z) * sigm(lo16(bv.z)); u[5] = hi16(av.z) * sigm(hi16(bv.z)); u[6] = lo16(av.w) * sigm(lo16(bv.w)); u[7] = hi16(av.w) * sigm(hi16(bv.w));
}
__device__ __forceinline__ void conv_prompt_item(const Args& a, int l, int item, LAS unsigned char* lds) {
    int tid_o = threadIdx.x; asm volatile("" : "+v"(tid_o)); const int tid = tid_o, lane = tid & 63, wave = __builtin_amdgcn_readfirstlane(tid >> 6); (void)lane; (void)wave;
    const bf16* P = (const bf16*)(a.ws + WS_P);
    LAS float* U = (LAS float*)lds; LAS float* red = U + 62 * 512; LAS float* stat = red + 512;
    const int b = item >> 6, tile = item & 63, t0 = tile * 32;
    for (int c = tid; c < 62 * 64; c += 512) { const int r = c >> 6, ch = c & 63, t = t0 - 30 + r; float u[8];
        if (t >= 0) glu8(P, (size_t)b * SEQ + t, ch, u); else {
#pragma unroll
            for (int e = 0; e < 8; ++e) u[e] = 0.f; }
        *(LAS f32x4*)(U + r * 512 + ch * 8) = (f32x4){u[0], u[1], u[2], u[3]}; *(LAS f32x4*)(U + r * 512 + ch * 8 + 4) = (f32x4){u[4], u[5], u[6], u[7]};
        if (tile == 63 && t >= SEQ - 30) { float* o = a.out + O_NCP + ((size_t)(l * NB + b) * 30 + (t - (SEQ - 30))) * 512 + ch * 8;
            *(f32x4*)o = (f32x4){u[0], u[1], u[2], u[3]}; *(f32x4*)(o + 4) = (f32x4){u[4], u[5], u[6], u[7]}; } }
    __syncthreads();
    conv_compute<32>(a, l, U, red, stat, (size_t)b * SEQ + t0, tid, wave, lane);
    __syncthreads();
}
__device__ __forceinline__ void conv_sample_item(const Args& a, int l, int item, LAS unsigned char* lds) {
    int tid_o = threadIdx.x; asm volatile("" : "+v"(tid_o)); const int tid = tid_o, lane = tid & 63, wave = __builtin_amdgcn_readfirstlane(tid >> 6); (void)lane; (void)wave;
    const bf16* P = (const bf16*)(a.ws + WS_P);
    LAS float* U = (LAS float*)lds; LAS float* red = U + 62 * 512; LAS float* stat = red + 512;
    const int b = item; const float* sc = a.in[I_SCONV] + (size_t)(l * DECB + b) * 30 * 512;
    for (int c = tid; c < 38 * 64; c += 512) { const int r = c >> 6, ch = c & 63; float u[8];
        if (r < 30) { const f32x4 x0 = *(const f32x4*)(sc + r * 512 + ch * 8), x1 = *(const f32x4*)(sc + r * 512 + ch * 8 + 4);
            u[0] = x0[0]; u[1] = x0[1]; u[2] = x0[2]; u[3] = x0[3]; u[4] = x1[0]; u[5] = x1[1]; u[6] = x1[2]; u[7] = x1[3]; }
        else glu8(P, (size_t)NPTOK + b * DECT + (r - 30), ch, u);
        *(LAS f32x4*)(U + r * 512 + ch * 8) = (f32x4){u[0], u[1], u[2], u[3]}; *(LAS f32x4*)(U + r * 512 + ch * 8 + 4) = (f32x4){u[4], u[5], u[6], u[7]};
        if (r >= 8) { float* o = a.out + O_NCS + ((size_t)(l * DECB + b) * 30 + (r - 8)) * 512 + ch * 8;
            *(f32x4*)o = (f32x4){u[0], u[1], u[2], u[3]}; *(f32x4*)(o + 4) = (f32x4){u[4], u[5], u[6], u[7]}; } }
    __syncthreads();
    conv_compute<8>(a, l, U, red, stat, (size_t)NPTOK + b * DECT, tid, wave, lane);
    __syncthreads();
}

struct SsmLane { float ar, ai; float bzr[16], bzi[16]; bf16x8 cf[4]; f32x4 dv; float a256r, a256i; };
__device__ __forceinline__ void ssm_setup(const Args& a, int l, int g, int lane, SsmLane& S) {
    const int p = lane, lg = l * 32 + g;
    const double are = (double)a.in[I_ARE][lg * 64 + p], aim = (double)a.in[I_AIM][lg * 64 + p], dt = dexp_((double)a.in[I_LDT][lg]);
    const double mag = dexp_(are * dt); double sn, cs; dsincos_(aim * dt, sn, cs);
    const double abr = mag * cs, abi = mag * sn, den = are * are + aim * aim;
    const double zr = ((abr - 1.0) * are + abi * aim) / den, zi = (abi * are - (abr - 1.0) * aim) / den;
    S.ar = (float)abr; S.ai = (float)abi;
    double pr = abr, pi = abi;
#pragma unroll
    for (int i = 0; i < 8; ++i) { const double nr = pr * pr - pi * pi, ni = 2.0 * pr * pi; pr = nr; pi = ni; }
    S.a256r = (float)pr; S.a256i = (float)pi;
    const float* br = a.in[I_BRE] + (size_t)(lg * 64 + p) * 16; const float* bi = a.in[I_BIM] + (size_t)(lg * 64 + p) * 16;
    const float zrf = (float)zr, zif = (float)zi;
#pragma unroll
    for (int c = 0; c < 16; ++c) { const float x = br[c], y = bi[c]; S.bzr[c] = zrf * x - zif * y; S.bzi[c] = zrf * y + zif * x; }
    const int lr = lane & 15, q4 = lane >> 4;
#pragma unroll
    for (int ks = 0; ks < 4; ++ks) { const int k0 = (ks & 1) * 32 + 8 * q4; const float* src = (ks < 2 ? a.in[I_CRE] : a.in[I_CIM]) + (size_t)(lg * 16 + lr) * 64 + k0; const float sg = ks < 2 ? 1.f : -1.f;
        const f32x4 x0 = *(const f32x4*)src, x1 = *(const f32x4*)(src + 4);
        v4u w; w.x = pk2(sg * x0[0], sg * x0[1]); w.y = pk2(sg * x0[2], sg * x0[3]); w.z = pk2(sg * x1[0], sg * x1[1]); w.w = pk2(sg * x1[2], sg * x1[3]);
        S.cf[ks] = __builtin_bit_cast(bf16x8, w); }
    S.dv = *(const f32x4*)(a.in[I_SD] + l * 512 + g * 16 + 4 * q4);
}
__device__ __forceinline__ float gelu_tanh(float x) { const float z = 0.7978845608028654f * (x + 0.044715f * x * x * x); const float t = 1.f - 2.f / (__expf(2.f * z) + 1.f); return 0.5f * x * (1.f + t); }

template <bool PASS2>
__device__ __forceinline__ void ssm_run(const Args& a, const SsmLane& S, int g, size_t tok0, int nsub, int nvalid, float& hr, float& hi, LAS float* ubuf, LAS bf16* hbuf, int lane) {
    const bf16* P = (const bf16*)(a.ws + WS_P); bf16* YS = (bf16*)(a.ws + WS_YS);
    const int lr = lane & 15, q4 = lane >> 4, st_l = lane >> 2, c4 = (lane & 3) * 4;
#pragma nounroll
    for (int sub = 0; sub < nsub; ++sub) {
        { f32x4 uv = (f32x4){0.f, 0.f, 0.f, 0.f};
          if (st_l < nvalid) { const v2u w = *(const v2u*)(P + (tok0 + sub * 16 + st_l) * IN_DIM + C_XS + g * 16 + c4); uv = (f32x4){lo16(w.x), hi16(w.x), lo16(w.y), hi16(w.y)}; }
          *(LAS f32x4*)(ubuf + st_l * 16 + c4) = uv; }
        WAVE_SYNC();
#pragma unroll
        for (int st = 0; st < 16; ++st) {
            if (st < nvalid) {
                const f32x4 u0 = *(const LAS f32x4*)(ubuf + st * 16), u1 = *(const LAS f32x4*)(ubuf + st * 16 + 4), u2 = *(const LAS f32x4*)(ubuf + st * 16 + 8), u3 = *(const LAS f32x4*)(ubuf + st * 16 + 12);
                float xr = 0.f, xi = 0.f;
#pragma unroll
                for (int c = 0; c < 4; ++c) { xr = fmaf(S.bzr[c], u0[c], xr); xi = fmaf(S.bzi[c], u0[c], xi); }
#pragma unroll
                for (int c = 0; c < 4; ++c) { xr = fmaf(S.bzr[4 + c], u1[c], xr); xi = fmaf(S.bzi[4 + c], u1[c], xi); }
#pragma unroll
                for (int c = 0; c < 4; ++c) { xr = fmaf(S.bzr[8 + c], u2[c], xr); xi = fmaf(S.bzi[8 + c], u2[c], xi); }
#pragma unroll
                for (int c = 0; c < 4; ++c) { xr = fmaf(S.bzr[12 + c], u3[c], xr); xi = fmaf(S.bzi[12 + c], u3[c], xi); }
                const float nr = fmaf(S.ar, hr, fmaf(-S.ai, hi, xr)), ni = fmaf(S.ar, hi, fmaf(S.ai, hr, xi));
                hr = nr; hi = ni;
            }
            if (PASS2) { hbuf[st * 136 + lane] = (bf16)f2bf(hr); hbuf[st * 136 + 64 + lane] = (bf16)f2bf(hi); }
            if ((st & 3) == 3) __builtin_amdgcn_sched_barrier(0);
        }
        if (PASS2) {
            WAVE_SYNC();
            f32x4 acc = (f32x4){0.f, 0.f, 0.f, 0.f};
#pragma unroll
            for (int ks = 0; ks < 4; ++ks) { const bf16x8 hb = *(const LAS bf16x8*)(hbuf + lr * 136 + 32 * ks + 8 * q4); acc = __builtin_amdgcn_mfma_f32_16x16x32_bf16(S.cf[ks], hb, acc, 0, 0, 0); }
            const f32x4 uv = *(const LAS f32x4*)(ubuf + lr * 16 + 4 * q4);
            if (lr < nvalid) { f32x4 yv = acc + S.dv * uv; v2u w; w.x = pk2(gelu_tanh(yv[0]), gelu_tanh(yv[1])); w.y = pk2(gelu_tanh(yv[2]), gelu_tanh(yv[3]));
                *(v2u*)(YS + (tok0 + sub * 16 + lr) * 512 + g * 16 + 4 * q4) = w; }
        }
        WAVE_SYNC();
    }
}
__device__ __forceinline__ void ssm_prompt_item(const Args& a, int l, int item, LAS unsigned char* lds) {
    int tid_o = threadIdx.x; asm volatile("" : "+v"(tid_o)); const int tid = tid_o, lane = tid & 63, wave = __builtin_amdgcn_readfirstlane(tid >> 6); (void)lane; (void)wave;
    const int g = item & 31, b = item >> 5;
    LAS float* ubuf = (LAS float*)(lds + wave * 5632); LAS bf16* hbuf = (LAS bf16*)(lds + wave * 5632 + 1024); LAS float* ex = (LAS float*)(lds + 8 * 5632);
    SsmLane S; ssm_setup(a, l, g, lane, S);
    const size_t tok0 = (size_t)b * SEQ + 256 * wave;
    float hr = 0.f, hi = 0.f;
    ssm_run<false>(a, S, g, tok0, 16, 16, hr, hi, ubuf, hbuf, lane);
    ex[(wave * 64 + lane) * 2] = hr; ex[(wave * 64 + lane) * 2 + 1] = hi;
    __syncthreads();
    hr = 0.f; hi = 0.f;
    for (int j = 0; j < wave; ++j) { const float er = ex[(j * 64 + lane) * 2], ei = ex[(j * 64 + lane) * 2 + 1]; const float nr = S.a256r * hr - S.a256i * hi + er, ni = S.a256r * hi + S.a256i * hr + ei; hr = nr; hi = ni; }
    ssm_run<true>(a, S, g, tok0, 16, 16, hr, hi, ubuf, hbuf, lane);
    if (wave == 7) { a.out[O_NRP + (size_t)((l * NB + b) * 32 + g) * 64 + lane] = hr; a.out[O_NIP + (size_t)((l * NB + b) * 32 + g) * 64 + lane] = hi; }
    __syncthreads();
}
__device__ __forceinline__ void ssm_sample_item(const Args& a, int l, int item, LAS unsigned char* lds) {
    int tid_o = threadIdx.x; asm volatile("" : "+v"(tid_o)); const int tid = tid_o, lane = tid & 63, wave = __builtin_amdgcn_readfirstlane(tid >> 6); (void)lane; (void)wave;
    const int g = item & 31, bg = item >> 5;
    LAS float* ubuf = (LAS float*)(lds + wave * 5632); LAS bf16* hbuf = (LAS bf16*)(lds + wave * 5632 + 1024);
    SsmLane S; ssm_setup(a, l, g, lane, S);
    for (int bb = 0; bb < 2; ++bb) {
        const int bs = bg * 16 + wave * 2 + bb; const size_t so = (size_t)((l * DECB + bs) * 32 + g) * 64 + lane;
        float hr = a.in[I_SRE][so], hi = a.in[I_SIM][so];
        ssm_run<true>(a, S, g, (size_t)NPTOK + bs * DECT, 1, 8, hr, hi, ubuf, hbuf, lane);
        a.out[O_NRS + so] = hr; a.out[O_NIS + so] = hi;
    }
    __syncthreads();
}

__device__ __forceinline__ void mixer_phase(const Args& a, int l, LAS unsigned char* lds) {
    for (int it = blockIdx.x; it < 1280; it += gridDim.x) {
        if (0) {}
#ifndef NO_SSMP
        else if (it < 128) ssm_prompt_item(a, l, it, lds);
#endif
#ifndef NO_ATTP
        else if (it < 384) attn_prompt_item(a, l, it - 128, lds);
#endif
#ifndef NO_CONVP
        else if (it < 640) conv_prompt_item(a, l, it - 384, lds);
#endif
#ifndef NO_ATTS
        else if (it < 896) attn_sample_item(a, l, it - 640, lds);
#endif
#ifndef NO_SSMS
        else if (it < 1152) ssm_sample_item(a, l, it - 896, lds);
#endif
#ifndef NO_CONVS
        else if (it < 1280) conv_sample_item(a, l, it - 1152, lds);
#endif
    }
}

#define IN(k) (lo <= (k) && (k) < hi)
#define SEAM(k) do { if (IN(k) && IN((k) + 1)) grid.sync(); } while (0)
#define GEMM(EPI, E, Aptr, Bptr, M_, N_, K_) do { pg8::Gemm g_{(const pg8::bf16_t*)(Aptr), (const pg8::bf16_t*)(Bptr), M_, N_, K_}; pg8::StaticOrder S_; S_.init(M_, N_, G, (int)blockIdx.x); \
        pg8::gemm_phase<EPI, pg8::StaticOrder, true, true>(lds, g_, S_, E); } while (0)
template <int l>
__device__ __forceinline__ void layer_phases(const Args& a, LAS unsigned char* lds, cg::grid_group& grid, int lo, int hi) {
    const int G = gridDim.x; float* Y = a.out + O_Y;
        const int pb = 2 + 9 * l;
        int tid_l = threadIdx.x; asm volatile("" : "+v"(tid_l));
        unsigned char* ws = a.ws; asm volatile("" : "+s"(ws));
        const int tid = tid_l, lane = tid & 63, wave = __builtin_amdgcn_readfirstlane(tid >> 6), gw = blockIdx.x * 8 + wave, gtid = blockIdx.x * 512 + tid;
        float* mod = (float*)(ws + WS_MOD); bf16* Hb = (bf16*)(ws + WS_H); bf16* Pb = (bf16*)(ws + WS_P); float* MG = (float*)(ws + WS_MG); float* Xb = (float*)(ws + WS_X);
        const unsigned char* wl = ws + WS_WL + (size_t)l * WL_STRIDE;
        const float* xp = l == 0 ? a.in[I_XP] : Xb; const float* xs = l == 0 ? a.in[I_XS] : Xb + (size_t)NPTOK * DM;
        float* xout = l == 0 ? Xb : Y;
#ifndef NO_NORM
        if (IN(pb + 0)) norm_mod_phase(xp, xs, a.in[I_NORM1] + l * DM, mod, l, 0, Hb);
#endif
        SEAM(pb + 0);
#ifndef NO_G1
        if (IN(pb + 1)) { pg8::EpiP E{Pb}; GEMM(pg8::EpiP, E, Hb, wl + WL_IN, NTOK, IN_DIM, DM); }
#endif
        SEAM(pb + 1);
#ifndef NO_PREP
        if (IN(pb + 2)) qk_prep_phase(a, l);
#endif
        SEAM(pb + 2);
#ifndef NO_MIX
        if (IN(pb + 3)) mixer_phase(a, l, lds);
#endif
        SEAM(pb + 3);
#ifndef NO_MERGE
        if (IN(pb + 4)) {
            { pg8::EpiStoreF32 E{MG}; GEMM(pg8::EpiStoreF32, E, ws + WS_YS, wl + WL_GA, NTOK, DM, 512); }
            { pg8::EpiGluB E{MG, Pb}; GEMM(pg8::EpiGluB, E, ws + WS_YS, wl + WL_GB, NTOK, DM, 512); }
            { pg8::EpiAccG E{MG, Pb, 0}; GEMM(pg8::EpiAccG, E, ws + WS_O, wl + WL_O, NTOK, DM, 1024); }
            { pg8::EpiMergeFinal E{MG, Pb, Hb, 1}; GEMM(pg8::EpiMergeFinal, E, ws + WS_YC, wl + WL_CO, NTOK, DM, 512); }
        }
#endif
        SEAM(pb + 4);
#ifndef NO_REST
        if (IN(pb + 5)) { pg8::EpiResid E{xp, xs, mod + l * ADA_N + 2 * DM, Y}; GEMM(pg8::EpiResid, E, Hb, wl + WL_OUT, NTOK, DM, DM); }
        SEAM(pb + 5);
        if (IN(pb + 6)) norm_mod_phase(Y, Y + (size_t)NPTOK * DM, a.in[I_NORM2] + l * DM, mod, l, 1, Hb);
        SEAM(pb + 6);
        if (IN(pb + 7)) { pg8::EpiRelu2 E{Pb}; GEMM(pg8::EpiRelu2, E, Hb, wl + WL_F1, NTOK, FF, DM); }
        SEAM(pb + 7);
        if (IN(pb + 8)) { pg8::EpiResid E{Y, Y + (size_t)NPTOK * DM, mod + l * ADA_N + 5 * DM, xout}; GEMM(pg8::EpiResid, E, Pb, wl + WL_F2, NTOK, DM, FF); }
#endif
        SEAM(pb + 8);
}

__global__ void __launch_bounds__(512, 2) hybrid_fwd(Args a) {
    extern __shared__ __attribute__((aligned(16))) unsigned char lds_raw[];
    LAS unsigned char* lds = (LAS unsigned char*)lds_raw;
    cg::grid_group grid = cg::this_grid();
    const int tid = threadIdx.x, lane = tid & 63, wave = __builtin_amdgcn_readfirstlane(tid >> 6);
    const int G = gridDim.x, gw = blockIdx.x * 8 + wave, NGW = G * 8, gtid = blockIdx.x * 512 + tid, NGT = G * 512;
    unsigned char* ws = a.ws;
    const int lo = a.ph_lo, hi = a.ph_hi;
    float* mod = (float*)(ws + WS_MOD);
    bf16* Hb = (bf16*)(ws + WS_H); bf16* Pb = (bf16*)(ws + WS_P); float* MG = (float*)(ws + WS_MG); float* Xb = (float*)(ws + WS_X);
    float* Y = a.out + O_Y;
#ifndef NO_P0
    if (IN(0)) { p0_prologue(a, lds, gw, NGW, lane, wave, gtid, NGT); __syncthreads(); }
#endif
    SEAM(0);
#ifndef NO_ADA
    if (IN(1)) { pg8::EpiAda E{mod, a.in[I_BADA]}; GEMM(pg8::EpiAda, E, ws + WS_AC, ws + WS_WADA, 256, 2 * ADA_N, DM); }
#endif
    SEAM(1);
    layer_phases<0>(a, lds, grid, lo, hi);
    layer_phases<1>(a, lds, grid, lo, hi);
#undef IN
#undef SEAM
#undef GEMM
}

extern "C" void kernel_launch(void* const* d_in, const int* in_sizes, int n_in, void* d_out, int out_size, void* d_ws, size_t ws_size, hipStream_t stream) {
    static int grid = 0;
    if (grid == 0) {
        if (n_in != 36 || (size_t)out_size != O_END || ws_size < WS_END) { fprintf(stderr, "kernel_launch: unexpected sizes n_in %d out %d ws %zu (need %zu)\n", n_in, out_size, ws_size, (size_t)WS_END); grid = -1; return; }
        int dev = 0, cus = 0, per_cu = 0;
        (void)hipGetDevice(&dev); (void)hipDeviceGetAttribute(&cus, hipDeviceAttributeMultiprocessorCount, dev);
        if (hipFuncSetAttribute((const void*)hybrid_fwd, hipFuncAttributeMaxDynamicSharedMemorySize, LDS_BYTES) != hipSuccess) { fprintf(stderr, "kernel_launch: hipFuncSetAttribute failed\n"); grid = -1; return; }
        if (hipOccupancyMaxActiveBlocksPerMultiprocessor(&per_cu, (const void*)hybrid_fwd, 512, LDS_BYTES) != hipSuccess || per_cu < 1) { fprintf(stderr, "kernel_launch: occupancy query failed (%d)\n", per_cu); per_cu = 1; }
        (void)hipGetLastError();
        if (per_cu > 1) per_cu = 1;
        grid = cus * per_cu;
        fprintf(stderr, "kernel_launch: grid %d (cus %d)\n", grid, cus);
    }
    if (grid < 0) return;
    Args a{};
    for (int i = 0; i < 36; ++i) a.in[i] = (const float*)d_in[i];
    a.out = (float*)d_out; a.ws = (unsigned char*)d_ws;
#if MK_ONE_LAUNCH
    a.ph_lo = 0; a.ph_hi = NPHASE;
    void* args[] = {&a};
    hipError_t e = hipLaunchCooperativeKernel((const void*)hybrid_fwd, dim3(grid), dim3(512), args, LDS_BYTES, stream);
    if (e != hipSuccess) fprintf(stderr, "kernel_launch: cooperative launch failed: %s (grid %d)\n", hipGetErrorString(e), grid);
#else
    for (int k = 0; k < NPHASE; ++k) { a.ph_lo = k; a.ph_hi = k + 1; hipLaunchKernelGGL(hybrid_fwd, dim3(grid), dim3(512), LDS_BYTES, stream, a); }
#endif
}
```

```cpp
#include <hip/hip_runtime.h>
#include <hip/hip_cooperative_groups.h>
#include <cstdio>
#include <cstdint>
namespace cg = cooperative_groups;
namespace pg8 {
#define PG8_LAS __attribute__((address_space(3)))
typedef unsigned short bf16_t;
typedef short bf16x8 __attribute__((ext_vector_type(8)));
typedef float f32x4 __attribute__((ext_vector_type(4)));
typedef unsigned u32x4 __attribute__((ext_vector_type(4)));
constexpr int BM = 256, BK = 64, HALF = 128, HTB = HALF * BK * 2  , STAGE_BYTES = 8 * HTB, NXCD = 8, WGM = 8;

__host__ __device__ __forceinline__ int lds_byte(int r, int c) { const int st = (r >> 4) * 2 + (c >> 5), rr = r & 15, cc = c & 31, ob = rr * 64 + cc * 2; return st * 1024 + (ob ^ (((ob >> 9) & 1) << 5)); }
__host__ __device__ __forceinline__ void stage_rc(int b, int& R, int& C) { const int st = b / 1024, sb = b % 1024, swz = sb ^ (((sb >> 9) & 1) << 5); R = (st >> 1) * 16 + swz / 64; C = (st & 1) * 32 + (swz % 64) / 2; }
__host__ __device__ __forceinline__ int perm32(int rho) { const int n = rho >> 4, i = rho & 15; return 8 * (i >> 2) + 4 * n + (i & 3); }

struct Unit { int pm, pn, k0, nt, tail, part, seg; };
struct Gemm { const bf16_t* A; const bf16_t* Bt; int M, N, K; };

struct HybridOrder {
    int nM, nN, nwg, G, c, R, ntail, S, ntk, npart, segk; float* slots; unsigned* cnt;
    __device__ void init(int M, int N, int K, int G_, int c_, int S_, float* slots_, unsigned* cnt_) { nM = M / BM; nN = N / BM; nwg = nM * nN; G = G_; c = c_; R = nwg / G; ntail = nwg - R * G;
        S = S_; ntk = K / BK; npart = ntk / S; slots = slots_; cnt = cnt_; segk = 0; }
    __device__ void tile_of(int L, Unit& u) const {
        int wgid = L; { const int q = nwg / NXCD, r = nwg % NXCD, xcd = wgid % NXCD, off = wgid / NXCD; wgid = (xcd < r ? xcd * (q + 1) : r * (q + 1) + (xcd - r) * q) + off; }
        const int nig = WGM * nN, gid = wgid / nig, fm = gid * WGM, gsz = (nM - fm) < WGM ? (nM - fm) : WGM;
        u.pm = fm + ((wgid % nig) % gsz); u.pn = (wgid % nig) / gsz;
    }
    __device__ bool next(int i2, Unit& u) const {
        const int i = segk ? (i2 >> 1) : i2, sg = segk ? (i2 & 1) : 0;
        u.seg = 0;
        if (i < R) { tile_of(i * G + c, u); u.k0 = 0; u.nt = ntk; u.tail = -1; u.part = 0; }
        else if (i == R && c < ntail * S) { const int j = c % ntail, p = c / ntail; tile_of(R * G + j, u); u.k0 = p * npart; u.nt = npart; u.tail = S > 1 ? j : -1; u.part = p; }
        else return false;
        if (segk) { if (sg == 0) { u.nt = segk; u.seg = 1; } else { u.k0 = segk; u.nt = ntk - segk; } }
        return true;
    }
    __device__ __forceinline__ void a_ready(const Unit&) const {}
    __device__ __forceinline__ void done(const Unit&) const {}
};

__device__ __forceinline__ unsigned cvt_pk_bf16(float lo, float hi) { unsigned r; asm volatile("v_cvt_pk_bf16_f32 %0, %1, %2" : "=v"(r) : "v"(lo), "v"(hi)); return r; }
typedef float f32x2 __attribute__((ext_vector_type(2)));
template <int NS, class Sched>
__device__ __forceinline__ unsigned tail_exchange_t(f32x4 (&acc)[2][2][4][2], const Unit& u, const Sched& S, int tid) {
    constexpr int RS = 32 / NS; const int part = u.part;
    float* base = S.slots + (size_t)(u.tail * NS) * 65536 + tid * 4;
    float* mine = base + (size_t)part * 65536;
#pragma unroll
    for (int ai = 0; ai < 2; ++ai)
#pragma unroll
        for (int m = 0; m < 4; ++m)
#pragma unroll
            for (int bj = 0; bj < 2; ++bj)
#pragma unroll
                for (int n = 0; n < 2; ++n) { const int r = ((ai * 4 + m) * 2 + bj) * 2 + n; const f32x4 v = acc[ai][bj][m][n]; const float* q = mine + r * 2048;
                    asm volatile("global_store_dwordx4 %0, %1, off sc1" :: "v"(q), "v"(v) : "memory"); }
    asm volatile("s_waitcnt vmcnt(0)" ::: "memory");
    __builtin_amdgcn_s_barrier();
    if (tid == 0) { unsigned* cw = S.cnt + u.tail * 16; __hip_atomic_fetch_add(cw, 1u, __ATOMIC_RELAXED, __HIP_MEMORY_SCOPE_AGENT);
        unsigned sp = 0; while (__hip_atomic_load(cw, __ATOMIC_RELAXED, __HIP_MEMORY_SCOPE_AGENT) < (unsigned)NS) { __builtin_amdgcn_s_sleep(2); if (++sp > (1u << 22)) break; } }
    asm volatile("s_waitcnt vmcnt(0) lgkmcnt(0)" ::: "memory");
    __builtin_amdgcn_s_barrier();
    asm volatile("" ::: "memory");
#pragma unroll
    for (int ai = 0; ai < 2; ++ai)
#pragma unroll
        for (int m = 0; m < 4; ++m)
#pragma unroll
            for (int bj = 0; bj < 2; ++bj)
#pragma unroll
                for (int n = 0; n < 2; ++n) { const int r = ((ai * 4 + m) * 2 + bj) * 2 + n;
                    if (r / RS == part) { f32x4 pv[NS];
#pragma unroll
                        for (int pp = 0; pp < NS; ++pp) { const float* q = base + (size_t)pp * 65536 + r * 2048; asm volatile("global_load_dwordx4 %0, %1, off sc1" : "=v"(pv[pp]) : "v"(q) : "memory"); }
                        if constexpr (NS == 16) asm volatile("s_waitcnt vmcnt(0)" : "+v"(pv[0]), "+v"(pv[1]), "+v"(pv[2]), "+v"(pv[3]), "+v"(pv[4]), "+v"(pv[5]), "+v"(pv[6]), "+v"(pv[7]), "+v"(pv[8 % NS]), "+v"(pv[9 % NS]), "+v"(pv[10 % NS]), "+v"(pv[11 % NS]), "+v"(pv[12 % NS]), "+v"(pv[13 % NS]), "+v"(pv[14 % NS]), "+v"(pv[15 % NS]) :: "memory");
                        else if constexpr (NS == 8) asm volatile("s_waitcnt vmcnt(0)" : "+v"(pv[0]), "+v"(pv[1]), "+v"(pv[2 % NS]), "+v"(pv[3 % NS]), "+v"(pv[4 % NS]), "+v"(pv[5 % NS]), "+v"(pv[6 % NS]), "+v"(pv[7 % NS]) :: "memory");
                        else if constexpr (NS == 4) asm volatile("s_waitcnt vmcnt(0)" : "+v"(pv[0]), "+v"(pv[1]), "+v"(pv[2 % NS]), "+v"(pv[3 % NS]) :: "memory");
                        else asm volatile("s_waitcnt vmcnt(0)" : "+v"(pv[0]), "+v"(pv[1]) :: "memory");
                        f32x4 s = pv[0];
#pragma unroll
                        for (int pp = 1; pp < NS; ++pp) s += pv[pp];
                        acc[ai][bj][m][n] = s; } }
    return (RS >= 32 ? 0xffffffffu : ((1u << RS) - 1u)) << (part * RS);
}
template <class Sched>
__device__ __forceinline__ unsigned tail_exchange(f32x4 (&acc)[2][2][4][2], const Unit& u, const Sched& S, int tid) {
    if (S.S == 8) return tail_exchange_t<8>(acc, u, S, tid);
    if (S.S == 16) return tail_exchange_t<16>(acc, u, S, tid);
    if (S.S == 2) return tail_exchange_t<2>(acc, u, S, tid);
    return tail_exchange_t<4>(acc, u, S, tid);
}
template <class Epi, class Sched, bool ALIGN_EPI = false, bool SP2 = false>
__device__ __forceinline__ void gemm_phase(PG8_LAS unsigned char* lds, const Gemm g, const Sched& S, const Epi& E) {
    int tid_ = threadIdx.x; asm volatile("" : "+v"(tid_));
    const int tid = tid_, wid = __builtin_amdgcn_readfirstlane(tid >> 6), lane = tid & 63, wr = wid >> 2, wc = wid & 3, fr = lane & 15, fq = lane >> 4;
    const int K = g.K;
    unsigned voffA[2], voffB[2];
#pragma unroll
    for (int i = 0; i < 2; ++i) { int R, C; stage_rc(tid * 16 + i * 8192, R, C); const int Rb = Epi::PERM ? ((R & ~31) + perm32(R & 31)) : R;
        voffA[i] = (unsigned)(R * K + C) * 2u; voffB[i] = (unsigned)(Rb * K + C) * 2u; }
    const size_t kstep = (size_t)(BK * 2);
    const size_t hstep = (size_t)HALF * K * 2;
    const size_t tstep = 2 * hstep;
    const unsigned ldsw = (unsigned)wid * 1024u;
    const int aoff = lds_byte(wr * 64 + fr, fq * 8), boff = lds_byte(wc * 32 + fr, fq * 8);
#define PG8_SA(b, h) (((b) * 2 + (h)) * HTB)
#define PG8_SB(b, h) ((4 + (b) * 2 + (h)) * HTB)
#define PG8_STAGE(bufoff, gbase, voff) do { _Pragma("unroll") for (int _i = 0; _i < 2; ++_i) \
        __builtin_amdgcn_global_load_lds((const unsigned*)((const char*)(gbase) + (voff)[_i]), (PG8_LAS unsigned*)(lds + (bufoff) + ldsw + _i * 8192), 16, 0, 0); } while (0)
#define PG8_LDA(dst, b, h) do { _Pragma("unroll") for (int m = 0; m < 4; ++m) _Pragma("unroll") for (int k = 0; k < 2; ++k) dst[m][k] = *(const PG8_LAS bf16x8*)(lds + PG8_SA(b, h) + aoff + m * 2048 + k * 1024); } while (0)
#define PG8_LDB(dst, b, h) do { _Pragma("unroll") for (int n = 0; n < 2; ++n) _Pragma("unroll") for (int k = 0; k < 2; ++k) dst[n][k] = *(const PG8_LAS bf16x8*)(lds + PG8_SB(b, h) + boff + n * 2048 + k * 1024); } while (0)
#define PG8_MMA(ai, bj, At, Bt) do { __builtin_amdgcn_s_setprio(1); _Pragma("unroll") for (int m = 0; m < 4; ++m) _Pragma("unroll") for (int n = 0; n < 2; ++n) _Pragma("unroll") for (int k = 0; k < 2; ++k) \
        acc[ai][bj][m][n] = __builtin_amdgcn_mfma_f32_16x16x32_bf16(Bt[n][k], At[m][k], acc[ai][bj][m][n], 0, 0, 0); __builtin_amdgcn_s_setprio(0); } while (0)
#define PG8_WAIT_V(n) asm volatile("s_waitcnt vmcnt(" #n ")" ::: "memory")
#define PG8_WAIT_L(n) asm volatile("s_waitcnt lgkmcnt(" #n ")" ::: "memory")
#define PG8_BAR __builtin_amdgcn_s_barrier()
#define PG8_SCHED __builtin_amdgcn_sched_barrier(0)
    Unit cur, nxt; int ui = 0;
    if (!S.next(0, cur)) return;
    f32x4 acc[2][2][4][2];
#pragma unroll
    for (int a = 0; a < 2; ++a)
#pragma unroll
        for (int b = 0; b < 2; ++b)
#pragma unroll
            for (int m = 0; m < 4; ++m)
#pragma unroll
                for (int n = 0; n < 2; ++n) acc[a][b][m][n] = (f32x4){0.f, 0.f, 0.f, 0.f};
    bf16x8 At[4][2], B0[2][2], B1[2][2];
    const char* cA = (const char*)g.A + (size_t)cur.pm * tstep + (size_t)cur.k0 * kstep; const char* cB = (const char*)g.Bt + (size_t)cur.pn * tstep + (size_t)cur.k0 * kstep;
    S.a_ready(cur);
    if constexpr (SP2) {
        PG8_STAGE(PG8_SB(0, 0), cB, voffB); PG8_STAGE(PG8_SB(0, 1), cB + hstep, voffB); PG8_STAGE(PG8_SA(0, 0), cA, voffA); PG8_STAGE(PG8_SA(0, 1), cA + hstep, voffA);
        if (wr == 1) PG8_BAR;
        PG8_WAIT_V(2); PG8_BAR;
        PG8_STAGE(PG8_SB(1, 0), cB + kstep, voffB); PG8_STAGE(PG8_SA(1, 0), cA + kstep, voffA); PG8_STAGE(PG8_SB(1, 1), cB + hstep + kstep, voffB);
        PG8_WAIT_V(6); PG8_BAR;
    } else {
        PG8_STAGE(PG8_SB(0, 0), cB, voffB); PG8_STAGE(PG8_SA(0, 0), cA, voffA); PG8_STAGE(PG8_SB(0, 1), cB + hstep, voffB); PG8_STAGE(PG8_SA(0, 1), cA + hstep, voffA);
        if (wr == 1) PG8_BAR;
        PG8_WAIT_V(4); PG8_BAR;
        PG8_STAGE(PG8_SB(1, 0), cB + kstep, voffB); PG8_STAGE(PG8_SA(1, 0), cA + kstep, voffA); PG8_STAGE(PG8_SB(1, 1), cB + hstep + kstep, voffB);
        PG8_WAIT_V(6); PG8_BAR;
    }
    for (;;) {
        const bool has_next = S.next(ui + 1, nxt);
        const char* nA = has_next ? (const char*)g.A + (size_t)nxt.pm * tstep + (size_t)nxt.k0 * kstep : cA; const char* nB = has_next ? (const char*)g.Bt + (size_t)nxt.pn * tstep + (size_t)nxt.k0 * kstep : cB;
        const int nt = cur.nt;
        for (int t = 0; t < nt; t += 2) {
            const bool last = (t == nt - 2);
            const char* a1 = cA + (size_t)(t + 1) * kstep;
            const char* a2 = last ? nA : cA + (size_t)(t + 2) * kstep; const char* b2 = last ? nB : cB + (size_t)(t + 2) * kstep;
            const char* a3 = a2 + kstep; const char* b3 = b2 + kstep;
            if (last && has_next) S.a_ready(nxt);
            if constexpr (SP2) {
            PG8_LDB(B0, 0, 0); PG8_LDB(B1, 0, 1); PG8_SCHED; PG8_LDA(At, 0, 0); PG8_STAGE(PG8_SA(1, 1), a1 + hstep, voffA);
            PG8_WAIT_V(8); PG8_WAIT_L(0); PG8_BAR; PG8_MMA(0, 0, At, B0); PG8_MMA(0, 1, At, B1); PG8_BAR; PG8_SCHED;
            PG8_LDA(At, 0, 1); PG8_STAGE(PG8_SB(0, 0), b2, voffB); PG8_STAGE(PG8_SB(0, 1), b2 + hstep, voffB); PG8_STAGE(PG8_SA(0, 0), a2, voffA);
            PG8_WAIT_V(8); PG8_WAIT_L(0); PG8_BAR; PG8_MMA(1, 0, At, B0); PG8_MMA(1, 1, At, B1); PG8_BAR; PG8_SCHED;
            PG8_LDB(B0, 1, 0); PG8_LDB(B1, 1, 1); PG8_SCHED; PG8_LDA(At, 1, 0); PG8_STAGE(PG8_SA(0, 1), a2 + hstep, voffA);
            PG8_WAIT_V(8); PG8_WAIT_L(0); PG8_BAR; PG8_MMA(0, 0, At, B0); PG8_MMA(0, 1, At, B1); PG8_BAR; PG8_SCHED;
            PG8_LDA(At, 1, 1); PG8_STAGE(PG8_SB(1, 0), b3, voffB); PG8_STAGE(PG8_SB(1, 1), b3 + hstep, voffB); PG8_STAGE(PG8_SA(1, 0), a3, voffA);
            PG8_WAIT_V(8); PG8_WAIT_L(0); PG8_BAR; PG8_MMA(1, 0, At, B0); PG8_MMA(1, 1, At, B1); PG8_BAR; PG8_SCHED;
            } else {
            PG8_LDB(B0, 0, 0); PG8_SCHED; PG8_LDA(At, 0, 0); PG8_STAGE(PG8_SA(1, 1), a1 + hstep, voffA);
            PG8_WAIT_L(8); PG8_BAR; PG8_WAIT_L(0); PG8_MMA(0, 0, At, B0); PG8_BAR; PG8_SCHED;
            PG8_LDB(B1, 0, 1); PG8_STAGE(PG8_SB(0, 0), b2, voffB);
            PG8_BAR; PG8_WAIT_L(0); PG8_MMA(0, 1, At, B1); PG8_BAR;
            PG8_LDA(At, 0, 1); PG8_STAGE(PG8_SA(0, 0), a2, voffA);
            PG8_BAR; PG8_WAIT_L(0); PG8_MMA(1, 0, At, B0); PG8_BAR; PG8_SCHED;
            PG8_STAGE(PG8_SB(0, 1), b2 + hstep, voffB);
            PG8_WAIT_V(6); PG8_BAR; PG8_MMA(1, 1, At, B1); PG8_BAR;
            PG8_LDB(B0, 1, 0); PG8_SCHED; PG8_LDA(At, 1, 0); PG8_STAGE(PG8_SA(0, 1), a2 + hstep, voffA);
            PG8_WAIT_L(8); PG8_BAR; PG8_WAIT_L(0); PG8_MMA(0, 0, At, B0); PG8_BAR; PG8_SCHED;
            PG8_LDB(B1, 1, 1); PG8_STAGE(PG8_SB(1, 0), b3, voffB);
            PG8_BAR; PG8_WAIT_L(0); PG8_MMA(0, 1, At, B1); PG8_BAR;
            PG8_LDA(At, 1, 1); PG8_STAGE(PG8_SA(1, 0), a3, voffA);
            PG8_BAR; PG8_WAIT_L(0); PG8_MMA(1, 0, At, B0); PG8_BAR; PG8_SCHED;
            PG8_STAGE(PG8_SB(1, 1), b3 + hstep, voffB);
            PG8_WAIT_V(6); PG8_BAR; PG8_MMA(1, 1, At, B1); PG8_BAR;
            }
        }
        if constexpr (ALIGN_EPI) { if (wr == 0) PG8_BAR; }
        if (cur.seg == 1) { if constexpr (Epi::MID_T > 0) E.mid(acc, cur, wr, wc, fr, fq); }
        else { unsigned rmask = 0xffffffffu; if (cur.tail >= 0) rmask = tail_exchange(acc, cur, S, tid); E(acc, cur, wr, wc, fr, fq, rmask); }
        if (!has_next) break;
        if (cur.seg != 1)
#pragma unroll
        for (int a = 0; a < 2; ++a)
#pragma unroll
            for (int b = 0; b < 2; ++b)
#pragma unroll
                for (int m = 0; m < 4; ++m)
#pragma unroll
                    for (int n = 0; n < 2; ++n) acc[a][b][m][n] = (f32x4){0.f, 0.f, 0.f, 0.f};
        cur = nxt; cA = nA; cB = nB; ++ui;
        if constexpr (ALIGN_EPI) { if (wr == 1) PG8_BAR; }
    }
    PG8_WAIT_V(0);
    if constexpr (!ALIGN_EPI) { if (wr == 0) PG8_BAR; }
    PG8_BAR;
#undef PG8_SA
#undef PG8_SB
#undef PG8_STAGE
#undef PG8_LDA
#undef PG8_LDB
#undef PG8_MMA
#undef PG8_WAIT_V
#undef PG8_WAIT_L
#undef PG8_BAR
#undef PG8_SCHED
}
}

#define LAS __attribute__((address_space(3)))
typedef unsigned short bf16;
typedef unsigned v4u __attribute__((ext_vector_type(4)));
typedef unsigned v2u __attribute__((ext_vector_type(2)));
typedef float f32x4 __attribute__((ext_vector_type(4)));
typedef float f32x2 __attribute__((ext_vector_type(2)));
typedef short bf16x8 __attribute__((ext_vector_type(8)));
typedef short s16x4 __attribute__((ext_vector_type(4)));

#ifndef MK_ONE_LAUNCH
#define MK_ONE_LAUNCH 1
#endif

constexpr int DM = 2048, NTOK = 9216, NPTOK = 8192, SEQ = 2048, NB = 4, DECB = 128, DECT = 8;
constexpr int IN_DIM = 9216, FF = 8192, ADA_N = 12288;
constexpr int C_K = 1024, C_V = 1280, C_XA = 1536, C_XB = 2048, C_XS = 2560, C_G = 3072;
constexpr int NMODROW = 132;
constexpr int NPHASE = 20;
constexpr int SK_G1 = 16, SK_MG = 1, SK_WO = 8, SK_F1 = 2, SK_F2 = 8;

constexpr size_t MiB = 1u << 20;
constexpr size_t WS_CTL = 0, CTL_BYTES = 1 * MiB;
constexpr size_t WS_ROPE = 1 * MiB, WS_AC = 2 * MiB, WS_MOD = 3 * MiB, WS_WADA = 16 * MiB;
constexpr size_t WS_WL = 112 * MiB, WL_STRIDE = 118 * MiB;
constexpr size_t WL_IN = 0, WL_O = 36 * MiB, WL_CO = 40 * MiB, WL_GA = 42 * MiB, WL_GB = 44 * MiB, WL_OUT = 46 * MiB, WL_F1 = 54 * MiB, WL_F2 = 86 * MiB;
constexpr size_t WS_H = 348 * MiB;
constexpr size_t WS_P = 384 * MiB;
constexpr size_t WS_QN = 546 * MiB, WS_KN = 564 * MiB, WS_O = 569 * MiB, WS_YC = 587 * MiB, WS_YS = 596 * MiB;
constexpr size_t WS_MG = 605 * MiB;
constexpr size_t WS_X = 677 * MiB;
constexpr size_t WS_SLOT2 = 749 * MiB;
constexpr size_t WS_END = 781 * MiB;

constexpr size_t O_Y = 0;
constexpr size_t O_NKP = (size_t)NTOK * DM;
constexpr size_t O_NVP = O_NKP + 2 * 4 * 128 * 256;
constexpr size_t O_NCP = O_NVP + 2 * 4 * 128 * 256;
constexpr size_t O_NRP = O_NCP + 2 * 4 * 30 * 512;
constexpr size_t O_NIP = O_NRP + 2 * 4 * 32 * 64;
constexpr size_t O_NKS = O_NIP + 2 * 4 * 32 * 64;
constexpr size_t O_NVS = O_NKS + (size_t)2 * 128 * 128 * 256;
constexpr size_t O_NCS = O_NVS + (size_t)2 * 128 * 128 * 256;
constexpr size_t O_NRS = O_NCS + (size_t)2 * 128 * 30 * 512;
constexpr size_t O_NIS = O_NRS + (size_t)2 * 128 * 32 * 64;
constexpr size_t O_END = O_NIS + (size_t)2 * 128 * 32 * 64;

constexpr int LDS_BYTES = 135168;

struct Args { const float* in[36]; float* out; unsigned char* ws; int ph_lo, ph_hi; };

enum { I_XP = 0, I_XS, I_CP, I_CS, I_CK, I_CV, I_SCONV, I_SRE, I_SIM, I_WADA, I_BADA, I_NORM1, I_WIN, I_QN, I_KN, I_SINK, I_WO, I_CW, I_CB, I_CLG, I_CLB, I_WCO,
       I_ARE, I_AIM, I_LDT, I_BRE, I_BIM, I_CRE, I_CIM, I_SD, I_WGA, I_WGB, I_WOUT, I_NORM2, I_WF1, I_WF2 };

__device__ __forceinline__ float bf2f(unsigned b) { return __uint_as_float(b << 16); }
__device__ __forceinline__ unsigned f2bf(float f) { unsigned u = __float_as_uint(f); return (u + 0x7fffu + ((u >> 16) & 1u)) >> 16; }
__device__ __forceinline__ unsigned pk2(float lo, float hi) { return f2bf(lo) | (f2bf(hi) << 16); }
__device__ __forceinline__ float lo16(unsigned w) { return __uint_as_float(w << 16); }
__device__ __forceinline__ float hi16(unsigned w) { return __uint_as_float(w & 0xffff0000u); }
__device__ __forceinline__ float sigm(float x) { return 1.f / (1.f + __expf(-x)); }
__device__ __forceinline__ float wave_sum(float v) {
#pragma unroll
    for (int o = 1; o < 64; o <<= 1) v += __shfl_xor(v, o);
    return v;
}
#define LDS_WAIT() asm volatile("s_waitcnt lgkmcnt(0)" ::: "memory")
#define WAVE_SYNC() do { asm volatile("s_waitcnt lgkmcnt(0)" ::: "memory"); __builtin_amdgcn_wave_barrier(); asm volatile("" ::: "memory"); } while (0)

__device__ __forceinline__ double dexp_(double x) {
    const double kf = rint(x * 1.4426950408889634);
    double r = fma(-kf, 6.93147180369123816490e-01, x); r = fma(-kf, 1.90821492927058770002e-10, r);
    double p = 1.0 / 6227020800.0;
    p = fma(p, r, 1.0 / 479001600.0); p = fma(p, r, 1.0 / 39916800.0); p = fma(p, r, 1.0 / 3628800.0); p = fma(p, r, 1.0 / 362880.0);
    p = fma(p, r, 1.0 / 40320.0); p = fma(p, r, 1.0 / 5040.0); p = fma(p, r, 1.0 / 720.0); p = fma(p, r, 1.0 / 120.0);
    p = fma(p, r, 1.0 / 24.0); p = fma(p, r, 1.0 / 6.0); p = fma(p, r, 0.5); p = fma(p, r, 1.0); p = fma(p, r, 1.0);
    const long long k = (long long)kf;
    return p * __longlong_as_double((1023ll + k) << 52);
}
__device__ __forceinline__ void dsincos_(double x, double& sn, double& cs) {
    const double kf = rint(x * 0.15915494309189535);
    double r = fma(-kf, 6.283185307179586, x); r = fma(-kf, 2.4492935982947064e-16, r);
    const double s = r * 0.125, z = s * s;
    double ps = -1.0 / 355687428096000.0;
    ps = fma(ps, z, 1.0 / 1307674368000.0); ps = fma(ps, z, -1.0 / 6227020800.0); ps = fma(ps, z, 1.0 / 39916800.0); ps = fma(ps, z, -1.0 / 362880.0);
    ps = fma(ps, z, 1.0 / 5040.0); ps = fma(ps, z, -1.0 / 120.0); ps = fma(ps, z, 1.0 / 6.0);
    double a = s - s * z * ps;
    double pc = 1.0 / 20922789888000.0;
    pc = fma(pc, z, -1.0 / 87178291200.0); pc = fma(pc, z, 1.0 / 479001600.0); pc = fma(pc, z, -1.0 / 3628800.0); pc = fma(pc, z, 1.0 / 40320.0);
    pc = fma(pc, z, -1.0 / 720.0); pc = fma(pc, z, 1.0 / 24.0); pc = fma(pc, z, -0.5);
    double b = fma(pc, z, 1.0);
#pragma unroll
    for (int i = 0; i < 3; ++i) { const double a2 = 2.0 * a * b, b2 = 1.0 - 2.0 * a * a; a = a2; b = b2; }
    sn = a; cs = b;
}

namespace pg8 {
#define EPI_FOREACH4(...) \
    _Pragma("unroll") for (int ai = 0; ai < 2; ++ai) _Pragma("unroll") for (int m = 0; m < 4; ++m) { const int row = u.pm * BM + ai * HALF + wr * 64 + m * 16 + fr; \
    _Pragma("unroll") for (int bj = 0; bj < 2; ++bj) _Pragma("unroll") for (int n = 0; n < 2; ++n) { const int col = u.pn * BM + bj * HALF + wc * 32 + n * 16 + 4 * fq; const f32x4 v = acc[ai][bj][m][n]; if ((rmask >> (((ai * 4 + m) * 2 + bj) * 2 + n)) & 1u) { __VA_ARGS__ } } if (m & 1) { asm volatile("" ::: "memory"); __builtin_amdgcn_sched_barrier(0); } }
#define EPI_FOREACH8(...) \
    _Pragma("unroll") for (int ai = 0; ai < 2; ++ai) _Pragma("unroll") for (int m = 0; m < 4; ++m) { const int row = u.pm * BM + ai * HALF + wr * 64 + m * 16 + fr; \
    _Pragma("unroll") for (int bj = 0; bj < 2; ++bj) { const int col = u.pn * BM + bj * HALF + wc * 32 + 8 * fq; const f32x4 v0 = acc[ai][bj][m][0], v1 = acc[ai][bj][m][1]; if ((rmask >> (((ai * 4 + m) * 2 + bj) * 2)) & 1u) { __VA_ARGS__ } } if (m & 1) { asm volatile("" ::: "memory"); __builtin_amdgcn_sched_barrier(0); } }
#define EPI_SIG const f32x4 (&acc)[2][2][4][2], const Unit& u, int wr, int wc, int fr, int fq, unsigned rmask

__device__ __forceinline__ int mod_row(int row) { return row < NPTOK ? (row >> 11) : 4 + ((row - NPTOK) >> 3); }
__device__ __forceinline__ v4u pack8(const f32x4 a, const f32x4 b) { v4u w; w.x = cvt_pk_bf16(a[0], a[1]); w.y = cvt_pk_bf16(a[2], a[3]); w.z = cvt_pk_bf16(b[0], b[1]); w.w = cvt_pk_bf16(b[2], b[3]); return w; }

struct EpiAda {
    static constexpr bool PERM = false, AFTER_DRAIN = false; static constexpr int MID_T = -1; float* mod; const float* bias;
    __device__ __forceinline__ void operator()(EPI_SIG) const {
        EPI_FOREACH4( if (row < NMODROW) { const f32x4 bv = *(const f32x4*)(bias + col); *(f32x4*)(mod + row * (2 * ADA_N) + col) = v + bv; } )
    }
};
struct EpiP {
    static constexpr bool PERM = true, AFTER_DRAIN = false; static constexpr int MID_T = -1; bf16_t* P;
    __device__ __forceinline__ void operator()(EPI_SIG) const {
        const bool sg = (u.pn * BM) >= C_G;
        EPI_FOREACH8( f32x4 a = v0, b = v1; if (sg) {
            _Pragma("unroll") for (int i = 0; i < 4; ++i) { a[i] = sigm(a[i]); b[i] = sigm(b[i]); } }
            *(v4u*)(P + (unsigned)(row * IN_DIM + col)) = pack8(a, b); )
    }
};
struct EpiStoreF32 {
    static constexpr bool PERM = false, AFTER_DRAIN = false; static constexpr int MID_T = -1; float* MG;
    __device__ __forceinline__ void operator()(EPI_SIG) const { EPI_FOREACH4( *(f32x4*)(MG + (unsigned)(row * DM + col)) = v; ) }
};
__device__ __forceinline__ f32x4 gate4(const bf16_t* P, int row, int col, int br) {
    const v2u g = *(const v2u*)(P + (unsigned)(row * IN_DIM + C_G + br * DM + col)); return (f32x4){lo16(g.x), hi16(g.x), lo16(g.y), hi16(g.y)};
}
struct EpiGluB {
    static constexpr bool PERM = false, AFTER_DRAIN = false; static constexpr int MID_T = -1; float* MG; const bf16_t* P;
    __device__ __forceinline__ void operator()(EPI_SIG) const {
        EPI_FOREACH4( float* p = MG + (unsigned)(row * DM + col); const f32x4 a = *(const f32x4*)p; const f32x4 g = gate4(P, row, col, 2); f32x4 o;
            _Pragma("unroll") for (int i = 0; i < 4; ++i) o[i] = g[i] * a[i] * sigm(v[i]);
            *(f32x4*)p = o; )
    }
};
struct EpiAccG {
    static constexpr bool PERM = false, AFTER_DRAIN = false; static constexpr int MID_T = -1; float* MG; const bf16_t* P; int br;
    __device__ __forceinline__ void operator()(EPI_SIG) const {
        EPI_FOREACH4( float* p = MG + (unsigned)(row * DM + col); const f32x4 a = *(const f32x4*)p; const f32x4 g = gate4(P, row, col, br); *(f32x4*)p = a + g * v; )
    }
};
struct EpiMergeFinal {
    static constexpr bool PERM = false, AFTER_DRAIN = false; static constexpr int MID_T = -1; const float* MG; const bf16_t* P; bf16_t* MGb; int br;
    __device__ __forceinline__ void operator()(EPI_SIG) const {
        EPI_FOREACH4( const f32x4 a = *(const f32x4*)(MG + (unsigned)(row * DM + col)); const f32x4 g = gate4(P, row, col, br); const f32x4 o = a + g * v;
            v2u w; w.x = cvt_pk_bf16(o[0], o[1]); w.y = cvt_pk_bf16(o[2], o[3]); *(v2u*)(MGb + (unsigned)(row * DM + col)) = w; )
    }
};
struct EpiGlu {
    static constexpr bool PERM = false, AFTER_DRAIN = false; static constexpr int MID_T = -1; bf16_t* MGa; const bf16_t* P;
    __device__ __forceinline__ void operator()(EPI_SIG) const {
        _Pragma("unroll") for (int ai = 0; ai < 2; ++ai) _Pragma("unroll") for (int m = 0; m < 4; ++m) { const int row = u.pm * BM + ai * HALF + wr * 64 + m * 16 + fr;
            _Pragma("unroll") for (int bj = 0; bj < 2; ++bj) { if ((rmask >> (((ai * 4 + m) * 2 + bj) * 2)) & 1u) {
                const int j = u.pn * 128 + bj * 64 + wc * 16 + 4 * fq; const f32x4 av = acc[ai][bj][m][0], bv = acc[ai][bj][m][1]; const f32x4 g = gate4(P, row, j, 2); f32x4 o;
                _Pragma("unroll") for (int i = 0; i < 4; ++i) o[i] = g[i] * av[i] * sigm(bv[i]);
                v2u w; w.x = cvt_pk_bf16(o[0], o[1]); w.y = cvt_pk_bf16(o[2], o[3]); *(v2u*)(MGa + (unsigned)(row * DM + j)) = w; } }
            if (m & 1) { asm volatile("" ::: "memory"); __builtin_amdgcn_sched_barrier(0); } }
    }
};
struct EpiMergeMain {
    static constexpr bool PERM = false, AFTER_DRAIN = false; static constexpr int MID_T = 16; const bf16_t* MGa; const bf16_t* P; bf16_t* MGb;
    __device__ __forceinline__ void mid(f32x4 (&acc)[2][2][4][2], const Unit& u, int wr, int wc, int fr, int fq) const {
        _Pragma("unroll") for (int ai = 0; ai < 2; ++ai) _Pragma("unroll") for (int m = 0; m < 4; ++m) { const int row = u.pm * BM + ai * HALF + wr * 64 + m * 16 + fr;
            _Pragma("unroll") for (int bj = 0; bj < 2; ++bj) _Pragma("unroll") for (int n = 0; n < 2; ++n) { const int col = u.pn * BM + bj * HALF + wc * 32 + n * 16 + 4 * fq;
                const f32x4 g0 = gate4(P, row, col, 0), g1 = gate4(P, row, col, 1); f32x4 r;
                _Pragma("unroll") for (int i = 0; i < 4; ++i) r[i] = g0[i] * __builtin_amdgcn_rcpf(fmaxf(g1[i], 1e-30f));
                acc[ai][bj][m][n] = acc[ai][bj][m][n] * r; }
            if (m & 1) { asm volatile("" ::: "memory"); __builtin_amdgcn_sched_barrier(0); } }
    }
    __device__ __forceinline__ void operator()(EPI_SIG) const {
        EPI_FOREACH4( const f32x4 g1 = gate4(P, row, col, 1); const v2u mw = *(const v2u*)(MGa + (unsigned)(row * DM + col)); const f32x4 mg = (f32x4){lo16(mw.x), hi16(mw.x), lo16(mw.y), hi16(mw.y)};
            const f32x4 o = g1 * v + mg; v2u w; w.x = cvt_pk_bf16(o[0], o[1]); w.y = cvt_pk_bf16(o[2], o[3]); *(v2u*)(MGb + (unsigned)(row * DM + col)) = w; )
    }
};
struct EpiResid {
    static constexpr bool PERM = false, AFTER_DRAIN = false; static constexpr int MID_T = -1; const float* xp; const float* xs; const float* gate; float* out;
    __device__ __forceinline__ void operator()(EPI_SIG) const {
        const bool smp = u.pm * BM >= NPTOK; const float* xb = smp ? xs : xp; const int rb = smp ? NPTOK : 0;
        EPI_FOREACH4( const f32x4 x = *(const f32x4*)(xb + (unsigned)((row - rb) * DM + col));
            const int mr = smp ? 4 + ((row - NPTOK) >> 3) : (row >> 11);
            const f32x4 g = *(const f32x4*)(gate + (unsigned)(mr * (2 * ADA_N) + col)); *(f32x4*)(out + (unsigned)(row * DM + col)) = x + g * v; )
    }
};
struct EpiRelu2 {
    static constexpr bool PERM = true, AFTER_DRAIN = false; static constexpr int MID_T = -1; bf16_t* F;
    __device__ __forceinline__ void operator()(EPI_SIG) const {
        EPI_FOREACH8( f32x4 a = v0, b = v1;
            _Pragma("unroll") for (int i = 0; i < 4; ++i) { const float x = fmaxf(a[i], 0.f), y = fmaxf(b[i], 0.f); a[i] = x * x; b[i] = y * y; }
            *(v4u*)(F + (unsigned)(row * FF + col)) = pack8(a, b); )
    }
};
}

__device__ __forceinline__ void p0_transpose_item(const float* W, int K, int N, bf16* WT, int pitch, int koff, int row_off, int sel, LAS float* scr, int item, int lane) {
    const int nblk = N / 32, kb = item / nblk, nb = item % nblk, k0 = 64 * kb, n0 = 32 * nb;
#pragma unroll 16
    for (int i = 0; i < 32; ++i) { const int kk = 2 * i + (lane >> 5); scr[kk * 33 + (lane & 31)] = W[(size_t)(k0 + kk) * N + n0 + (lane & 31)]; }
    LDS_WAIT(); asm volatile("" ::: "memory");
    const int c = lane & 7;
#pragma unroll
    for (int j = 0; j < 4; ++j) { const int n = (lane >> 3) + 8 * j; const LAS float* s = scr + (8 * c) * 33 + n;
        v4u o; o.x = pk2(s[0 * 33], s[1 * 33]); o.y = pk2(s[2 * 33], s[3 * 33]); o.z = pk2(s[4 * 33], s[5 * 33]); o.w = pk2(s[6 * 33], s[7 * 33]);
        const int ng = n0 + n, drow = sel < 0 ? row_off + ng : 32 * (ng >> 4) + 16 * sel + (ng & 15);
        *(v4u*)(WT + (size_t)drow * pitch + koff + k0 + 8 * c) = o; }
    LDS_WAIT(); asm volatile("" ::: "memory");
}

constexpr int I_ADA = (DM / 64) * (ADA_N / 32), I_IN = (DM / 64) * (IN_DIM / 32), I_O = (1024 / 64) * (DM / 32), I_CO = (512 / 64) * (DM / 32), I_G = I_CO,
              I_OUT = (DM / 64) * (DM / 32), I_F1 = (DM / 64) * (FF / 32), I_F2 = (FF / 64) * (DM / 32);
constexpr int I_LAYER = I_IN + I_O + I_CO + 2 * I_G + I_OUT + I_F1 + I_F2, I_L0_PRO = I_LAYER - 12800;
__device__ __forceinline__ void convert_layer_item(const Args& a, int l, int r, LAS float* scr, int lane) {
    bf16* wl = (bf16*)(a.ws + WS_WL + (size_t)l * WL_STRIDE);
    if (r < I_IN) { p0_transpose_item(a.in[I_WIN] + (size_t)l * DM * IN_DIM, DM, IN_DIM, wl + WL_IN / 2, DM, 0, 0, -1, scr, r, lane); return; } r -= I_IN;
    if (r < I_O) { p0_transpose_item(a.in[I_WO] + (size_t)l * 1024 * DM, 1024, DM, wl + WL_O / 2, 1536, 0, 0, -1, scr, r, lane); return; } r -= I_O;
    if (r < I_CO) { p0_transpose_item(a.in[I_WCO] + (size_t)l * 512 * DM, 512, DM, wl + WL_O / 2, 1536, 1024, 0, -1, scr, r, lane); return; } r -= I_CO;
    if (r < I_G) { p0_transpose_item(a.in[I_WGA] + (size_t)l * 512 * DM, 512, DM, wl + WL_GA / 2, 512, 0, 0, 0, scr, r, lane); return; } r -= I_G;
    if (r < I_G) { p0_transpose_item(a.in[I_WGB] + (size_t)l * 512 * DM, 512, DM, wl + WL_GA / 2, 512, 0, 0, 1, scr, r, lane); return; } r -= I_G;
    if (r < I_OUT) { p0_transpose_item(a.in[I_WOUT] + (size_t)l * DM * DM, DM, DM, wl + WL_OUT / 2, DM, 0, 0, -1, scr, r, lane); return; } r -= I_OUT;
    if (r < I_F1) { p0_transpose_item(a.in[I_WF1] + (size_t)l * DM * FF, DM, FF, wl + WL_F1 / 2, DM, 0, 0, -1, scr, r, lane); return; } r -= I_F1;
    p0_transpose_item(a.in[I_WF2] + (size_t)l * FF * DM, FF, DM, wl + WL_F2 / 2, FF, 0, 0, -1, scr, r, lane);
}
__device__ __forceinline__ void convert_idle(const Args& a, LAS unsigned char* lds, int l, int c0, int i0, int i1) {
    int tid_o = threadIdx.x; asm volatile("" : "+v"(tid_o)); const int lane = tid_o & 63, wave = __builtin_amdgcn_readfirstlane(tid_o >> 6);
    const int c = (int)blockIdx.x - c0; if (c < 0) return;
    LAS float* scr = (LAS float*)(lds + wave * 16384);
    const int nw = ((int)gridDim.x - c0) * 8;
    for (int it = i0 + c * 8 + wave; it < i1; it += nw) convert_layer_item(a, l, it, scr, lane);
}

__device__ __forceinline__ void p0_prologue(const Args& a, LAS unsigned char* lds, int gw, int NGW, int lane, int wave, int gtid, int NGT) {
    LAS float* scr = (LAS float*)(lds + wave * 16384);
    unsigned char* ws = a.ws;
    for (int it = gw; it < 2 * I_ADA + I_L0_PRO; it += NGW) {
        if (it < 2 * I_ADA) { const int l = it / I_ADA, r = it - l * I_ADA; p0_transpose_item(a.in[I_WADA] + (size_t)l * DM * ADA_N, DM, ADA_N, (bf16*)(ws + WS_WADA), DM, 0, l * ADA_N, -1, scr, r, lane); }
        else convert_layer_item(a, 0, it - 2 * I_ADA, scr, lane);
    }
    for (int it = gw; it < I_LAYER; it += NGW) convert_layer_item(a, 1, it, scr, lane);
    unsigned* AC = (unsigned*)(ws + WS_AC);
    for (int i = gtid; i < 256 * DM / 2; i += NGT) {
        const int row = i / (DM / 2), c2 = (i % (DM / 2)) * 2; unsigned w = 0u;
        if (row < NMODROW) { const float* src = row < 4 ? a.in[I_CP] + row * DM + c2 : a.in[I_CS] + (row - 4) * DM + c2; const float x = src[0], y = src[1]; w = pk2(x * sigm(x), y * sigm(y)); }
        AC[i] = w;
    }
    f32x2* RT = (f32x2*)(ws + WS_ROPE);
    for (int i = gtid; i < 2056 * 8; i += NGT) {
        const int pi = i >> 3, fi = i & 7; const double pos = pi < 2048 ? (double)pi : (double)(8192 + pi - 2048);
        const double invf = dexp_(-(double)fi * 0.125 * 13.122363377404328);
        double sn, cs; dsincos_(pos * invf, sn, cs); RT[i] = (f32x2){(float)cs, (float)sn};
    }
}

__device__ __forceinline__ void norm_mod_phase(const float* xp, const float* xs, const float* normw, const float* mod, int l, int second, bf16* H) {
    int tid_o = threadIdx.x; asm volatile("" : "+v"(tid_o)); const int tid = tid_o, lane = tid & 63, wave = __builtin_amdgcn_readfirstlane(tid >> 6); (void)lane; (void)wave;
    const int NGW = gridDim.x * 8, gw = blockIdx.x * 8 + wave;
    for (int row0 = gw; row0 < NTOK; row0 += 2 * NGW) {
        const int row1 = row0 + NGW; const bool has1 = row1 < NTOK; const int r1 = has1 ? row1 : row0;
        const float* xr0 = row0 < NPTOK ? xp + (size_t)row0 * DM : xs + (size_t)(row0 - NPTOK) * DM;
        const float* xr1 = r1 < NPTOK ? xp + (size_t)r1 * DM : xs + (size_t)(r1 - NPTOK) * DM;
        f32x4 v0[8], v1[8]; float s0 = 0.f, s1 = 0.f;
#pragma unroll
        for (int j = 0; j < 8; ++j) { v0[j] = *(const f32x4*)(xr0 + 4 * (lane + 64 * j)); v1[j] = *(const f32x4*)(xr1 + 4 * (lane + 64 * j)); }
#pragma unroll
        for (int j = 0; j < 8; ++j) { s0 += (v0[j][0] * v0[j][0] + v0[j][1] * v0[j][1]) + (v0[j][2] * v0[j][2] + v0[j][3] * v0[j][3]); s1 += (v1[j][0] * v1[j][0] + v1[j][1] * v1[j][1]) + (v1[j][2] * v1[j][2] + v1[j][3] * v1[j][3]); }
        s0 = wave_sum(s0); s1 = wave_sum(s1);
        const float rs0 = rsqrtf(s0 * (1.f / DM) + 1e-6f), rs1 = rsqrtf(s1 * (1.f / DM) + 1e-6f);
        const float* sh0 = mod + (size_t)pg8::mod_row(row0) * (2 * ADA_N) + l * ADA_N + (second ? 3 : 0) * DM; const float* sh1 = mod + (size_t)pg8::mod_row(r1) * (2 * ADA_N) + l * ADA_N + (second ? 3 : 0) * DM;
#pragma unroll
        for (int j = 0; j < 8; ++j) { const int c = 4 * (lane + 64 * j); const f32x4 nw = *(const f32x4*)(normw + c);
            { const f32x4 sc = *(const f32x4*)(sh0 + DM + c), sh = *(const f32x4*)(sh0 + c); const f32x4 y = (v0[j] * rs0) * nw * (sc + 1.f) + sh; v2u w; w.x = pk2(y[0], y[1]); w.y = pk2(y[2], y[3]); *(v2u*)(H + (size_t)row0 * DM + c) = w; }
            if (has1) { const f32x4 sc = *(const f32x4*)(sh1 + DM + c), sh = *(const f32x4*)(sh1 + c); const f32x4 y = (v1[j] * rs1) * nw * (sc + 1.f) + sh; v2u w; w.x = pk2(y[0], y[1]); w.y = pk2(y[2], y[3]); *(v2u*)(H + (size_t)row1 * DM + c) = w; } }
    }
}

__device__ __forceinline__ void unpack8(const v4u r, float (&x)[8]) { x[0] = lo16(r.x); x[1] = hi16(r.x); x[2] = lo16(r.y); x[3] = hi16(r.y); x[4] = lo16(r.z); x[5] = hi16(r.z); x[6] = lo16(r.w); x[7] = hi16(r.w); }
__device__ __forceinline__ v4u pack8f(const float (&x)[8]) { v4u w; w.x = pk2(x[0], x[1]); w.y = pk2(x[2], x[3]); w.z = pk2(x[4], x[5]); w.w = pk2(x[6], x[7]); return w; }
template <int NKT>
__device__ __forceinline__ void attn_qgroup(const LAS bf16* Ks, int kst, const LAS bf16* Vt, int vst, const bf16* qrow, const float* qg, const f32x2* rt, int qi, bool hasprev, float sink, bf16* orow, bool store_ok, int lane) {
    static_assert(NKT % 2 == 0, "key tiles come in pairs");
    const int lr = lane & 15, q4 = lane >> 4;
    bf16x8 qf0, qf1;
    { float x0[8], x1[8]; unpack8(*(const v4u*)(qrow + 8 * q4), x0); unpack8(*(const v4u*)(qrow + 32 + 8 * q4), x1);
      float ss = 0.f;
#pragma unroll
      for (int e = 0; e < 8; ++e) ss += x0[e] * x0[e] + x1[e] * x1[e];
      ss += __shfl_xor(ss, 16); ss += __shfl_xor(ss, 32);
      const float rstd = rsqrtf(ss * (1.f / 64.f) + 1e-6f);
#pragma unroll
      for (int e = 0; e < 8; ++e) { x0[e] = x0[e] * rstd * qg[8 * q4 + e]; x1[e] = x1[e] * rstd * qg[32 + 8 * q4 + e]; }
#pragma unroll
      for (int e = 0; e < 8; ++e) { const float other = __shfl_xor(x0[e], 16); const f32x2 cs = rt[e];
          if (q4 == 0) x0[e] = x0[e] * cs.x - other * cs.y; else if (q4 == 1) x0[e] = x0[e] * cs.x + other * cs.y; }
#pragma unroll
      for (int e = 0; e < 8; ++e) { x0[e] *= 0.125f; x1[e] *= 0.125f; }
      qf0 = __builtin_bit_cast(bf16x8, pack8f(x0)); qf1 = __builtin_bit_cast(bf16x8, pack8f(x1)); }
    f32x4 s[NKT];
#pragma unroll
    for (int kt = 0; kt < NKT; ++kt) {
        const LAS bf16* kp = Ks + (16 * kt + lr) * kst + 8 * q4;
        const bf16x8 k0 = *(const LAS bf16x8*)kp, k1 = *(const LAS bf16x8*)(kp + 32);
        f32x4 z = (f32x4){0.f, 0.f, 0.f, 0.f};
        z = __builtin_amdgcn_mfma_f32_16x16x32_bf16(k0, qf0, z, 0, 0, 0);
        z = __builtin_amdgcn_mfma_f32_16x16x32_bf16(k1, qf1, z, 0, 0, 0);
        s[kt] = z;
        if ((kt & 3) == 3) __builtin_amdgcn_sched_barrier(0);
    }
    float m = sink;
#pragma unroll
    for (int kt = 0; kt < NKT; ++kt)
#pragma unroll
        for (int i = 0; i < 4; ++i) { const int kj = 16 * kt + 4 * q4 + i; const bool ok = (kj > qi) && (kj <= qi + 128) && (hasprev || kj >= 128);
            const float v = ok ? s[kt][i] : -INFINITY; s[kt][i] = v; m = fmaxf(m, v); }
    m = fmaxf(m, __shfl_xor(m, 16)); m = fmaxf(m, __shfl_xor(m, 32));
    float sum = 0.f;
#pragma unroll
    for (int kt = 0; kt < NKT; ++kt)
#pragma unroll
        for (int i = 0; i < 4; ++i) { const float p = __expf(s[kt][i] - m); s[kt][i] = p; sum += p; }
    sum += __shfl_xor(sum, 16); sum += __shfl_xor(sum, 32);
    const float inv = 1.f / (sum + __expf(sink - m));
    f32x4 o[4];
#pragma unroll
    for (int dt = 0; dt < 4; ++dt) o[dt] = (f32x4){0.f, 0.f, 0.f, 0.f};
#pragma unroll
    for (int kp = 0; kp < NKT / 2; ++kp) {
        v4u pw; pw.x = pk2(s[2 * kp][0], s[2 * kp][1]); pw.y = pk2(s[2 * kp][2], s[2 * kp][3]); pw.z = pk2(s[2 * kp + 1][0], s[2 * kp + 1][1]); pw.w = pk2(s[2 * kp + 1][2], s[2 * kp + 1][3]);
        const bf16x8 pb = __builtin_bit_cast(bf16x8, pw);
#pragma unroll
        for (int dt = 0; dt < 4; ++dt) {
            const LAS bf16* vp = Vt + (16 * dt + lr) * vst + 32 * kp + 4 * q4;
            const v2u lo = *(const LAS v2u*)vp, hi = *(const LAS v2u*)(vp + 16);
            v4u vw; vw.x = lo.x; vw.y = lo.y; vw.z = hi.x; vw.w = hi.y;
            o[dt] = __builtin_amdgcn_mfma_f32_16x16x32_bf16(__builtin_bit_cast(bf16x8, vw), pb, o[dt], 0, 0, 0);
        }
    }
    if (store_ok) {
#pragma unroll
        for (int dt = 0; dt < 4; ++dt) { v2u w; w.x = pk2(o[dt][0] * inv, o[dt][1] * inv); w.y = pk2(o[dt][2] * inv, o[dt][3] * inv); *(v2u*)(orow + 16 * dt + 4 * q4) = w; }
    }
}

constexpr int AP_KST = 72, AP_VST = 264;
constexpr int AS_KST = 72, AS_VST = 168, AS_NK = 160;

__device__ __forceinline__ void knorm_rope8(float (&x)[8], int ch, const float* kg, const f32x2* rt) {
    float ss = 0.f;
#pragma unroll
    for (int e = 0; e < 8; ++e) ss += x[e] * x[e];
    ss += __shfl_xor(ss, 1); ss += __shfl_xor(ss, 2); ss += __shfl_xor(ss, 4);
    const float rstd = rsqrtf(ss * (1.f / 64.f) + 1e-6f);
#pragma unroll
    for (int e = 0; e < 8; ++e) x[e] = x[e] * rstd * kg[ch * 8 + e];
#pragma unroll
    for (int e = 0; e < 8; ++e) { const float other = __shfl_xor(x[e], 1); const f32x2 cs = rt[e];
        if (ch == 0) x[e] = x[e] * cs.x - other * cs.y; else if (ch == 1) x[e] = x[e] * cs.x + other * cs.y; }
}
__device__ __forceinline__ void attn_prompt_item(const Args& a, int l, int item, LAS unsigned char* lds) {
    int tid_o = threadIdx.x; asm volatile("" : "+v"(tid_o)); const int tid = tid_o, lane = tid & 63, wave = __builtin_amdgcn_readfirstlane(tid >> 6); (void)lane; (void)wave;
    unsigned char* ws = a.ws; asm volatile("" : "+s"(ws)); const bf16* P = (const bf16*)(ws + WS_P); bf16* O = (bf16*)(ws + WS_O); const f32x2* RT = (const f32x2*)(ws + WS_ROPE);
    const float* qg = a.in[I_QN] + l * 64; const float* kg = a.in[I_KN] + l * 64;
    const int kvh = item & 3, n = (item >> 2) & 15, b = item >> 6;
    LAS bf16* Ks = (LAS bf16*)lds; LAS bf16* Vt = (LAS bf16*)(lds + 256 * AP_KST * 2);
#pragma unroll
    for (int i = 0; i < 4; ++i) { const int c = tid + 512 * i, r = c >> 3, ch = c & 7, pos = 128 * (n - 1) + r, pc = pos >= 0 ? pos : 0;
        v4u val = (v4u){0u, 0u, 0u, 0u}; if (pos >= 0) val = *(const v4u*)(P + (size_t)(b * SEQ + pos) * IN_DIM + C_K + kvh * 64 + ch * 8);
        float x[8]; unpack8(val, x); knorm_rope8(x, ch, kg, RT + pc * 8);
        *(LAS v4u*)(Ks + r * AP_KST + ch * 8) = pack8f(x);
        if (n == 15 && r >= 128) { float* o = a.out + O_NKP + ((size_t)(l * NB + b) * 128 + (r - 128)) * 256 + kvh * 64 + ch * 8;
            *(f32x4*)o = (f32x4){x[0], x[1], x[2], x[3]}; *(f32x4*)(o + 4) = (f32x4){x[4], x[5], x[6], x[7]}; } }
#pragma unroll
    for (int i = 0; i < 4; ++i) { const int c = tid + 512 * i, key = c & 255, ch = c >> 8, pos = 128 * (n - 1) + key;
        v4u val = (v4u){0u, 0u, 0u, 0u}; if (pos >= 0) val = *(const v4u*)(P + (size_t)(b * SEQ + pos) * IN_DIM + C_V + kvh * 64 + ch * 8);
        LAS bf16* d = Vt + (ch * 8) * AP_VST + key;
        d[0 * AP_VST] = (bf16)(val.x & 0xffffu); d[1 * AP_VST] = (bf16)(val.x >> 16); d[2 * AP_VST] = (bf16)(val.y & 0xffffu); d[3 * AP_VST] = (bf16)(val.y >> 16);
        d[4 * AP_VST] = (bf16)(val.z & 0xffffu); d[5 * AP_VST] = (bf16)(val.z >> 16); d[6 * AP_VST] = (bf16)(val.w & 0xffffu); d[7 * AP_VST] = (bf16)(val.w >> 16);
        if (n == 15 && key >= 128) { float* o = a.out + O_NVP + ((size_t)(l * NB + b) * 128 + (key - 128)) * 256 + kvh * 64 + ch * 8;
            *(f32x4*)o = (f32x4){lo16(val.x), hi16(val.x), lo16(val.y), hi16(val.y)}; *(f32x4*)(o + 4) = (f32x4){lo16(val.z), hi16(val.z), lo16(val.w), hi16(val.w)}; } }
    __syncthreads();
    const int g = wave >> 1, half = wave & 1, head = kvh * 4 + g; const float sink = a.in[I_SINK][l * 16 + head];
#pragma nounroll
    for (int qg_i = 0; qg_i < 4; ++qg_i) {
        const int qi = 64 * half + 16 * qg_i + (lane & 15); const size_t tok = (size_t)b * SEQ + 128 * n + qi;
        attn_qgroup<16>(Ks, AP_KST, Vt, AP_VST, P + tok * IN_DIM + head * 64, qg, RT + (128 * n + qi) * 8, qi, n > 0, sink, O + tok * 1536 + head * 64, true, lane);
    }
    __syncthreads();
}

__device__ __forceinline__ void attn_sample_item(const Args& a, int l, int item, LAS unsigned char* lds) {
    int tid_o = threadIdx.x; asm volatile("" : "+v"(tid_o)); const int tid = tid_o, lane = tid & 63, wave = __builtin_amdgcn_readfirstlane(tid >> 6); (void)lane; (void)wave;
    unsigned char* ws = a.ws; asm volatile("" : "+s"(ws)); const bf16* P = (const bf16*)(ws + WS_P); bf16* O = (bf16*)(ws + WS_O); const f32x2* RT = (const f32x2*)(ws + WS_ROPE);
    const float* qg = a.in[I_QN] + l * 64; const float* kg = a.in[I_KN] + l * 64;
    const int pair = item & 1, b = item >> 1;
    LAS bf16* Ks = (LAS bf16*)lds; LAS bf16* Vt = (LAS bf16*)(lds + 2 * AS_NK * AS_KST * 2);
    const float* ck = a.in[I_CK] + (size_t)(l * DECB + b) * 128 * 256; const float* cv = a.in[I_CV] + (size_t)(l * DECB + b) * 128 * 256;
    float* onk = a.out + O_NKS + (size_t)(l * DECB + b) * 128 * 256; float* onv = a.out + O_NVS + (size_t)(l * DECB + b) * 128 * 256;
#pragma unroll
    for (int i = 0; i < 8; ++i) { const int c = tid + 512 * i, kk = c >> 11, rem = c & 2047, r = rem >> 4, ch4 = rem & 15;
        const f32x4 v = *(const f32x4*)(ck + (size_t)r * 256 + (2 * pair + kk) * 64 + ch4 * 4); v2u w; w.x = pk2(v[0], v[1]); w.y = pk2(v[2], v[3]);
        *(LAS v2u*)(Ks + (kk * AS_NK + r) * AS_KST + ch4 * 4) = w;
        if (r >= 8) *(f32x4*)(onk + (size_t)(r - 8) * 256 + (2 * pair + kk) * 64 + ch4 * 4) = v; }
    { const int kk = tid >> 8, rem = tid & 255, r = 128 + (rem >> 3), ch = rem & 7, t = r < 136 ? r - 128 : 0;
      v4u val = (v4u){0u, 0u, 0u, 0u}; if (r < 136) val = *(const v4u*)(P + (size_t)(NPTOK + b * DECT + t) * IN_DIM + C_K + (2 * pair + kk) * 64 + ch * 8);
      float x[8]; unpack8(val, x); knorm_rope8(x, ch, kg, RT + (2048 + t) * 8);
      *(LAS v4u*)(Ks + (kk * AS_NK + r) * AS_KST + ch * 8) = pack8f(x);
      if (r < 136) { float* o = onk + (size_t)(120 + t) * 256 + (2 * pair + kk) * 64 + ch * 8; *(f32x4*)o = (f32x4){x[0], x[1], x[2], x[3]}; *(f32x4*)(o + 4) = (f32x4){x[4], x[5], x[6], x[7]}; } }
#pragma unroll
    for (int i = 0; i < 8; ++i) { const int c = tid + 512 * i, key = c & 127, kk = (c >> 7) & 1, ch4 = c >> 8;
        const f32x4 v = *(const f32x4*)(cv + (size_t)key * 256 + (2 * pair + kk) * 64 + ch4 * 4);
        LAS bf16* d = Vt + (kk * 64 + ch4 * 4) * AS_VST + key;
        d[0] = (bf16)f2bf(v[0]); d[AS_VST] = (bf16)f2bf(v[1]); d[2 * AS_VST] = (bf16)f2bf(v[2]); d[3 * AS_VST] = (bf16)f2bf(v[3]);
        if (key >= 8) *(f32x4*)(onv + (size_t)(key - 8) * 256 + (2 * pair + kk) * 64 + ch4 * 4) = v; }
#pragma unroll
    for (int i = 0; i < 8; ++i) { const int c = tid + 512 * i, col = 128 + (c & 31), d = (c >> 5) & 63, kk = c >> 11; bf16 val = 0;
        if (col < 136) { val = P[(size_t)(NPTOK + b * DECT + (col - 128)) * IN_DIM + C_V + (2 * pair + kk) * 64 + d]; onv[(size_t)(120 + col - 128) * 256 + (2 * pair + kk) * 64 + d] = bf2f(val); }
        Vt[(kk * 64 + d) * AS_VST + col] = val; }
    __syncthreads();
    const int kk = wave >> 2, g = wave & 3, kvh = 2 * pair + kk, head = kvh * 4 + g; const float sink = a.in[I_SINK][l * 16 + head];
    const int qi = lane & 15, qld = qi < 8 ? qi : 7; const size_t tok = (size_t)NPTOK + b * DECT + qld;
    attn_qgroup<10>(Ks + kk * AS_NK * AS_KST, AS_KST, Vt + kk * 64 * AS_VST, AS_VST, P + tok * IN_DIM + head * 64, qg, RT + (2048 + qld) * 8, qi, true, sink, O + tok * 1536 + head * 64, qi < 8, lane);
    __syncthreads();
}

template <int TT>
__device__ __forceinline__ void conv_compute(const Args& a, int l, LAS float* U, LAS float* red, LAS float* stat, size_t tok0, int tid, int wave, int lane) {
    const int c = tid;
    float w[31];
#pragma unroll
    for (int j = 0; j < 31; ++j) w[j] = a.in[I_CW][(size_t)(l * 31 + j) * 512 + c];
    const float bias = a.in[I_CB][l * 512 + c];
    float y[TT];
#pragma unroll
    for (int tb = 0; tb < TT / 8; ++tb) {
        float win[38];
#pragma unroll
        for (int r = 0; r < 38; ++r) win[r] = U[(tb * 8 + r) * 512 + c];
#pragma unroll
        for (int t = 0; t < 8; ++t) { float acc = bias;
#pragma unroll
            for (int j = 0; j < 31; ++j) acc = fmaf(w[j], win[t + j], acc);
            y[tb * 8 + t] = acc; }
    }
#pragma unroll
    for (int t = 0; t < TT; ++t) { const float s1 = wave_sum(y[t]), s2 = wave_sum(y[t] * y[t]); if (lane == 0) { red[(wave * 32 + t) * 2] = s1; red[(wave * 32 + t) * 2 + 1] = s2; } }
    __syncthreads();
    if (tid < TT * 2) { const int t = tid >> 1, k = tid & 1; float s = 0.f;
#pragma unroll
        for (int ww = 0; ww < 8; ++ww) s += red[(ww * 32 + t) * 2 + k];
        stat[t * 2 + k] = s; }
    __syncthreads();
    const float lg = a.in[I_CLG][l * 512 + c], lb = a.in[I_CLB][l * 512 + c];
    bf16* YC = (bf16*)(a.ws + WS_O) + 1024;
#pragma unroll
    for (int t = 0; t < TT; ++t) { const float mean = stat[t * 2] * (1.f / 512.f), var = stat[t * 2 + 1] * (1.f / 512.f) - mean * mean, rstd = rsqrtf(fmaxf(var, 0.f) + 1e-6f);
        const float v = (y[t] - mean) * rstd * lg + lb; YC[(tok0 + t) * 1536 + c] = (bf16)f2bf(v * sigm(v)); }
}
__device__ __forceinline__ void glu8(const bf16* P, size_t tok, int ch, float (&u)[8]) {
    const v4u av = *(const v4u*)(P + tok * IN_DIM + C_XA + ch * 8), bv = *(const v4u*)(P + tok * IN_DIM + C_XB + ch * 8);
    u[0] = lo16(av.x) * sigm(lo16(bv.x)); u[1] = hi16(av.x) * sigm(hi16(bv.x)); u[2] = lo16(av.y) * sigm(lo16(bv.y)); u[3] = hi16(av.y) * sigm(hi16(bv.y));
    u[4] = lo16(av.z) * sigm(lo16(bv.z)); u[5] = hi16(av.z) * sigm(hi16(bv.z)); u[6] = lo16(av.w) * sigm(lo16(bv.w)); u[7] = hi16(av.w) * sigm(hi16(bv.w));
}
__device__ __forceinline__ void conv_prompt_item(const Args& a, int l, int item, LAS unsigned char* lds) {
    int tid_o = threadIdx.x; asm volatile("" : "+v"(tid_o)); const int tid = tid_o, lane = tid & 63, wave = __builtin_amdgcn_readfirstlane(tid >> 6); (void)lane; (void)wave;
    const bf16* P = (const bf16*)(a.ws + WS_P);
    LAS float* U = (LAS float*)lds; LAS float* red = U + 62 * 512; LAS float* stat = red + 512;
    const int b = item >> 6, tile = item & 63, t0 = tile * 32;
#pragma unroll 4
    for (int c = tid; c < 62 * 64; c += 512) { const int r = c >> 6, ch = c & 63, t = t0 - 30 + r; float u[8];
        if (t >= 0) glu8(P, (size_t)b * SEQ + t, ch, u); else {
#pragma unroll
            for (int e = 0; e < 8; ++e) u[e] = 0.f; }
        *(LAS f32x4*)(U + r * 512 + ch * 8) = (f32x4){u[0], u[1], u[2], u[3]}; *(LAS f32x4*)(U + r * 512 + ch * 8 + 4) = (f32x4){u[4], u[5], u[6], u[7]};
        if (tile == 63 && t >= SEQ - 30) { float* o = a.out + O_NCP + ((size_t)(l * NB + b) * 30 + (t - (SEQ - 30))) * 512 + ch * 8;
            *(f32x4*)o = (f32x4){u[0], u[1], u[2], u[3]}; *(f32x4*)(o + 4) = (f32x4){u[4], u[5], u[6], u[7]}; } }
    __syncthreads();
    conv_compute<32>(a, l, U, red, stat, (size_t)b * SEQ + t0, tid, wave, lane);
    __syncthreads();
}
__device__ __forceinline__ void conv_sample_item(const Args& a, int l, int item, LAS unsigned char* lds) {
    int tid_o = threadIdx.x; asm volatile("" : "+v"(tid_o)); const int tid = tid_o, lane = tid & 63, wave = __builtin_amdgcn_readfirstlane(tid >> 6); (void)lane; (void)wave;
    const bf16* P = (const bf16*)(a.ws + WS_P);
    LAS float* U = (LAS float*)lds; LAS float* red = U + 62 * 512; LAS float* stat = red + 512;
    const int b = item; const float* sc = a.in[I_SCONV] + (size_t)(l * DECB + b) * 30 * 512;
#pragma unroll 5
    for (int c = tid; c < 38 * 64; c += 512) { const int r = c >> 6, ch = c & 63; float u[8];
        if (r < 30) { const f32x4 x0 = *(const f32x4*)(sc + r * 512 + ch * 8), x1 = *(const f32x4*)(sc + r * 512 + ch * 8 + 4);
            u[0] = x0[0]; u[1] = x0[1]; u[2] = x0[2]; u[3] = x0[3]; u[4] = x1[0]; u[5] = x1[1]; u[6] = x1[2]; u[7] = x1[3]; }
        else glu8(P, (size_t)NPTOK + b * DECT + (r - 30), ch, u);
        *(LAS f32x4*)(U + r * 512 + ch * 8) = (f32x4){u[0], u[1], u[2], u[3]}; *(LAS f32x4*)(U + r * 512 + ch * 8 + 4) = (f32x4){u[4], u[5], u[6], u[7]};
        if (r >= 8) { float* o = a.out + O_NCS + ((size_t)(l * DECB + b) * 30 + (r - 8)) * 512 + ch * 8;
            *(f32x4*)o = (f32x4){u[0], u[1], u[2], u[3]}; *(f32x4*)(o + 4) = (f32x4){u[4], u[5], u[6], u[7]}; } }
    __syncthreads();
    conv_compute<8>(a, l, U, red, stat, (size_t)NPTOK + b * DECT, tid, wave, lane);
    __syncthreads();
}

struct SsmLane { float ar, ai; f32x2 bz[16]; bf16x8 cf[4]; f32x4 dv; float a256r, a256i; };
__device__ __forceinline__ void ssm_setup(const Args& a, int l, int g, int lane, SsmLane& S) {
    const int p = lane, lg = l * 32 + g;
    const double are = (double)a.in[I_ARE][lg * 64 + p], aim = (double)a.in[I_AIM][lg * 64 + p], dt = dexp_((double)a.in[I_LDT][lg]);
    const double mag = dexp_(are * dt); double sn, cs; dsincos_(aim * dt, sn, cs);
    const double abr = mag * cs, abi = mag * sn, den = are * are + aim * aim;
    const double zr = ((abr - 1.0) * are + abi * aim) / den, zi = (abi * are - (abr - 1.0) * aim) / den;
    S.ar = (float)abr; S.ai = (float)abi;
    double pr = abr, pi = abi;
#pragma unroll
    for (int i = 0; i < 8; ++i) { const double nr = pr * pr - pi * pi, ni = 2.0 * pr * pi; pr = nr; pi = ni; }
    S.a256r = (float)pr; S.a256i = (float)pi;
    const float* br = a.in[I_BRE] + (size_t)(lg * 64 + p) * 16; const float* bi = a.in[I_BIM] + (size_t)(lg * 64 + p) * 16;
    const float zrf = (float)zr, zif = (float)zi;
#pragma unroll
    for (int c = 0; c < 16; ++c) { const float x = br[c], y = bi[c]; S.bz[c] = (f32x2){zrf * x - zif * y, zrf * y + zif * x}; }
    const int lr = lane & 15, q4 = lane >> 4;
#pragma unroll
    for (int ks = 0; ks < 4; ++ks) { const int k0 = (ks & 1) * 32 + 8 * q4; const float* src = (ks < 2 ? a.in[I_CRE] : a.in[I_CIM]) + (size_t)(lg * 16 + lr) * 64 + k0; const float sg = ks < 2 ? 1.f : -1.f;
        const f32x4 x0 = *(const f32x4*)src, x1 = *(const f32x4*)(src + 4);
        v4u w; w.x = pk2(sg * x0[0], sg * x0[1]); w.y = pk2(sg * x0[2], sg * x0[3]); w.z = pk2(sg * x1[0], sg * x1[1]); w.w = pk2(sg * x1[2], sg * x1[3]);
        S.cf[ks] = __builtin_bit_cast(bf16x8, w); }
    S.dv = *(const f32x4*)(a.in[I_SD] + l * 512 + g * 16 + 4 * q4);
}
__device__ __forceinline__ float gelu_tanh(float x) { const float z = 0.7978845608028654f * (x + 0.044715f * x * x * x); const float t = 1.f - 2.f / (__expf(2.f * z) + 1.f); return 0.5f * x * (1.f + t); }

template <bool PASS2>
__device__ __forceinline__ void ssm_run(const Args& a, const SsmLane& S, int g, size_t tok0, int nsub, int nvalid, float& hr, float& hi, LAS float* ubuf, LAS bf16* hbuf, int lane) {
    const bf16* P = (const bf16*)(a.ws + WS_P); bf16* YS = (bf16*)(a.ws + WS_YS);
    const int lr = lane & 15, q4 = lane >> 4, st_l = lane >> 2, c4 = (lane & 3) * 4;
    v2u wnext = (v2u){0u, 0u};
    if (st_l < nvalid) wnext = *(const v2u*)(P + (tok0 + st_l) * IN_DIM + C_XS + g * 16 + c4);
#pragma nounroll
    for (int sub = 0; sub < nsub; ++sub) {
        *(LAS f32x4*)(ubuf + st_l * 16 + c4) = (f32x4){lo16(wnext.x), hi16(wnext.x), lo16(wnext.y), hi16(wnext.y)};
        if (sub + 1 < nsub) wnext = *(const v2u*)(P + (tok0 + (sub + 1) * 16 + st_l) * IN_DIM + C_XS + g * 16 + c4);
        WAVE_SYNC();
        f32x4 un[4];
#pragma unroll
        for (int q = 0; q < 4; ++q) un[q] = *(const LAS f32x4*)(ubuf + q * 4);
#pragma unroll
        for (int st = 0; st < 16; ++st) {
            f32x4 uc[4];
#pragma unroll
            for (int q = 0; q < 4; ++q) uc[q] = un[q];
            if (st < 15) {
#pragma unroll
                for (int q = 0; q < 4; ++q) un[q] = *(const LAS f32x4*)(ubuf + (st + 1) * 16 + q * 4);
            }
            if (st < nvalid) {
                f32x2 x2 = (f32x2){0.f, 0.f};
#pragma unroll
                for (int q = 0; q < 4; ++q)
#pragma unroll
                    for (int c = 0; c < 4; ++c) x2 = S.bz[4 * q + c] * (f32x2){uc[q][c], uc[q][c]} + x2;
                const f32x2 t2 = (f32x2){S.ar, S.ar} * (f32x2){hr, hi} + x2;
                const f32x2 n2 = (f32x2){-S.ai, S.ai} * (f32x2){hi, hr} + t2;
                hr = n2.x; hi = n2.y;
            }
            if (PASS2) { hbuf[st * 136 + lane] = (bf16)f2bf(hr); hbuf[st * 136 + 64 + lane] = (bf16)f2bf(hi); }
            __builtin_amdgcn_sched_barrier(0);
        }
        if (PASS2) {
            WAVE_SYNC();
            f32x4 acc = (f32x4){0.f, 0.f, 0.f, 0.f};
#pragma unroll
            for (int ks = 0; ks < 4; ++ks) { const bf16x8 hb = *(const LAS bf16x8*)(hbuf + lr * 136 + 32 * ks + 8 * q4); acc = __builtin_amdgcn_mfma_f32_16x16x32_bf16(S.cf[ks], hb, acc, 0, 0, 0); }
            const f32x4 uv = *(const LAS f32x4*)(ubuf + lr * 16 + 4 * q4);
            if (lr < nvalid) { f32x4 yv = acc + S.dv * uv; v2u w; w.x = pk2(gelu_tanh(yv[0]), gelu_tanh(yv[1])); w.y = pk2(gelu_tanh(yv[2]), gelu_tanh(yv[3]));
                *(v2u*)(YS + (tok0 + sub * 16 + lr) * 512 + g * 16 + 4 * q4) = w; }
        }
        WAVE_SYNC();
    }
}
__device__ __forceinline__ void ssm_prompt_item(const Args& a, int l, int item, LAS unsigned char* lds) {
    int tid_o = threadIdx.x; asm volatile("" : "+v"(tid_o)); const int tid = tid_o, lane = tid & 63, wave = __builtin_amdgcn_readfirstlane(tid >> 6); (void)lane; (void)wave;
    const int g = item & 31, b = item >> 5;
    LAS float* ubuf = (LAS float*)(lds + wave * 5632); LAS bf16* hbuf = (LAS bf16*)(lds + wave * 5632 + 1024); LAS float* ex = (LAS float*)(lds + 8 * 5632);
    SsmLane S; ssm_setup(a, l, g, lane, S);
    const size_t tok0 = (size_t)b * SEQ + 256 * wave;
    float hr = 0.f, hi = 0.f;
    ssm_run<false>(a, S, g, tok0, 16, 16, hr, hi, ubuf, hbuf, lane);
    ex[(wave * 64 + lane) * 2] = hr; ex[(wave * 64 + lane) * 2 + 1] = hi;
    __syncthreads();
    hr = 0.f; hi = 0.f;
    for (int j = 0; j < wave; ++j) { const float er = ex[(j * 64 + lane) * 2], ei = ex[(j * 64 + lane) * 2 + 1]; const float nr = S.a256r * hr - S.a256i * hi + er, ni = S.a256r * hi + S.a256i * hr + ei; hr = nr; hi = ni; }
    ssm_run<true>(a, S, g, tok0, 16, 16, hr, hi, ubuf, hbuf, lane);
    if (wave == 7) { a.out[O_NRP + (size_t)((l * NB + b) * 32 + g) * 64 + lane] = hr; a.out[O_NIP + (size_t)((l * NB + b) * 32 + g) * 64 + lane] = hi; }
    __syncthreads();
}
__device__ __forceinline__ void ssm_sample_item(const Args& a, int l, int item, LAS unsigned char* lds) {
    int tid_o = threadIdx.x; asm volatile("" : "+v"(tid_o)); const int tid = tid_o, lane = tid & 63, wave = __builtin_amdgcn_readfirstlane(tid >> 6); (void)lane; (void)wave;
    const int g = item & 31, bg = item >> 5;
    LAS float* ubuf = (LAS float*)(lds + wave * 5632); LAS bf16* hbuf = (LAS bf16*)(lds + wave * 5632 + 1024);
    SsmLane S; ssm_setup(a, l, g, lane, S);
    for (int bb = 0; bb < 2; ++bb) {
        const int bs = bg * 16 + wave * 2 + bb; const size_t so = (size_t)((l * DECB + bs) * 32 + g) * 64 + lane;
        float hr = a.in[I_SRE][so], hi = a.in[I_SIM][so];
        ssm_run<true>(a, S, g, (size_t)NPTOK + bs * DECT, 1, 8, hr, hi, ubuf, hbuf, lane);
        a.out[O_NRS + so] = hr; a.out[O_NIS + so] = hi;
    }
    __syncthreads();
}

__device__ __forceinline__ void mixer_phase(const Args& a, int l, LAS unsigned char* lds) {
    unsigned* qctr = (unsigned*)(a.ws + WS_CTL + 640 * 1024) + l * 64;
    volatile LAS unsigned* qslot = (volatile LAS unsigned*)(lds + 131072 + 128);
    for (;;) {
        if (threadIdx.x == 0) *qslot = __hip_atomic_fetch_add(qctr, 1u, __ATOMIC_RELAXED, __HIP_MEMORY_SCOPE_AGENT);
        __syncthreads();
        const int it = (int)*qslot;
        __syncthreads();
        if (it >= 1280) break;
        if (0) {}
#ifndef NO_SSMP
        else if (it < 128) ssm_prompt_item(a, l, it, lds);
#endif
#ifndef NO_ATTP
        else if (it < 384) attn_prompt_item(a, l, it - 128, lds);
#endif
#ifndef NO_CONVP
        else if (it < 640) conv_prompt_item(a, l, it - 384, lds);
#endif
#ifndef NO_ATTS
        else if (it < 896) attn_sample_item(a, l, it - 640, lds);
#endif
#ifndef NO_SSMS
        else if (it < 1152) ssm_sample_item(a, l, it - 896, lds);
#endif
#ifndef NO_CONVS
        else if (it < 1280) conv_sample_item(a, l, it - 1152, lds);
#endif
    }
}

#define XB_TMO      128
#define XB_XCNT(j)  (256  + 64 * (j))
#define XB_XSUB(j)  (1280 + 64 * (j))
#define XB_XGEN(j)  (2304 + 64 * (j))
#define XB_TOP      3328
#define XB_TOPGEN   3392
#define XCD_BAR_WORDS 3456
#define XB_SPIN_CAP (1u << 18)

__device__ __forceinline__ unsigned xb_ld(unsigned* p)              { return __hip_atomic_load(p, __ATOMIC_RELAXED, __HIP_MEMORY_SCOPE_AGENT); }
__device__ __forceinline__ unsigned xb_add(unsigned* p, unsigned v) { return __hip_atomic_fetch_add(p, v, __ATOMIC_RELAXED, __HIP_MEMORY_SCOPE_AGENT); }
__device__ __forceinline__ unsigned xb_xcc_id() { return (unsigned)__builtin_amdgcn_s_getreg((3 << 11) | 20) & 0xFu; }
#define XB_SPIN(cond, bar) do { unsigned _sp = 0; while (cond) { __builtin_amdgcn_s_sleep(1); \
    if ((++_sp & 255u) == 0u) { if (xb_ld(&(bar)[XB_TMO])) break; if (_sp > XB_SPIN_CAP) { atomicAdd(&(bar)[XB_TMO], 1u); break; } } } } while (0)

struct XcdBarrier {
    unsigned* bar; unsigned x;
    volatile LAS unsigned* st;
};

__device__ __forceinline__ XcdBarrier xcd_barrier_post(unsigned* bar, volatile LAS unsigned* st) {
    XcdBarrier b; b.bar = bar; b.x = xb_xcc_id(); b.st = st;
    if (threadIdx.x == 0) (void)xb_add(&bar[XB_XCNT(b.x)], 1u);
    return b;
}
__device__ __forceinline__ void xcd_barrier_complete(unsigned* bar, unsigned x, unsigned& nloc, unsigned& nx) {
    const unsigned G = gridDim.x * gridDim.y * gridDim.z;
    unsigned sum, cnt, mine, sp = 0u;
    for (;;) {
        sum = 0u; cnt = 0u; mine = 0u;
#pragma unroll
        for (unsigned j = 0; j < 16; ++j) { const unsigned c = xb_ld(&bar[XB_XCNT(j)]); sum += c; cnt += (c > 0u) ? 1u : 0u; mine = (j == x) ? c : mine; }
        if (sum == G) break;
        __builtin_amdgcn_s_sleep(1);
        if ((++sp & 255u) == 0u) { if (xb_ld(&bar[XB_TMO])) break; if (sp > XB_SPIN_CAP) { atomicAdd(&bar[XB_TMO], 1u); break; } }
    }
    nloc = mine > 0u ? mine : 1u; nx = cnt > 0u ? cnt : 1u;
}

__device__ __forceinline__ void xcd_barrier(const XcdBarrier& b) {
    asm volatile("s_waitcnt vmcnt(0)" ::: "memory");
    __syncthreads();
    if (threadIdx.x == 0) {
        unsigned* bar = b.bar;
        __builtin_amdgcn_s_waitcnt(0);
        unsigned nloc = b.st[0], nx = b.st[1];
        if (nloc == 0u) { xcd_barrier_complete(bar, b.x, nloc, nx); b.st[0] = nloc; b.st[1] = nx; }
        const unsigned old = xb_add(&bar[XB_XSUB(b.x)], 1u);
        const unsigned gen = old / nloc;
        if (old + 1u == (gen + 1u) * nloc) {
            __builtin_amdgcn_fence(__ATOMIC_RELEASE, "agent");
            asm volatile("s_waitcnt vmcnt(0)" ::: "memory");
            const unsigned og = xb_add(&bar[XB_TOP], 1u);
            const unsigned tg = og / nx;
            if (og + 1u == (tg + 1u) * nx) xb_add(&bar[XB_TOPGEN], 1u);
            else XB_SPIN(xb_ld(&bar[XB_TOPGEN]) == tg, bar);
            __builtin_amdgcn_fence(__ATOMIC_ACQUIRE, "agent");
            xb_add(&bar[XB_XGEN(b.x)], 1u);
            asm volatile("s_waitcnt vmcnt(0)" ::: "memory");
        } else {
            XB_SPIN(xb_ld(&bar[XB_XGEN(b.x)]) == gen, bar);
            __builtin_amdgcn_fence(__ATOMIC_ACQUIRE, "agent");
            asm volatile("s_waitcnt vmcnt(0)" ::: "memory");
        }
    }
    __syncthreads();
}

constexpr size_t WS_BAR = 768 * 1024;
constexpr int LDS_ST_OFF = 131072 + 64;

#define IN(k) (lo <= (k) && (k) < hi)
#ifdef PROBE_SEL
#define SEAM(k) do { if (IN(k) && IN((k) + 1)) { xcd_barrier(xbar); } if (blockIdx.x == 0 && threadIdx.x == 0) ((unsigned long long*)(a.ws + WS_CTL + 512 * 1024))[(k) + 1] = __builtin_amdgcn_s_memrealtime(); } while (0)
#else
#define SEAM(k) do { if (IN(k) && IN((k) + 1)) { xcd_barrier(xbar); } } while (0)
#endif
#define GEMM(EPI, E, Aptr, Bptr, M_, N_, K_, S_, SLOTS_, CID_) GEMMS(EPI, E, Aptr, Bptr, M_, N_, K_, S_, SLOTS_, CID_, 0)
#define GEMMS(EPI, E, Aptr, Bptr, M_, N_, K_, S_, SLOTS_, CID_, SEGK_) do { pg8::Gemm g_{(const pg8::bf16_t*)(Aptr), (const pg8::bf16_t*)(Bptr), M_, N_, K_}; pg8::HybridOrder S_o; \
        S_o.init(M_, N_, K_, G, (int)blockIdx.x, S_, (float*)(SLOTS_), (unsigned*)(ws + WS_CTL) + (CID_) * 2048); \
        S_o.segk = SEGK_; pg8::gemm_phase<EPI, pg8::HybridOrder, true, true>(lds, g_, S_o, E); } while (0)
template <int l>
__device__ __forceinline__ void layer_phases(const Args& a, LAS unsigned char* lds, cg::grid_group& grid, const XcdBarrier& xbar, int lo, int hi) {
    const int G = gridDim.x; float* Y = a.out + O_Y;
        const int pb = 2 + 9 * l;
        int tid_l = threadIdx.x; asm volatile("" : "+v"(tid_l));
        unsigned char* ws = a.ws; asm volatile("" : "+s"(ws));
        const int tid = tid_l, lane = tid & 63, wave = __builtin_amdgcn_readfirstlane(tid >> 6), gw = blockIdx.x * 8 + wave, gtid = blockIdx.x * 512 + tid;
        float* mod = (float*)(ws + WS_MOD); bf16* Hb = (bf16*)(ws + WS_H); bf16* Pb = (bf16*)(ws + WS_P); float* MG = (float*)(ws + WS_MG); float* Xb = (float*)(ws + WS_X);
        const unsigned char* wl = ws + WS_WL + (size_t)l * WL_STRIDE;
        const float* xp = l == 0 ? a.in[I_XP] : Xb; const float* xs = l == 0 ? a.in[I_XS] : Xb + (size_t)NPTOK * DM;
        float* xout = l == 0 ? Xb : Y;
#ifndef NO_NORM
        if (IN(pb + 0)) norm_mod_phase(xp, xs, a.in[I_NORM1] + l * DM, mod, l, 0, Hb);
#endif
        SEAM(pb + 0);
#ifndef NO_G1
        if (IN(pb + 1)) { pg8::EpiP E{Pb}; GEMM(pg8::EpiP, E, Hb, wl + WL_IN, NTOK, IN_DIM, DM, SK_G1, ws + WS_WADA, 1 + 8 * l); }
#endif
        SEAM(pb + 1);
#ifndef NO_MIX
        if (IN(pb + 3)) mixer_phase(a, l, lds);
#endif
        SEAM(pb + 3);
#ifndef NO_MERGE
        if (IN(pb + 4)) {
            { pg8::EpiGlu E{(pg8::bf16_t*)MG, Pb}; GEMM(pg8::EpiGlu, E, ws + WS_YS, wl + WL_GA, NTOK, 2 * DM, 512, 1, ws + WS_WADA, 2 + 8 * l); }
            { pg8::EpiMergeMain E{(const pg8::bf16_t*)MG, Pb, Hb}; GEMMS(pg8::EpiMergeMain, E, ws + WS_O, wl + WL_O, NTOK, DM, 1536, 1, ws + WS_WADA, 3 + 8 * l, 16); }
        }
#endif
        SEAM(pb + 4);
#ifndef NO_REST
        if (IN(pb + 5)) { pg8::EpiResid E{xp, xs, mod + l * ADA_N + 2 * DM, Y}; GEMM(pg8::EpiResid, E, Hb, wl + WL_OUT, NTOK, DM, DM, SK_WO, ws + WS_WADA, 6 + 8 * l); }
        SEAM(pb + 5);
        if (IN(pb + 6)) norm_mod_phase(Y, Y + (size_t)NPTOK * DM, a.in[I_NORM2] + l * DM, mod, l, 1, Hb);
        SEAM(pb + 6);
        if (IN(pb + 7)) { pg8::EpiRelu2 E{Pb}; GEMM(pg8::EpiRelu2, E, Hb, wl + WL_F1, NTOK, FF, DM, SK_F1, ws + WS_WADA, 7 + 8 * l); }
        SEAM(pb + 7);
        if (IN(pb + 8)) { pg8::EpiResid E{Y, Y + (size_t)NPTOK * DM, mod + l * ADA_N + 5 * DM, xout}; GEMM(pg8::EpiResid, E, Pb, wl + WL_F2, NTOK, DM, FF, SK_F2, ws + WS_WADA, 8 + 8 * l); }
#endif
        SEAM(pb + 8);
}

__global__ void __launch_bounds__(512, 2) hybrid_fwd(Args a) {
    extern __shared__ __attribute__((aligned(16))) unsigned char lds_raw[];
    LAS unsigned char* lds = (LAS unsigned char*)lds_raw;
    cg::grid_group grid = cg::this_grid();
    const int tid = threadIdx.x, lane = tid & 63, wave = __builtin_amdgcn_readfirstlane(tid >> 6);
    const int G = gridDim.x, gw = blockIdx.x * 8 + wave, NGW = G * 8, gtid = blockIdx.x * 512 + tid, NGT = G * 512;
    unsigned char* ws = a.ws;
    const int lo = a.ph_lo, hi = a.ph_hi;
    if (threadIdx.x < 4) ((LAS unsigned*)(lds + LDS_ST_OFF))[threadIdx.x] = 0u;
    __syncthreads();
    if (a.ph_lo < 0) grid.sync();
    const XcdBarrier xbar = xcd_barrier_post((unsigned*)(a.ws + WS_CTL + WS_BAR), (volatile LAS unsigned*)(lds + LDS_ST_OFF));
    float* mod = (float*)(ws + WS_MOD);
    bf16* Hb = (bf16*)(ws + WS_H); bf16* Pb = (bf16*)(ws + WS_P); float* MG = (float*)(ws + WS_MG); float* Xb = (float*)(ws + WS_X);
    float* Y = a.out + O_Y;
#ifdef PROBE_SEL
    if (blockIdx.x == 0 && threadIdx.x == 0) ((unsigned long long*)(a.ws + WS_CTL + 512 * 1024))[0] = __builtin_amdgcn_s_memrealtime();
#endif
#ifndef NO_P0
    if (IN(0)) { p0_prologue(a, lds, gw, NGW, lane, wave, gtid, NGT); __syncthreads(); }
#endif
    SEAM(0);
#ifndef NO_ADA
    if (IN(1)) { pg8::EpiAda E{mod, a.in[I_BADA]}; GEMM(pg8::EpiAda, E, ws + WS_AC, ws + WS_WADA, 256, 2 * ADA_N, DM, 1, ws + WS_X, 0); convert_idle(a, lds, 0, 96, I_L0_PRO, I_LAYER); }
#endif
    SEAM(1);
    layer_phases<0>(a, lds, grid, xbar, lo, hi);
    layer_phases<1>(a, lds, grid, xbar, lo, hi);
#ifdef PROBE_SEL
    grid.sync();
    if (blockIdx.x == 0 && threadIdx.x == 0) { const unsigned long long* ts = (const unsigned long long*)(a.ws + WS_CTL + 512 * 1024);
        const float us = (float)(ts[PROBE_SEL + 1] - ts[PROBE_SEL]) * 0.01f;
#if PROBE_SEL < 50
        atomicAdd(a.out + O_NIS + 5, us * 0.01f);
#endif
    }
#if PROBE_SEL >= 50
    { const unsigned long long t0 = __builtin_amdgcn_s_memrealtime(); grid.sync(); grid.sync(); grid.sync(); grid.sync(); const unsigned long long t1 = __builtin_amdgcn_s_memrealtime();
      if (blockIdx.x == 0 && threadIdx.x == 0) atomicAdd(a.out + O_NIS + 5, (float)(t1 - t0) * 0.01f * 0.01f); }
#endif
#endif
#undef IN
#undef SEAM
#undef GEMM
}

extern "C" void kernel_launch(void* const* d_in, const int* in_sizes, int n_in, void* d_out, int out_size, void* d_ws, size_t ws_size, hipStream_t stream) {
    static int grid = 0;
    if (grid == 0) {
        if (n_in != 36 || (size_t)out_size != O_END || ws_size < WS_END) { fprintf(stderr, "kernel_launch: unexpected sizes n_in %d out %d ws %zu (need %zu)\n", n_in, out_size, ws_size, (size_t)WS_END); grid = -1; return; }
        int dev = 0, cus = 0, per_cu = 0;
        (void)hipGetDevice(&dev); (void)hipDeviceGetAttribute(&cus, hipDeviceAttributeMultiprocessorCount, dev);
        if (hipFuncSetAttribute((const void*)hybrid_fwd, hipFuncAttributeMaxDynamicSharedMemorySize, LDS_BYTES) != hipSuccess) { fprintf(stderr, "kernel_launch: hipFuncSetAttribute failed\n"); grid = -1; return; }
        if (hipOccupancyMaxActiveBlocksPerMultiprocessor(&per_cu, (const void*)hybrid_fwd, 512, LDS_BYTES) != hipSuccess || per_cu < 1) { fprintf(stderr, "kernel_launch: occupancy query failed (%d)\n", per_cu); per_cu = 1; }
        (void)hipGetLastError();
        if (per_cu > 1) per_cu = 1;
        grid = cus * per_cu;
        fprintf(stderr, "kernel_launch: grid %d (cus %d)\n", grid, cus);
    }
    if (grid < 0) return;
    (void)hipMemsetAsync((char*)d_ws + WS_CTL, 0, CTL_BYTES, stream);
    Args a{};
    for (int i = 0; i < 36; ++i) a.in[i] = (const float*)d_in[i];
    a.out = (float*)d_out; a.ws = (unsigned char*)d_ws;
#if MK_ONE_LAUNCH
    a.ph_lo = 0; a.ph_hi = NPHASE;
    void* args[] = {&a};
    hipError_t e = hipLaunchCooperativeKernel((const void*)hybrid_fwd, dim3(grid), dim3(512), args, LDS_BYTES, stream);
    if (e != hipSuccess) fprintf(stderr, "kernel_launch: cooperative launch failed: %s (grid %d)\n", hipGetErrorString(e), grid);
#else
    for (int k = 0; k < NPHASE; ++k) { a.ph_lo = k; a.ph_hi = k + 1; hipLaunchKernelGGL(hybrid_fwd, dim3(grid), dim3(512), LDS_BYTES, stream, a); }
#endif
}
```

```cpp
#include <hip/hip_runtime.h>
#include <hip/hip_cooperative_groups.h>
#include <cstdio>
#include <cstdint>
namespace cg = cooperative_groups;
namespace pg8 {
#define PG8_LAS __attribute__((address_space(3)))
typedef unsigned short bf16_t;
typedef short bf16x8 __attribute__((ext_vector_type(8)));
typedef float f32x4 __attribute__((ext_vector_type(4)));
typedef unsigned u32x4 __attribute__((ext_vector_type(4)));
constexpr int BM = 256, BK = 64, HALF = 128, HTB = HALF * BK * 2  , STAGE_BYTES = 8 * HTB, NXCD = 8, WGM = 8;

__host__ __device__ __forceinline__ int lds_byte(int r, int c) { const int st = (r >> 4) * 2 + (c >> 5), rr = r & 15, cc = c & 31, ob = rr * 64 + cc * 2; return st * 1024 + (ob ^ (((ob >> 9) & 1) << 5)); }
__host__ __device__ __forceinline__ void stage_rc(int b, int& R, int& C) { const int st = b / 1024, sb = b % 1024, swz = sb ^ (((sb >> 9) & 1) << 5); R = (st >> 1) * 16 + swz / 64; C = (st & 1) * 32 + (swz % 64) / 2; }
__host__ __device__ __forceinline__ int perm32(int rho) { const int n = rho >> 4, i = rho & 15; return 8 * (i >> 2) + 4 * n + (i & 3); }

struct Unit { int pm, pn, k0, nt, tail, part, seg; };
struct Gemm { const bf16_t* A; const bf16_t* Bt; int M, N, K; };

struct HybridOrder {
    int nM, nN, nwg, G, c, R, ntail, S, ntk, npart, segk; float* slots; unsigned* cnt;
    __device__ void init(int M, int N, int K, int G_, int c_, int S_, float* slots_, unsigned* cnt_) { nM = M / BM; nN = N / BM; nwg = nM * nN; G = G_; c = c_; R = nwg / G; ntail = nwg - R * G;
        S = S_; ntk = K / BK; npart = ntk / S; slots = slots_; cnt = cnt_; segk = 0; }
    __device__ void tile_of(int L, Unit& u) const {
        int wgid = L; { const int q = nwg / NXCD, r = nwg % NXCD, xcd = wgid % NXCD, off = wgid / NXCD; wgid = (xcd < r ? xcd * (q + 1) : r * (q + 1) + (xcd - r) * q) + off; }
        const int nig = WGM * nN, gid = wgid / nig, fm = gid * WGM, gsz = (nM - fm) < WGM ? (nM - fm) : WGM;
        u.pm = fm + ((wgid % nig) % gsz); u.pn = (wgid % nig) / gsz;
    }
    __device__ bool next(int i2, Unit& u) const {
        const int i = segk ? (i2 >> 1) : i2, sg = segk ? (i2 & 1) : 0;
        u.seg = 0;
        if (i < R) { tile_of(i * G + c, u); u.k0 = 0; u.nt = ntk; u.tail = -1; u.part = 0; }
        else if (i == R && c < ntail * S) { const int j = c % ntail, p = c / ntail; tile_of(R * G + j, u); u.k0 = p * npart; u.nt = npart; u.tail = S > 1 ? j : -1; u.part = p; }
        else return false;
        if (segk) { if (sg == 0) { u.nt = segk; u.seg = 1; } else { u.k0 = segk; u.nt = ntk - segk; } }
        return true;
    }
    __device__ __forceinline__ void a_ready(const Unit&) const {}
    __device__ __forceinline__ void done(const Unit&) const {}
};

__device__ __forceinline__ unsigned cvt_pk_bf16(float lo, float hi) { unsigned r; asm volatile("v_cvt_pk_bf16_f32 %0, %1, %2" : "=v"(r) : "v"(lo), "v"(hi)); return r; }
typedef float f32x2 __attribute__((ext_vector_type(2)));
template <int NS, class Sched>
__device__ __forceinline__ unsigned tail_exchange_t(f32x4 (&acc)[2][2][4][2], const Unit& u, const Sched& S, int tid) {
    constexpr int RS = 32 / NS; const int part = u.part;
    float* base = S.slots + (size_t)(u.tail * NS) * 65536 + tid * 4;
    float* mine = base + (size_t)part * 65536;
#pragma unroll
    for (int ai = 0; ai < 2; ++ai)
#pragma unroll
        for (int m = 0; m < 4; ++m)
#pragma unroll
            for (int bj = 0; bj < 2; ++bj)
#pragma unroll
                for (int n = 0; n < 2; ++n) { const int r = ((ai * 4 + m) * 2 + bj) * 2 + n; const f32x4 v = acc[ai][bj][m][n]; const float* q = mine + r * 2048;
                    asm volatile("global_store_dwordx4 %0, %1, off sc1" :: "v"(q), "v"(v) : "memory"); }
    asm volatile("s_waitcnt vmcnt(0)" ::: "memory");
    __builtin_amdgcn_s_barrier();
    if (tid == 0) { unsigned* cw = S.cnt + u.tail * 16; __hip_atomic_fetch_add(cw, 1u, __ATOMIC_RELAXED, __HIP_MEMORY_SCOPE_AGENT);
        unsigned sp = 0; while (__hip_atomic_load(cw, __ATOMIC_RELAXED, __HIP_MEMORY_SCOPE_AGENT) < (unsigned)NS) { __builtin_amdgcn_s_sleep(2); if (++sp > (1u << 22)) break; } }
    asm volatile("s_waitcnt vmcnt(0) lgkmcnt(0)" ::: "memory");
    __builtin_amdgcn_s_barrier();
    asm volatile("" ::: "memory");
#pragma unroll
    for (int ai = 0; ai < 2; ++ai)
#pragma unroll
        for (int m = 0; m < 4; ++m)
#pragma unroll
            for (int bj = 0; bj < 2; ++bj)
#pragma unroll
                for (int n = 0; n < 2; ++n) { const int r = ((ai * 4 + m) * 2 + bj) * 2 + n;
                    if (r / RS == part) { f32x4 pv[NS];
#pragma unroll
                        for (int pp = 0; pp < NS; ++pp) { const float* q = base + (size_t)pp * 65536 + r * 2048; asm volatile("global_load_dwordx4 %0, %1, off sc1" : "=v"(pv[pp]) : "v"(q) : "memory"); }
                        if constexpr (NS == 16) asm volatile("s_waitcnt vmcnt(0)" : "+v"(pv[0]), "+v"(pv[1]), "+v"(pv[2]), "+v"(pv[3]), "+v"(pv[4]), "+v"(pv[5]), "+v"(pv[6]), "+v"(pv[7]), "+v"(pv[8 % NS]), "+v"(pv[9 % NS]), "+v"(pv[10 % NS]), "+v"(pv[11 % NS]), "+v"(pv[12 % NS]), "+v"(pv[13 % NS]), "+v"(pv[14 % NS]), "+v"(pv[15 % NS]) :: "memory");
                        else if constexpr (NS == 8) asm volatile("s_waitcnt vmcnt(0)" : "+v"(pv[0]), "+v"(pv[1]), "+v"(pv[2 % NS]), "+v"(pv[3 % NS]), "+v"(pv[4 % NS]), "+v"(pv[5 % NS]), "+v"(pv[6 % NS]), "+v"(pv[7 % NS]) :: "memory");
                        else if constexpr (NS == 4) asm volatile("s_waitcnt vmcnt(0)" : "+v"(pv[0]), "+v"(pv[1]), "+v"(pv[2 % NS]), "+v"(pv[3 % NS]) :: "memory");
                        else asm volatile("s_waitcnt vmcnt(0)" : "+v"(pv[0]), "+v"(pv[1]) :: "memory");
                        f32x4 s = pv[0];
#pragma unroll
                        for (int pp = 1; pp < NS; ++pp) s += pv[pp];
                        acc[ai][bj][m][n] = s; } }
    return (RS >= 32 ? 0xffffffffu : ((1u << RS) - 1u)) << (part * RS);
}
template <class Sched>
__device__ __forceinline__ unsigned tail_exchange(f32x4 (&acc)[2][2][4][2], const Unit& u, const Sched& S, int tid) {
    if (S.S == 8) return tail_exchange_t<8>(acc, u, S, tid);
    if (S.S == 16) return tail_exchange_t<16>(acc, u, S, tid);
    if (S.S == 2) return tail_exchange_t<2>(acc, u, S, tid);
    return tail_exchange_t<4>(acc, u, S, tid);
}
template <class Epi, class Sched, bool ALIGN_EPI = false, bool SP2 = false>
__device__ __forceinline__ void gemm_phase(PG8_LAS unsigned char* lds, const Gemm g, const Sched& S, const Epi& E) {
    int tid_ = threadIdx.x; asm volatile("" : "+v"(tid_));
    const int tid = tid_, wid = __builtin_amdgcn_readfirstlane(tid >> 6), lane = tid & 63, wr = wid >> 2, wc = wid & 3, fr = lane & 15, fq = lane >> 4;
    const int K = g.K;
    unsigned voffA[2], voffB[2];
#pragma unroll
    for (int i = 0; i < 2; ++i) { int R, C; stage_rc(tid * 16 + i * 8192, R, C); const int Rb = Epi::PERM ? ((R & ~31) + perm32(R & 31)) : R;
        voffA[i] = (unsigned)(R * K + C) * 2u; voffB[i] = (unsigned)(Rb * K + C) * 2u; }
    const size_t kstep = (size_t)(BK * 2);
    const size_t hstep = (size_t)HALF * K * 2;
    const size_t tstep = 2 * hstep;
    const unsigned ldsw = (unsigned)wid * 1024u;
    const int aoff = lds_byte(wr * 64 + fr, fq * 8), boff = lds_byte(wc * 32 + fr, fq * 8);
#define PG8_SA(b, h) (((b) * 2 + (h)) * HTB)
#define PG8_SB(b, h) ((4 + (b) * 2 + (h)) * HTB)
#define PG8_STAGE(bufoff, gbase, voff) do { _Pragma("unroll") for (int _i = 0; _i < 2; ++_i) \
        __builtin_amdgcn_global_load_lds((const unsigned*)((const char*)(gbase) + (voff)[_i]), (PG8_LAS unsigned*)(lds + (bufoff) + ldsw + _i * 8192), 16, 0, 0); } while (0)
#define PG8_LDA(dst, b, h) do { _Pragma("unroll") for (int m = 0; m < 4; ++m) _Pragma("unroll") for (int k = 0; k < 2; ++k) dst[m][k] = *(const PG8_LAS bf16x8*)(lds + PG8_SA(b, h) + aoff + m * 2048 + k * 1024); } while (0)
#define PG8_LDB(dst, b, h) do { _Pragma("unroll") for (int n = 0; n < 2; ++n) _Pragma("unroll") for (int k = 0; k < 2; ++k) dst[n][k] = *(const PG8_LAS bf16x8*)(lds + PG8_SB(b, h) + boff + n * 2048 + k * 1024); } while (0)
#define PG8_MMA(ai, bj, At, Bt) do { __builtin_amdgcn_s_setprio(1); _Pragma("unroll") for (int m = 0; m < 4; ++m) _Pragma("unroll") for (int n = 0; n < 2; ++n) _Pragma("unroll") for (int k = 0; k < 2; ++k) \
        acc[ai][bj][m][n] = __builtin_amdgcn_mfma_f32_16x16x32_bf16(Bt[n][k], At[m][k], acc[ai][bj][m][n], 0, 0, 0); __builtin_amdgcn_s_setprio(0); } while (0)
#define PG8_WAIT_V(n) asm volatile("s_waitcnt vmcnt(" #n ")" ::: "memory")
#define PG8_WAIT_L(n) asm volatile("s_waitcnt lgkmcnt(" #n ")" ::: "memory")
#define PG8_BAR __builtin_amdgcn_s_barrier()
#define PG8_SCHED __builtin_amdgcn_sched_barrier(0)
    Unit cur, nxt; int ui = 0;
    if (!S.next(0, cur)) return;
    f32x4 acc[2][2][4][2];
#pragma unroll
    for (int a = 0; a < 2; ++a)
#pragma unroll
        for (int b = 0; b < 2; ++b)
#pragma unroll
            for (int m = 0; m < 4; ++m)
#pragma unroll
                for (int n = 0; n < 2; ++n) acc[a][b][m][n] = (f32x4){0.f, 0.f, 0.f, 0.f};
    bf16x8 At[4][2], B0[2][2], B1[2][2];
    const char* cA = (const char*)g.A + (size_t)cur.pm * tstep + (size_t)cur.k0 * kstep; const char* cB = (const char*)g.Bt + (size_t)cur.pn * tstep + (size_t)cur.k0 * kstep;
    S.a_ready(cur);
    if constexpr (SP2) {
        PG8_STAGE(PG8_SB(0, 0), cB, voffB); PG8_STAGE(PG8_SB(0, 1), cB + hstep, voffB); PG8_STAGE(PG8_SA(0, 0), cA, voffA); PG8_STAGE(PG8_SA(0, 1), cA + hstep, voffA);
        if (wr == 1) PG8_BAR;
        PG8_WAIT_V(2); PG8_BAR;
        PG8_STAGE(PG8_SB(1, 0), cB + kstep, voffB); PG8_STAGE(PG8_SA(1, 0), cA + kstep, voffA); PG8_STAGE(PG8_SB(1, 1), cB + hstep + kstep, voffB);
        PG8_WAIT_V(6); PG8_BAR;
    } else {
        PG8_STAGE(PG8_SB(0, 0), cB, voffB); PG8_STAGE(PG8_SA(0, 0), cA, voffA); PG8_STAGE(PG8_SB(0, 1), cB + hstep, voffB); PG8_STAGE(PG8_SA(0, 1), cA + hstep, voffA);
        if (wr == 1) PG8_BAR;
        PG8_WAIT_V(4); PG8_BAR;
        PG8_STAGE(PG8_SB(1, 0), cB + kstep, voffB); PG8_STAGE(PG8_SA(1, 0), cA + kstep, voffA); PG8_STAGE(PG8_SB(1, 1), cB + hstep + kstep, voffB);
        PG8_WAIT_V(6); PG8_BAR;
    }
    for (;;) {
        const bool has_next = S.next(ui + 1, nxt);
        const char* nA = has_next ? (const char*)g.A + (size_t)nxt.pm * tstep + (size_t)nxt.k0 * kstep : cA; const char* nB = has_next ? (const char*)g.Bt + (size_t)nxt.pn * tstep + (size_t)nxt.k0 * kstep : cB;
        const int nt = cur.nt;
        for (int t = 0; t < nt; t += 2) {
            const bool last = (t == nt - 2);
            const char* a1 = cA + (size_t)(t + 1) * kstep;
            const char* a2 = last ? nA : cA + (size_t)(t + 2) * kstep; const char* b2 = last ? nB : cB + (size_t)(t + 2) * kstep;
            const char* a3 = a2 + kstep; const char* b3 = b2 + kstep;
            if (last && has_next) S.a_ready(nxt);
            if constexpr (SP2) {
            PG8_LDB(B0, 0, 0); PG8_LDB(B1, 0, 1); PG8_SCHED; PG8_LDA(At, 0, 0); PG8_STAGE(PG8_SA(1, 1), a1 + hstep, voffA);
            PG8_WAIT_V(8); PG8_WAIT_L(0); PG8_BAR; PG8_MMA(0, 0, At, B0); PG8_MMA(0, 1, At, B1); PG8_BAR; PG8_SCHED;
            PG8_LDA(At, 0, 1); PG8_STAGE(PG8_SB(0, 0), b2, voffB); PG8_STAGE(PG8_SB(0, 1), b2 + hstep, voffB); PG8_STAGE(PG8_SA(0, 0), a2, voffA);
            PG8_WAIT_V(8); PG8_WAIT_L(0); PG8_BAR; PG8_MMA(1, 0, At, B0); PG8_MMA(1, 1, At, B1); PG8_BAR; PG8_SCHED;
            PG8_LDB(B0, 1, 0); PG8_LDB(B1, 1, 1); PG8_SCHED; PG8_LDA(At, 1, 0); PG8_STAGE(PG8_SA(0, 1), a2 + hstep, voffA);
            PG8_WAIT_V(8); PG8_WAIT_L(0); PG8_BAR; PG8_MMA(0, 0, At, B0); PG8_MMA(0, 1, At, B1); PG8_BAR; PG8_SCHED;
            PG8_LDA(At, 1, 1); PG8_STAGE(PG8_SB(1, 0), b3, voffB); PG8_STAGE(PG8_SB(1, 1), b3 + hstep, voffB); PG8_STAGE(PG8_SA(1, 0), a3, voffA);
            PG8_WAIT_V(8); PG8_WAIT_L(0); PG8_BAR; PG8_MMA(1, 0, At, B0); PG8_MMA(1, 1, At, B1); PG8_BAR; PG8_SCHED;
            } else {
            PG8_LDB(B0, 0, 0); PG8_SCHED; PG8_LDA(At, 0, 0); PG8_STAGE(PG8_SA(1, 1), a1 + hstep, voffA);
            PG8_WAIT_L(8); PG8_BAR; PG8_WAIT_L(0); PG8_MMA(0, 0, At, B0); PG8_BAR; PG8_SCHED;
            PG8_LDB(B1, 0, 1); PG8_STAGE(PG8_SB(0, 0), b2, voffB);
            PG8_BAR; PG8_WAIT_L(0); PG8_MMA(0, 1, At, B1); PG8_BAR;
            PG8_LDA(At, 0, 1); PG8_STAGE(PG8_SA(0, 0), a2, voffA);
            PG8_BAR; PG8_WAIT_L(0); PG8_MMA(1, 0, At, B0); PG8_BAR; PG8_SCHED;
            PG8_STAGE(PG8_SB(0, 1), b2 + hstep, voffB);
            PG8_WAIT_V(6); PG8_BAR; PG8_MMA(1, 1, At, B1); PG8_BAR;
            PG8_LDB(B0, 1, 0); PG8_SCHED; PG8_LDA(At, 1, 0); PG8_STAGE(PG8_SA(0, 1), a2 + hstep, voffA);
            PG8_WAIT_L(8); PG8_BAR; PG8_WAIT_L(0); PG8_MMA(0, 0, At, B0); PG8_BAR; PG8_SCHED;
            PG8_LDB(B1, 1, 1); PG8_STAGE(PG8_SB(1, 0), b3, voffB);
            PG8_BAR; PG8_WAIT_L(0); PG8_MMA(0, 1, At, B1); PG8_BAR;
            PG8_LDA(At, 1, 1); PG8_STAGE(PG8_SA(1, 0), a3, voffA);
            PG8_BAR; PG8_WAIT_L(0); PG8_MMA(1, 0, At, B0); PG8_BAR; PG8_SCHED;
            PG8_STAGE(PG8_SB(1, 1), b3 + hstep, voffB);
            PG8_WAIT_V(6); PG8_BAR; PG8_MMA(1, 1, At, B1); PG8_BAR;
            }
        }
        if constexpr (ALIGN_EPI) { if (wr == 0) PG8_BAR; }
        if (cur.seg == 1) { if constexpr (Epi::MID_T > 0) E.mid(acc, cur, wr, wc, fr, fq); }
        else { unsigned rmask = 0xffffffffu; if (cur.tail >= 0) rmask = tail_exchange(acc, cur, S, tid); E(acc, cur, wr, wc, fr, fq, rmask); }
        if (!has_next) break;
        if (cur.seg != 1)
#pragma unroll
        for (int a = 0; a < 2; ++a)
#pragma unroll
            for (int b = 0; b < 2; ++b)
#pragma unroll
                for (int m = 0; m < 4; ++m)
#pragma unroll
                    for (int n = 0; n < 2; ++n) acc[a][b][m][n] = (f32x4){0.f, 0.f, 0.f, 0.f};
        cur = nxt; cA = nA; cB = nB; ++ui;
        if constexpr (ALIGN_EPI) { if (wr == 1) PG8_BAR; }
    }
    PG8_WAIT_V(0);
    if constexpr (!ALIGN_EPI) { if (wr == 0) PG8_BAR; }
    PG8_BAR;
#undef PG8_SA
#undef PG8_SB
#undef PG8_STAGE
#undef PG8_LDA
#undef PG8_LDB
#undef PG8_MMA
#undef PG8_WAIT_V
#undef PG8_WAIT_L
#undef PG8_BAR
#undef PG8_SCHED
}
}

#define LAS __attribute__((address_space(3)))
typedef unsigned short bf16;
typedef unsigned v4u __attribute__((ext_vector_type(4)));
typedef unsigned v2u __attribute__((ext_vector_type(2)));
typedef float f32x4 __attribute__((ext_vector_type(4)));
typedef float f32x2 __attribute__((ext_vector_type(2)));
typedef short bf16x8 __attribute__((ext_vector_type(8)));
typedef short s16x4 __attribute__((ext_vector_type(4)));

#ifndef MK_ONE_LAUNCH
#define MK_ONE_LAUNCH 1
#endif

constexpr int DM = 2048, NTOK = 9216, NPTOK = 8192, SEQ = 2048, NB = 4, DECB = 128, DECT = 8;
constexpr int IN_DIM = 9216, FF = 8192, ADA_N = 12288;
constexpr int C_K = 1024, C_V = 1280, C_XA = 1536, C_XB = 2048, C_XS = 2560, C_G = 3072;
constexpr int NMODROW = 132;
constexpr int NPHASE = 20;
constexpr int SK_G1 = 16, SK_MG = 1, SK_WO = 8, SK_F1 = 2, SK_F2 = 8;

constexpr size_t MiB = 1u << 20;
constexpr size_t WS_CTL = 0, CTL_BYTES = 1 * MiB;
constexpr size_t WS_ROPE = 1 * MiB, WS_AC = 2 * MiB, WS_MOD = 3 * MiB, WS_WADA = 16 * MiB;
constexpr size_t WS_WL = 112 * MiB, WL_STRIDE = 118 * MiB;
constexpr size_t WL_IN = 0, WL_O = 36 * MiB, WL_CO = 40 * MiB, WL_GA = 42 * MiB, WL_GB = 44 * MiB, WL_OUT = 46 * MiB, WL_F1 = 54 * MiB, WL_F2 = 86 * MiB;
constexpr size_t WS_H = 348 * MiB;
constexpr size_t WS_P = 384 * MiB;
constexpr size_t WS_QN = 546 * MiB, WS_KN = 564 * MiB, WS_O = 569 * MiB, WS_YC = 587 * MiB, WS_YS = 596 * MiB;
constexpr size_t WS_MG = 605 * MiB;
constexpr size_t WS_X = 677 * MiB;
constexpr size_t WS_SLOT2 = 749 * MiB;
constexpr size_t WS_END = 781 * MiB;

constexpr size_t O_Y = 0;
constexpr size_t O_NKP = (size_t)NTOK * DM;
constexpr size_t O_NVP = O_NKP + 2 * 4 * 128 * 256;
constexpr size_t O_NCP = O_NVP + 2 * 4 * 128 * 256;
constexpr size_t O_NRP = O_NCP + 2 * 4 * 30 * 512;
constexpr size_t O_NIP = O_NRP + 2 * 4 * 32 * 64;
constexpr size_t O_NKS = O_NIP + 2 * 4 * 32 * 64;
constexpr size_t O_NVS = O_NKS + (size_t)2 * 128 * 128 * 256;
constexpr size_t O_NCS = O_NVS + (size_t)2 * 128 * 128 * 256;
constexpr size_t O_NRS = O_NCS + (size_t)2 * 128 * 30 * 512;
constexpr size_t O_NIS = O_NRS + (size_t)2 * 128 * 32 * 64;
constexpr size_t O_END = O_NIS + (size_t)2 * 128 * 32 * 64;

constexpr int LDS_BYTES = 135168;

struct Args { const float* in[36]; float* out; unsigned char* ws; int ph_lo, ph_hi; };

enum { I_XP = 0, I_XS, I_CP, I_CS, I_CK, I_CV, I_SCONV, I_SRE, I_SIM, I_WADA, I_BADA, I_NORM1, I_WIN, I_QN, I_KN, I_SINK, I_WO, I_CW, I_CB, I_CLG, I_CLB, I_WCO,
       I_ARE, I_AIM, I_LDT, I_BRE, I_BIM, I_CRE, I_CIM, I_SD, I_WGA, I_WGB, I_WOUT, I_NORM2, I_WF1, I_WF2 };

__device__ __forceinline__ float bf2f(unsigned b) { return __uint_as_float(b << 16); }
__device__ __forceinline__ unsigned f2bf(float f) { unsigned u = __float_as_uint(f); return (u + 0x7fffu + ((u >> 16) & 1u)) >> 16; }
__device__ __forceinline__ unsigned pk2(float lo, float hi) { return f2bf(lo) | (f2bf(hi) << 16); }
__device__ __forceinline__ float lo16(unsigned w) { return __uint_as_float(w << 16); }
__device__ __forceinline__ float hi16(unsigned w) { return __uint_as_float(w & 0xffff0000u); }
__device__ __forceinline__ float sigm(float x) { return __builtin_amdgcn_rcpf(1.f + __expf(-x)); }
__device__ __forceinline__ float wave_sum(float v) {
#pragma unroll
    for (int o = 1; o < 64; o <<= 1) v += __shfl_xor(v, o);
    return v;
}
#define LDS_WAIT() asm volatile("s_waitcnt lgkmcnt(0)" ::: "memory")
#define WAVE_SYNC() do { asm volatile("s_waitcnt lgkmcnt(0)" ::: "memory"); __builtin_amdgcn_wave_barrier(); asm volatile("" ::: "memory"); } while (0)

__device__ __forceinline__ double dexp_(double x) {
    const double kf = rint(x * 1.4426950408889634);
    double r = fma(-kf, 6.93147180369123816490e-01, x); r = fma(-kf, 1.90821492927058770002e-10, r);
    double p = 1.0 / 6227020800.0;
    p = fma(p, r, 1.0 / 479001600.0); p = fma(p, r, 1.0 / 39916800.0); p = fma(p, r, 1.0 / 3628800.0); p = fma(p, r, 1.0 / 362880.0);
    p = fma(p, r, 1.0 / 40320.0); p = fma(p, r, 1.0 / 5040.0); p = fma(p, r, 1.0 / 720.0); p = fma(p, r, 1.0 / 120.0);
    p = fma(p, r, 1.0 / 24.0); p = fma(p, r, 1.0 / 6.0); p = fma(p, r, 0.5); p = fma(p, r, 1.0); p = fma(p, r, 1.0);
    const long long k = (long long)kf;
    return p * __longlong_as_double((1023ll + k) << 52);
}
__device__ __forceinline__ void dsincos_(double x, double& sn, double& cs) {
    const double kf = rint(x * 0.15915494309189535);
    double r = fma(-kf, 6.283185307179586, x); r = fma(-kf, 2.4492935982947064e-16, r);
    const double s = r * 0.125, z = s * s;
    double ps = -1.0 / 355687428096000.0;
    ps = fma(ps, z, 1.0 / 1307674368000.0); ps = fma(ps, z, -1.0 / 6227020800.0); ps = fma(ps, z, 1.0 / 39916800.0); ps = fma(ps, z, -1.0 / 362880.0);
    ps = fma(ps, z, 1.0 / 5040.0); ps = fma(ps, z, -1.0 / 120.0); ps = fma(ps, z, 1.0 / 6.0);
    double a = s - s * z * ps;
    double pc = 1.0 / 20922789888000.0;
    pc = fma(pc, z, -1.0 / 87178291200.0); pc = fma(pc, z, 1.0 / 479001600.0); pc = fma(pc, z, -1.0 / 3628800.0); pc = fma(pc, z, 1.0 / 40320.0);
    pc = fma(pc, z, -1.0 / 720.0); pc = fma(pc, z, 1.0 / 24.0); pc = fma(pc, z, -0.5);
    double b = fma(pc, z, 1.0);
#pragma unroll
    for (int i = 0; i < 3; ++i) { const double a2 = 2.0 * a * b, b2 = 1.0 - 2.0 * a * a; a = a2; b = b2; }
    sn = a; cs = b;
}

namespace pg8 {
#define EPI_FOREACH4(...) \
    _Pragma("unroll") for (int ai = 0; ai < 2; ++ai) _Pragma("unroll") for (int m = 0; m < 4; ++m) { const int row = u.pm * BM + ai * HALF + wr * 64 + m * 16 + fr; \
    _Pragma("unroll") for (int bj = 0; bj < 2; ++bj) _Pragma("unroll") for (int n = 0; n < 2; ++n) { const int col = u.pn * BM + bj * HALF + wc * 32 + n * 16 + 4 * fq; const f32x4 v = acc[ai][bj][m][n]; if ((rmask >> (((ai * 4 + m) * 2 + bj) * 2 + n)) & 1u) { __VA_ARGS__ } } if (m & 1) { asm volatile("" ::: "memory"); __builtin_amdgcn_sched_barrier(0); } }
#define EPI_FOREACH8(...) \
    _Pragma("unroll") for (int ai = 0; ai < 2; ++ai) _Pragma("unroll") for (int m = 0; m < 4; ++m) { const int row = u.pm * BM + ai * HALF + wr * 64 + m * 16 + fr; \
    _Pragma("unroll") for (int bj = 0; bj < 2; ++bj) { const int col = u.pn * BM + bj * HALF + wc * 32 + 8 * fq; const f32x4 v0 = acc[ai][bj][m][0], v1 = acc[ai][bj][m][1]; if ((rmask >> (((ai * 4 + m) * 2 + bj) * 2)) & 1u) { __VA_ARGS__ } } if (m & 1) { asm volatile("" ::: "memory"); __builtin_amdgcn_sched_barrier(0); } }
#define EPI_SIG const f32x4 (&acc)[2][2][4][2], const Unit& u, int wr, int wc, int fr, int fq, unsigned rmask

__device__ __forceinline__ int mod_row(int row) { return row < NPTOK ? (row >> 11) : 4 + ((row - NPTOK) >> 3); }
__device__ __forceinline__ v4u pack8(const f32x4 a, const f32x4 b) { v4u w; w.x = cvt_pk_bf16(a[0], a[1]); w.y = cvt_pk_bf16(a[2], a[3]); w.z = cvt_pk_bf16(b[0], b[1]); w.w = cvt_pk_bf16(b[2], b[3]); return w; }

struct EpiAda {
    static constexpr bool PERM = false, AFTER_DRAIN = false; static constexpr int MID_T = -1; float* mod; const float* bias;
    __device__ __forceinline__ void operator()(EPI_SIG) const {
        EPI_FOREACH4( if (row < NMODROW) { const f32x4 bv = *(const f32x4*)(bias + col); *(f32x4*)(mod + row * (2 * ADA_N) + col) = v + bv; } )
    }
};
struct EpiP {
    static constexpr bool PERM = true, AFTER_DRAIN = false; static constexpr int MID_T = -1; bf16_t* P;
    __device__ __forceinline__ void operator()(EPI_SIG) const {
        const bool sg = (u.pn * BM) >= C_G;
        EPI_FOREACH8( f32x4 a = v0, b = v1; if (sg) {
            _Pragma("unroll") for (int i = 0; i < 4; ++i) { a[i] = sigm(a[i]); b[i] = sigm(b[i]); } }
            *(v4u*)(P + (unsigned)(row * IN_DIM + col)) = pack8(a, b); )
    }
};
struct EpiStoreF32 {
    static constexpr bool PERM = false, AFTER_DRAIN = false; static constexpr int MID_T = -1; float* MG;
    __device__ __forceinline__ void operator()(EPI_SIG) const { EPI_FOREACH4( *(f32x4*)(MG + (unsigned)(row * DM + col)) = v; ) }
};
__device__ __forceinline__ f32x4 gate4(const bf16_t* P, int row, int col, int br) {
    const v2u g = *(const v2u*)(P + (unsigned)(row * IN_DIM + C_G + br * DM + col)); return (f32x4){lo16(g.x), hi16(g.x), lo16(g.y), hi16(g.y)};
}
struct EpiGluB {
    static constexpr bool PERM = false, AFTER_DRAIN = false; static constexpr int MID_T = -1; float* MG; const bf16_t* P;
    __device__ __forceinline__ void operator()(EPI_SIG) const {
        EPI_FOREACH4( float* p = MG + (unsigned)(row * DM + col); const f32x4 a = *(const f32x4*)p; const f32x4 g = gate4(P, row, col, 2); f32x4 o;
            _Pragma("unroll") for (int i = 0; i < 4; ++i) o[i] = g[i] * a[i] * sigm(v[i]);
            *(f32x4*)p = o; )
    }
};
struct EpiAccG {
    static constexpr bool PERM = false, AFTER_DRAIN = false; static constexpr int MID_T = -1; float* MG; const bf16_t* P; int br;
    __device__ __forceinline__ void operator()(EPI_SIG) const {
        EPI_FOREACH4( float* p = MG + (unsigned)(row * DM + col); const f32x4 a = *(const f32x4*)p; const f32x4 g = gate4(P, row, col, br); *(f32x4*)p = a + g * v; )
    }
};
struct EpiMergeFinal {
    static constexpr bool PERM = false, AFTER_DRAIN = false; static constexpr int MID_T = -1; const float* MG; const bf16_t* P; bf16_t* MGb; int br;
    __device__ __forceinline__ void operator()(EPI_SIG) const {
        EPI_FOREACH4( const f32x4 a = *(const f32x4*)(MG + (unsigned)(row * DM + col)); const f32x4 g = gate4(P, row, col, br); const f32x4 o = a + g * v;
            v2u w; w.x = cvt_pk_bf16(o[0], o[1]); w.y = cvt_pk_bf16(o[2], o[3]); *(v2u*)(MGb + (unsigned)(row * DM + col)) = w; )
    }
};
struct EpiGlu {
    static constexpr bool PERM = false, AFTER_DRAIN = false; static constexpr int MID_T = -1; bf16_t* MGa; const bf16_t* P;
    __device__ __forceinline__ void operator()(EPI_SIG) const {
        _Pragma("unroll") for (int ai = 0; ai < 2; ++ai) _Pragma("unroll") for (int m = 0; m < 4; ++m) { const int row = u.pm * BM + ai * HALF + wr * 64 + m * 16 + fr;
            _Pragma("unroll") for (int bj = 0; bj < 2; ++bj) { if ((rmask >> (((ai * 4 + m) * 2 + bj) * 2)) & 1u) {
                const int j = u.pn * 128 + bj * 64 + wc * 16 + 4 * fq; const f32x4 av = acc[ai][bj][m][0], bv = acc[ai][bj][m][1]; const f32x4 g = gate4(P, row, j, 2); f32x4 o;
                _Pragma("unroll") for (int i = 0; i < 4; ++i) o[i] = g[i] * av[i] * sigm(bv[i]);
                v2u w; w.x = cvt_pk_bf16(o[0], o[1]); w.y = cvt_pk_bf16(o[2], o[3]); *(v2u*)(MGa + (unsigned)(row * DM + j)) = w; } }
            if (m & 1) { asm volatile("" ::: "memory"); __builtin_amdgcn_sched_barrier(0); } }
    }
};
struct EpiMergeMain {
    static constexpr bool PERM = false, AFTER_DRAIN = false; static constexpr int MID_T = 16; const bf16_t* MGa; const bf16_t* P; bf16_t* MGb;
    __device__ __forceinline__ void mid(f32x4 (&acc)[2][2][4][2], const Unit& u, int wr, int wc, int fr, int fq) const {
        _Pragma("unroll") for (int ai = 0; ai < 2; ++ai) _Pragma("unroll") for (int m = 0; m < 4; ++m) { const int row = u.pm * BM + ai * HALF + wr * 64 + m * 16 + fr;
            _Pragma("unroll") for (int bj = 0; bj < 2; ++bj) _Pragma("unroll") for (int n = 0; n < 2; ++n) { const int col = u.pn * BM + bj * HALF + wc * 32 + n * 16 + 4 * fq;
                const f32x4 g0 = gate4(P, row, col, 0), g1 = gate4(P, row, col, 1); f32x4 r;
                _Pragma("unroll") for (int i = 0; i < 4; ++i) r[i] = g0[i] * __builtin_amdgcn_rcpf(fmaxf(g1[i], 1e-30f));
                acc[ai][bj][m][n] = acc[ai][bj][m][n] * r; }
            if (m & 1) { asm volatile("" ::: "memory"); __builtin_amdgcn_sched_barrier(0); } }
    }
    __device__ __forceinline__ void operator()(EPI_SIG) const {
        EPI_FOREACH4( const f32x4 g1 = gate4(P, row, col, 1); const v2u mw = *(const v2u*)(MGa + (unsigned)(row * DM + col)); const f32x4 mg = (f32x4){lo16(mw.x), hi16(mw.x), lo16(mw.y), hi16(mw.y)};
            const f32x4 o = g1 * v + mg; v2u w; w.x = cvt_pk_bf16(o[0], o[1]); w.y = cvt_pk_bf16(o[2], o[3]); *(v2u*)(MGb + (unsigned)(row * DM + col)) = w; )
    }
};
struct EpiResid {
    static constexpr bool PERM = false, AFTER_DRAIN = false; static constexpr int MID_T = -1; const float* xp; const float* xs; const float* gate; float* out;
    __device__ __forceinline__ void operator()(EPI_SIG) const {
        const bool smp = u.pm * BM >= NPTOK; const float* xb = smp ? xs : xp; const int rb = smp ? NPTOK : 0;
        EPI_FOREACH4( const f32x4 x = *(const f32x4*)(xb + (unsigned)((row - rb) * DM + col));
            const int mr = smp ? 4 + ((row - NPTOK) >> 3) : (row >> 11);
            const f32x4 g = *(const f32x4*)(gate + (unsigned)(mr * (2 * ADA_N) + col)); *(f32x4*)(out + (unsigned)(row * DM + col)) = x + g * v; )
    }
};
struct EpiRelu2 {
    static constexpr bool PERM = true, AFTER_DRAIN = false; static constexpr int MID_T = -1; bf16_t* F;
    __device__ __forceinline__ void operator()(EPI_SIG) const {
        EPI_FOREACH8( f32x4 a = v0, b = v1;
            _Pragma("unroll") for (int i = 0; i < 4; ++i) { const float x = fmaxf(a[i], 0.f), y = fmaxf(b[i], 0.f); a[i] = x * x; b[i] = y * y; }
            *(v4u*)(F + (unsigned)(row * FF + col)) = pack8(a, b); )
    }
};
}

__device__ __forceinline__ void p0_transpose_item(const float* W, int K, int N, bf16* WT, int pitch, int koff, int row_off, int sel, LAS float* scr, int item, int lane) {
    const int nblk = N / 32, kb = item / nblk, nb = item % nblk, k0 = 64 * kb, n0 = 32 * nb;
#pragma unroll 16
    for (int i = 0; i < 32; ++i) { const int kk = 2 * i + (lane >> 5); scr[kk * 33 + (lane & 31)] = __builtin_nontemporal_load(W + (size_t)(k0 + kk) * N + n0 + (lane & 31)); }
    LDS_WAIT(); asm volatile("" ::: "memory");
    const int c = lane & 7;
#pragma unroll
    for (int j = 0; j < 4; ++j) { const int n = (lane >> 3) + 8 * j; const LAS float* s = scr + (8 * c) * 33 + n;
        v4u o; o.x = pk2(s[0 * 33], s[1 * 33]); o.y = pk2(s[2 * 33], s[3 * 33]); o.z = pk2(s[4 * 33], s[5 * 33]); o.w = pk2(s[6 * 33], s[7 * 33]);
        const int ng = n0 + n, drow = sel < 0 ? row_off + ng : 32 * (ng >> 4) + 16 * sel + (ng & 15);
        *(v4u*)(WT + (size_t)drow * pitch + koff + k0 + 8 * c) = o; }
    LDS_WAIT(); asm volatile("" ::: "memory");
}

constexpr int I_ADA = (DM / 64) * (ADA_N / 32), I_IN = (DM / 64) * (IN_DIM / 32), I_O = (1024 / 64) * (DM / 32), I_CO = (512 / 64) * (DM / 32), I_G = I_CO,
              I_OUT = (DM / 64) * (DM / 32), I_F1 = (DM / 64) * (FF / 32), I_F2 = (FF / 64) * (DM / 32);
constexpr int I_LAYER = I_IN + I_O + I_CO + 2 * I_G + I_OUT + I_F1 + I_F2, I_L0_PRO = I_LAYER - 12800;
__device__ __forceinline__ void convert_layer_item(const Args& a, int l, int r, LAS float* scr, int lane) {
    bf16* wl = (bf16*)(a.ws + WS_WL + (size_t)l * WL_STRIDE);
    if (r < I_IN) { p0_transpose_item(a.in[I_WIN] + (size_t)l * DM * IN_DIM, DM, IN_DIM, wl + WL_IN / 2, DM, 0, 0, -1, scr, r, lane); return; } r -= I_IN;
    if (r < I_O) { p0_transpose_item(a.in[I_WO] + (size_t)l * 1024 * DM, 1024, DM, wl + WL_O / 2, 1536, 0, 0, -1, scr, r, lane); return; } r -= I_O;
    if (r < I_CO) { p0_transpose_item(a.in[I_WCO] + (size_t)l * 512 * DM, 512, DM, wl + WL_O / 2, 1536, 1024, 0, -1, scr, r, lane); return; } r -= I_CO;
    if (r < I_G) { p0_transpose_item(a.in[I_WGA] + (size_t)l * 512 * DM, 512, DM, wl + WL_GA / 2, 512, 0, 0, 0, scr, r, lane); return; } r -= I_G;
    if (r < I_G) { p0_transpose_item(a.in[I_WGB] + (size_t)l * 512 * DM, 512, DM, wl + WL_GA / 2, 512, 0, 0, 1, scr, r, lane); return; } r -= I_G;
    if (r < I_OUT) { p0_transpose_item(a.in[I_WOUT] + (size_t)l * DM * DM, DM, DM, wl + WL_OUT / 2, DM, 0, 0, -1, scr, r, lane); return; } r -= I_OUT;
    if (r < I_F1) { p0_transpose_item(a.in[I_WF1] + (size_t)l * DM * FF, DM, FF, wl + WL_F1 / 2, DM, 0, 0, -1, scr, r, lane); return; } r -= I_F1;
    p0_transpose_item(a.in[I_WF2] + (size_t)l * FF * DM, FF, DM, wl + WL_F2 / 2, FF, 0, 0, -1, scr, r, lane);
}
__device__ __forceinline__ void convert_idle(const Args& a, LAS unsigned char* lds, int l, int c0, int i0, int i1) {
    int tid_o = threadIdx.x; asm volatile("" : "+v"(tid_o)); const int lane = tid_o & 63, wave = __builtin_amdgcn_readfirstlane(tid_o >> 6);
    const int c = (int)blockIdx.x - c0; if (c < 0) return;
    LAS float* scr = (LAS float*)(lds + wave * 16384);
    const int nw = ((int)gridDim.x - c0) * 8;
    for (int it = i0 + c * 8 + wave; it < i1; it += nw) convert_layer_item(a, l, it, scr, lane);
}

__device__ __forceinline__ void p0_prologue(const Args& a, LAS unsigned char* lds, int gw, int NGW, int lane, int wave, int gtid, int NGT) {
    LAS float* scr = (LAS float*)(lds + wave * 16384);
    unsigned char* ws = a.ws;
    for (int it = gw; it < 2 * I_ADA + I_L0_PRO; it += NGW) {
        if (it < 2 * I_ADA) { const int l = it / I_ADA, r = it - l * I_ADA; p0_transpose_item(a.in[I_WADA] + (size_t)l * DM * ADA_N, DM, ADA_N, (bf16*)(ws + WS_WADA), DM, 0, l * ADA_N, -1, scr, r, lane); }
        else convert_layer_item(a, 0, it - 2 * I_ADA, scr, lane);
    }
    for (int it = gw; it < I_LAYER; it += NGW) convert_layer_item(a, 1, it, scr, lane);
    unsigned* AC = (unsigned*)(ws + WS_AC);
    for (int i = gtid; i < 256 * DM / 2; i += NGT) {
        const int row = i / (DM / 2), c2 = (i % (DM / 2)) * 2; unsigned w = 0u;
        if (row < NMODROW) { const float* src = row < 4 ? a.in[I_CP] + row * DM + c2 : a.in[I_CS] + (row - 4) * DM + c2; const float x = src[0], y = src[1]; w = pk2(x * sigm(x), y * sigm(y)); }
        AC[i] = w;
    }
    f32x2* RT = (f32x2*)(ws + WS_ROPE);
    for (int i = gtid; i < 2056 * 8; i += NGT) {
        const int pi = i >> 3, fi = i & 7; const double pos = pi < 2048 ? (double)pi : (double)(8192 + pi - 2048);
        const double invf = dexp_(-(double)fi * 0.125 * 13.122363377404328);
        double sn, cs; dsincos_(pos * invf, sn, cs); RT[i] = (f32x2){(float)cs, (float)sn};
    }
}

__device__ __forceinline__ void norm_mod_phase(const float* xp, const float* xs, const float* normw, const float* mod, int l, int second, bf16* H) {
    int tid_o = threadIdx.x; asm volatile("" : "+v"(tid_o)); const int tid = tid_o, lane = tid & 63, wave = __builtin_amdgcn_readfirstlane(tid >> 6); (void)lane; (void)wave;
    const int NGW = gridDim.x * 8, gw = blockIdx.x * 8 + wave;
    for (int row0 = gw; row0 < NTOK; row0 += 2 * NGW) {
        const int row1 = row0 + NGW; const bool has1 = row1 < NTOK; const int r1 = has1 ? row1 : row0;
        const float* xr0 = row0 < NPTOK ? xp + (size_t)row0 * DM : xs + (size_t)(row0 - NPTOK) * DM;
        const float* xr1 = r1 < NPTOK ? xp + (size_t)r1 * DM : xs + (size_t)(r1 - NPTOK) * DM;
        f32x4 v0[8], v1[8]; float s0 = 0.f, s1 = 0.f;
#pragma unroll
        for (int j = 0; j < 8; ++j) { v0[j] = *(const f32x4*)(xr0 + 4 * (lane + 64 * j)); v1[j] = *(const f32x4*)(xr1 + 4 * (lane + 64 * j)); }
#pragma unroll
        for (int j = 0; j < 8; ++j) { s0 += (v0[j][0] * v0[j][0] + v0[j][1] * v0[j][1]) + (v0[j][2] * v0[j][2] + v0[j][3] * v0[j][3]); s1 += (v1[j][0] * v1[j][0] + v1[j][1] * v1[j][1]) + (v1[j][2] * v1[j][2] + v1[j][3] * v1[j][3]); }
        s0 = wave_sum(s0); s1 = wave_sum(s1);
        const float rs0 = rsqrtf(s0 * (1.f / DM) + 1e-6f), rs1 = rsqrtf(s1 * (1.f / DM) + 1e-6f);
        const float* sh0 = mod + (size_t)pg8::mod_row(row0) * (2 * ADA_N) + l * ADA_N + (second ? 3 : 0) * DM; const float* sh1 = mod + (size_t)pg8::mod_row(r1) * (2 * ADA_N) + l * ADA_N + (second ? 3 : 0) * DM;
#pragma unroll
        for (int j = 0; j < 8; ++j) { const int c = 4 * (lane + 64 * j); const f32x4 nw = *(const f32x4*)(normw + c);
            { const f32x4 sc = *(const f32x4*)(sh0 + DM + c), sh = *(const f32x4*)(sh0 + c); const f32x4 y = (v0[j] * rs0) * nw * (sc + 1.f) + sh; v2u w; w.x = pk2(y[0], y[1]); w.y = pk2(y[2], y[3]); *(v2u*)(H + (size_t)row0 * DM + c) = w; }
            if (has1) { const f32x4 sc = *(const f32x4*)(sh1 + DM + c), sh = *(const f32x4*)(sh1 + c); const f32x4 y = (v1[j] * rs1) * nw * (sc + 1.f) + sh; v2u w; w.x = pk2(y[0], y[1]); w.y = pk2(y[2], y[3]); *(v2u*)(H + (size_t)row1 * DM + c) = w; } }
    }
}

__device__ __forceinline__ void unpack8(const v4u r, float (&x)[8]) { x[0] = lo16(r.x); x[1] = hi16(r.x); x[2] = lo16(r.y); x[3] = hi16(r.y); x[4] = lo16(r.z); x[5] = hi16(r.z); x[6] = lo16(r.w); x[7] = hi16(r.w); }
__device__ __forceinline__ v4u pack8f(const float (&x)[8]) { v4u w; w.x = pk2(x[0], x[1]); w.y = pk2(x[2], x[3]); w.z = pk2(x[4], x[5]); w.w = pk2(x[6], x[7]); return w; }
template <int NKT>
__device__ __forceinline__ void attn_qgroup(const LAS bf16* Ks, int kst, const LAS bf16* Vt, int vst, const bf16* qrow, const float* qg, const f32x2* rt, int qi, bool hasprev, float sink, bf16* orow, bool store_ok, int lane) {
    static_assert(NKT % 2 == 0, "key tiles come in pairs");
    const int lr = lane & 15, q4 = lane >> 4;
    bf16x8 qf0, qf1;
    { float x0[8], x1[8]; unpack8(*(const v4u*)(qrow + 8 * q4), x0); unpack8(*(const v4u*)(qrow + 32 + 8 * q4), x1);
      float ss = 0.f;
#pragma unroll
      for (int e = 0; e < 8; ++e) ss += x0[e] * x0[e] + x1[e] * x1[e];
      ss += __shfl_xor(ss, 16); ss += __shfl_xor(ss, 32);
      const float rstd = rsqrtf(ss * (1.f / 64.f) + 1e-6f);
#pragma unroll
      for (int e = 0; e < 8; ++e) { x0[e] = x0[e] * rstd * qg[8 * q4 + e]; x1[e] = x1[e] * rstd * qg[32 + 8 * q4 + e]; }
#pragma unroll
      for (int e = 0; e < 8; ++e) { const float other = __shfl_xor(x0[e], 16); const f32x2 cs = rt[e];
          if (q4 == 0) x0[e] = x0[e] * cs.x - other * cs.y; else if (q4 == 1) x0[e] = x0[e] * cs.x + other * cs.y; }
#pragma unroll
      for (int e = 0; e < 8; ++e) { x0[e] *= 0.125f; x1[e] *= 0.125f; }
      qf0 = __builtin_bit_cast(bf16x8, pack8f(x0)); qf1 = __builtin_bit_cast(bf16x8, pack8f(x1)); }
    f32x4 s[NKT];
#pragma unroll
    for (int kt = 0; kt < NKT; ++kt) {
        const LAS bf16* kp = Ks + (16 * kt + lr) * kst + 8 * q4;
        const bf16x8 k0 = *(const LAS bf16x8*)kp, k1 = *(const LAS bf16x8*)(kp + 32);
        f32x4 z = (f32x4){0.f, 0.f, 0.f, 0.f};
        z = __builtin_amdgcn_mfma_f32_16x16x32_bf16(k0, qf0, z, 0, 0, 0);
        z = __builtin_amdgcn_mfma_f32_16x16x32_bf16(k1, qf1, z, 0, 0, 0);
        s[kt] = z;
        if ((kt & 3) == 3) __builtin_amdgcn_sched_barrier(0);
    }
    float m = sink;
#pragma unroll
    for (int kt = 0; kt < NKT; ++kt)
#pragma unroll
        for (int i = 0; i < 4; ++i) { const int kj = 16 * kt + 4 * q4 + i; const bool ok = (kj > qi) && (kj <= qi + 128) && (hasprev || kj >= 128);
            const float v = ok ? s[kt][i] : -INFINITY; s[kt][i] = v; m = fmaxf(m, v); }
    m = fmaxf(m, __shfl_xor(m, 16)); m = fmaxf(m, __shfl_xor(m, 32));
    float sum = 0.f;
#pragma unroll
    for (int kt = 0; kt < NKT; ++kt)
#pragma unroll
        for (int i = 0; i < 4; ++i) { const float p = __expf(s[kt][i] - m); s[kt][i] = p; sum += p; }
    sum += __shfl_xor(sum, 16); sum += __shfl_xor(sum, 32);
    const float inv = 1.f / (sum + __expf(sink - m));
    f32x4 o[4];
#pragma unroll
    for (int dt = 0; dt < 4; ++dt) o[dt] = (f32x4){0.f, 0.f, 0.f, 0.f};
#pragma unroll
    for (int kp = 0; kp < NKT / 2; ++kp) {
        v4u pw; pw.x = pk2(s[2 * kp][0], s[2 * kp][1]); pw.y = pk2(s[2 * kp][2], s[2 * kp][3]); pw.z = pk2(s[2 * kp + 1][0], s[2 * kp + 1][1]); pw.w = pk2(s[2 * kp + 1][2], s[2 * kp + 1][3]);
        const bf16x8 pb = __builtin_bit_cast(bf16x8, pw);
#pragma unroll
        for (int dt = 0; dt < 4; ++dt) {
            const LAS bf16* vp = Vt + (16 * dt + lr) * vst + 32 * kp + 4 * q4;
            const v2u lo = *(const LAS v2u*)vp, hi = *(const LAS v2u*)(vp + 16);
            v4u vw; vw.x = lo.x; vw.y = lo.y; vw.z = hi.x; vw.w = hi.y;
            o[dt] = __builtin_amdgcn_mfma_f32_16x16x32_bf16(__builtin_bit_cast(bf16x8, vw), pb, o[dt], 0, 0, 0);
        }
    }
    if (store_ok) {
#pragma unroll
        for (int dt = 0; dt < 4; ++dt) { v2u w; w.x = pk2(o[dt][0] * inv, o[dt][1] * inv); w.y = pk2(o[dt][2] * inv, o[dt][3] * inv); *(v2u*)(orow + 16 * dt + 4 * q4) = w; }
    }
}

constexpr int AP_KST = 72, AP_VST = 264;
constexpr int AS_KST = 72, AS_VST = 168, AS_NK = 160;

__device__ __forceinline__ void knorm_rope8(float (&x)[8], int ch, const float* kg, const f32x2* rt) {
    float ss = 0.f;
#pragma unroll
    for (int e = 0; e < 8; ++e) ss += x[e] * x[e];
    ss += __shfl_xor(ss, 1); ss += __shfl_xor(ss, 2); ss += __shfl_xor(ss, 4);
    const float rstd = rsqrtf(ss * (1.f / 64.f) + 1e-6f);
#pragma unroll
    for (int e = 0; e < 8; ++e) x[e] = x[e] * rstd * kg[ch * 8 + e];
#pragma unroll
    for (int e = 0; e < 8; ++e) { const float other = __shfl_xor(x[e], 1); const f32x2 cs = rt[e];
        if (ch == 0) x[e] = x[e] * cs.x - other * cs.y; else if (ch == 1) x[e] = x[e] * cs.x + other * cs.y; }
}
__device__ __forceinline__ void attn_prompt_item(const Args& a, int l, int item, LAS unsigned char* lds) {
    int tid_o = threadIdx.x; asm volatile("" : "+v"(tid_o)); const int tid = tid_o, lane = tid & 63, wave = __builtin_amdgcn_readfirstlane(tid >> 6); (void)lane; (void)wave;
    unsigned char* ws = a.ws; asm volatile("" : "+s"(ws)); const bf16* P = (const bf16*)(ws + WS_P); bf16* O = (bf16*)(ws + WS_O); const f32x2* RT = (const f32x2*)(ws + WS_ROPE);
    const float* qg = a.in[I_QN] + l * 64; const float* kg = a.in[I_KN] + l * 64;
    const int kvh = item & 3, n = (item >> 2) & 15, b = item >> 6;
    LAS bf16* Ks = (LAS bf16*)lds; LAS bf16* Vt = (LAS bf16*)(lds + 256 * AP_KST * 2);
#pragma unroll
    for (int i = 0; i < 4; ++i) { const int c = tid + 512 * i, r = c >> 3, ch = c & 7, pos = 128 * (n - 1) + r, pc = pos >= 0 ? pos : 0;
        v4u val = (v4u){0u, 0u, 0u, 0u}; if (pos >= 0) val = *(const v4u*)(P + (size_t)(b * SEQ + pos) * IN_DIM + C_K + kvh * 64 + ch * 8);
        float x[8]; unpack8(val, x); knorm_rope8(x, ch, kg, RT + pc * 8);
        *(LAS v4u*)(Ks + r * AP_KST + ch * 8) = pack8f(x);
        if (n == 15 && r >= 128) { float* o = a.out + O_NKP + ((size_t)(l * NB + b) * 128 + (r - 128)) * 256 + kvh * 64 + ch * 8;
            *(f32x4*)o = (f32x4){x[0], x[1], x[2], x[3]}; *(f32x4*)(o + 4) = (f32x4){x[4], x[5], x[6], x[7]}; } }
#pragma unroll
    for (int i = 0; i < 4; ++i) { const int c = tid + 512 * i, key = c & 255, ch = c >> 8, pos = 128 * (n - 1) + key;
        v4u val = (v4u){0u, 0u, 0u, 0u}; if (pos >= 0) val = *(const v4u*)(P + (size_t)(b * SEQ + pos) * IN_DIM + C_V + kvh * 64 + ch * 8);
        LAS bf16* d = Vt + (ch * 8) * AP_VST + key;
        d[0 * AP_VST] = (bf16)(val.x & 0xffffu); d[1 * AP_VST] = (bf16)(val.x >> 16); d[2 * AP_VST] = (bf16)(val.y & 0xffffu); d[3 * AP_VST] = (bf16)(val.y >> 16);
        d[4 * AP_VST] = (bf16)(val.z & 0xffffu); d[5 * AP_VST] = (bf16)(val.z >> 16); d[6 * AP_VST] = (bf16)(val.w & 0xffffu); d[7 * AP_VST] = (bf16)(val.w >> 16);
        if (n == 15 && key >= 128) { float* o = a.out + O_NVP + ((size_t)(l * NB + b) * 128 + (key - 128)) * 256 + kvh * 64 + ch * 8;
            *(f32x4*)o = (f32x4){lo16(val.x), hi16(val.x), lo16(val.y), hi16(val.y)}; *(f32x4*)(o + 4) = (f32x4){lo16(val.z), hi16(val.z), lo16(val.w), hi16(val.w)}; } }
    __syncthreads();
    const int g = wave >> 1, half = wave & 1, head = kvh * 4 + g; const float sink = a.in[I_SINK][l * 16 + head];
#pragma nounroll
    for (int qg_i = 0; qg_i < 4; ++qg_i) {
        const int qi = 64 * half + 16 * qg_i + (lane & 15); const size_t tok = (size_t)b * SEQ + 128 * n + qi;
        attn_qgroup<16>(Ks, AP_KST, Vt, AP_VST, P + tok * IN_DIM + head * 64, qg, RT + (128 * n + qi) * 8, qi, n > 0, sink, O + tok * 1536 + head * 64, true, lane);
    }
    __syncthreads();
}

__device__ __forceinline__ void attn_sample_item(const Args& a, int l, int item, LAS unsigned char* lds) {
    int tid_o = threadIdx.x; asm volatile("" : "+v"(tid_o)); const int tid = tid_o, lane = tid & 63, wave = __builtin_amdgcn_readfirstlane(tid >> 6); (void)lane; (void)wave;
    unsigned char* ws = a.ws; asm volatile("" : "+s"(ws)); const bf16* P = (const bf16*)(ws + WS_P); bf16* O = (bf16*)(ws + WS_O); const f32x2* RT = (const f32x2*)(ws + WS_ROPE);
    const float* qg = a.in[I_QN] + l * 64; const float* kg = a.in[I_KN] + l * 64;
    const int pair = item & 1, b = item >> 1;
    LAS bf16* Ks = (LAS bf16*)lds; LAS bf16* Vt = (LAS bf16*)(lds + 2 * AS_NK * AS_KST * 2);
    const float* ck = a.in[I_CK] + (size_t)(l * DECB + b) * 128 * 256; const float* cv = a.in[I_CV] + (size_t)(l * DECB + b) * 128 * 256;
    float* onk = a.out + O_NKS + (size_t)(l * DECB + b) * 128 * 256; float* onv = a.out + O_NVS + (size_t)(l * DECB + b) * 128 * 256;
#pragma unroll
    for (int i = 0; i < 8; ++i) { const int c = tid + 512 * i, kk = c >> 11, rem = c & 2047, r = rem >> 4, ch4 = rem & 15;
        const f32x4 v = *(const f32x4*)(ck + (size_t)r * 256 + (2 * pair + kk) * 64 + ch4 * 4); v2u w; w.x = pk2(v[0], v[1]); w.y = pk2(v[2], v[3]);
        *(LAS v2u*)(Ks + (kk * AS_NK + r) * AS_KST + ch4 * 4) = w;
        if (r >= 8) *(f32x4*)(onk + (size_t)(r - 8) * 256 + (2 * pair + kk) * 64 + ch4 * 4) = v; }
    { const int kk = tid >> 8, rem = tid & 255, r = 128 + (rem >> 3), ch = rem & 7, t = r < 136 ? r - 128 : 0;
      v4u val = (v4u){0u, 0u, 0u, 0u}; if (r < 136) val = *(const v4u*)(P + (size_t)(NPTOK + b * DECT + t) * IN_DIM + C_K + (2 * pair + kk) * 64 + ch * 8);
      float x[8]; unpack8(val, x); knorm_rope8(x, ch, kg, RT + (2048 + t) * 8);
      *(LAS v4u*)(Ks + (kk * AS_NK + r) * AS_KST + ch * 8) = pack8f(x);
      if (r < 136) { float* o = onk + (size_t)(120 + t) * 256 + (2 * pair + kk) * 64 + ch * 8; *(f32x4*)o = (f32x4){x[0], x[1], x[2], x[3]}; *(f32x4*)(o + 4) = (f32x4){x[4], x[5], x[6], x[7]}; } }
#pragma unroll
    for (int i = 0; i < 8; ++i) { const int c = tid + 512 * i, key = c & 127, kk = (c >> 7) & 1, ch4 = c >> 8;
        const f32x4 v = *(const f32x4*)(cv + (size_t)key * 256 + (2 * pair + kk) * 64 + ch4 * 4);
        LAS bf16* d = Vt + (kk * 64 + ch4 * 4) * AS_VST + key;
        d[0] = (bf16)f2bf(v[0]); d[AS_VST] = (bf16)f2bf(v[1]); d[2 * AS_VST] = (bf16)f2bf(v[2]); d[3 * AS_VST] = (bf16)f2bf(v[3]);
        if (key >= 8) *(f32x4*)(onv + (size_t)(key - 8) * 256 + (2 * pair + kk) * 64 + ch4 * 4) = v; }
#pragma unroll
    for (int i = 0; i < 8; ++i) { const int c = tid + 512 * i, col = 128 + (c & 31), d = (c >> 5) & 63, kk = c >> 11; bf16 val = 0;
        if (col < 136) { val = P[(size_t)(NPTOK + b * DECT + (col - 128)) * IN_DIM + C_V + (2 * pair + kk) * 64 + d]; onv[(size_t)(120 + col - 128) * 256 + (2 * pair + kk) * 64 + d] = bf2f(val); }
        Vt[(kk * 64 + d) * AS_VST + col] = val; }
    __syncthreads();
    const int kk = wave >> 2, g = wave & 3, kvh = 2 * pair + kk, head = kvh * 4 + g; const float sink = a.in[I_SINK][l * 16 + head];
    const int qi = lane & 15, qld = qi < 8 ? qi : 7; const size_t tok = (size_t)NPTOK + b * DECT + qld;
    attn_qgroup<10>(Ks + kk * AS_NK * AS_KST, AS_KST, Vt + kk * 64 * AS_VST, AS_VST, P + tok * IN_DIM + head * 64, qg, RT + (2048 + qld) * 8, qi, true, sink, O + tok * 1536 + head * 64, qi < 8, lane);
    __syncthreads();
}

template <int TT>
__device__ __forceinline__ void conv_compute(const Args& a, int l, LAS float* U, LAS float* red, LAS float* stat, size_t tok0, int tid, int wave, int lane) {
    const int c = tid;
    float w[31];
#pragma unroll
    for (int j = 0; j < 31; ++j) w[j] = a.in[I_CW][(size_t)(l * 31 + j) * 512 + c];
    const float bias = a.in[I_CB][l * 512 + c];
    float y[TT];
#pragma unroll
    for (int tb = 0; tb < TT / 8; ++tb) {
        float win[38];
#pragma unroll
        for (int r = 0; r < 38; ++r) win[r] = U[(tb * 8 + r) * 512 + c];
#pragma unroll
        for (int t = 0; t < 8; ++t) { float acc = bias;
#pragma unroll
            for (int j = 0; j < 31; ++j) acc = fmaf(w[j], win[t + j], acc);
            y[tb * 8 + t] = acc; }
    }
#pragma unroll
    for (int t = 0; t < TT; ++t) { const float s1 = wave_sum(y[t]), s2 = wave_sum(y[t] * y[t]); if (lane == 0) { red[(wave * 32 + t) * 2] = s1; red[(wave * 32 + t) * 2 + 1] = s2; } }
    __syncthreads();
    if (tid < TT * 2) { const int t = tid >> 1, k = tid & 1; float s = 0.f;
#pragma unroll
        for (int ww = 0; ww < 8; ++ww) s += red[(ww * 32 + t) * 2 + k];
        stat[t * 2 + k] = s; }
    __syncthreads();
    const float lg = a.in[I_CLG][l * 512 + c], lb = a.in[I_CLB][l * 512 + c];
    bf16* YC = (bf16*)(a.ws + WS_O) + 1024;
#pragma unroll
    for (int t = 0; t < TT; ++t) { const float mean = stat[t * 2] * (1.f / 512.f), var = stat[t * 2 + 1] * (1.f / 512.f) - mean * mean, rstd = rsqrtf(fmaxf(var, 0.f) + 1e-6f);
        const float v = (y[t] - mean) * rstd * lg + lb; YC[(tok0 + t) * 1536 + c] = (bf16)f2bf(v * sigm(v)); }
}
__device__ __forceinline__ void glu8(const bf16* P, size_t tok, int ch, float (&u)[8]) {
    const v4u av = *(const v4u*)(P + tok * IN_DIM + C_XA + ch * 8), bv = *(const v4u*)(P + tok * IN_DIM + C_XB + ch * 8);
    u[0] = lo16(av.x) * sigm(lo16(bv.x)); u[1] = hi16(av.x) * sigm(hi16(bv.x)); u[2] = lo16(av.y) * sigm(lo16(bv.y)); u[3] = hi16(av.y) * sigm(hi16(bv.y));
    u[4] = lo16(av.z) * sigm(lo16(bv.z)); u[5] = hi16(av.z) * sigm(hi16(bv.z)); u[6] = lo16(av.w) * sigm(lo16(bv.w)); u[7] = hi16(av.w) * sigm(hi16(bv.w));
}
__device__ __forceinline__ void conv_prompt_item(const Args& a, int l, int item, LAS unsigned char* lds) {
    int tid_o = threadIdx.x; asm volatile("" : "+v"(tid_o)); const int tid = tid_o, lane = tid & 63, wave = __builtin_amdgcn_readfirstlane(tid >> 6); (void)lane; (void)wave;
    const bf16* P = (const bf16*)(a.ws + WS_P);
    LAS float* U = (LAS float*)lds; LAS float* red = U + 62 * 512; LAS float* stat = red + 512;
    const int b = item >> 6, tile = item & 63, t0 = tile * 32;
#pragma unroll 4
    for (int c = tid; c < 62 * 64; c += 512) { const int r = c >> 6, ch = c & 63, t = t0 - 30 + r; float u[8];
        if (t >= 0) glu8(P, (size_t)b * SEQ + t, ch, u); else {
#pragma unroll
            for (int e = 0; e < 8; ++e) u[e] = 0.f; }
        *(LAS f32x4*)(U + r * 512 + ch * 8) = (f32x4){u[0], u[1], u[2], u[3]}; *(LAS f32x4*)(U + r * 512 + ch * 8 + 4) = (f32x4){u[4], u[5], u[6], u[7]};
        if (tile == 63 && t >= SEQ - 30) { float* o = a.out + O_NCP + ((size_t)(l * NB + b) * 30 + (t - (SEQ - 30))) * 512 + ch * 8;
            *(f32x4*)o = (f32x4){u[0], u[1], u[2], u[3]}; *(f32x4*)(o + 4) = (f32x4){u[4], u[5], u[6], u[7]}; } }
    __syncthreads();
    conv_compute<32>(a, l, U, red, stat, (size_t)b * SEQ + t0, tid, wave, lane);
    __syncthreads();
}
__device__ __forceinline__ void conv_sample_item(const Args& a, int l, int item, LAS unsigned char* lds) {
    int tid_o = threadIdx.x; asm volatile("" : "+v"(tid_o)); const int tid = tid_o, lane = tid & 63, wave = __builtin_amdgcn_readfirstlane(tid >> 6); (void)lane; (void)wave;
    const bf16* P = (const bf16*)(a.ws + WS_P);
    LAS float* U = (LAS float*)lds; LAS float* red = U + 62 * 512; LAS float* stat = red + 512;
    const int b = item; const float* sc = a.in[I_SCONV] + (size_t)(l * DECB + b) * 30 * 512;
#pragma unroll 5
    for (int c = tid; c < 38 * 64; c += 512) { const int r = c >> 6, ch = c & 63; float u[8];
        if (r < 30) { const f32x4 x0 = *(const f32x4*)(sc + r * 512 + ch * 8), x1 = *(const f32x4*)(sc + r * 512 + ch * 8 + 4);
            u[0] = x0[0]; u[1] = x0[1]; u[2] = x0[2]; u[3] = x0[3]; u[4] = x1[0]; u[5] = x1[1]; u[6] = x1[2]; u[7] = x1[3]; }
        else glu8(P, (size_t)NPTOK + b * DECT + (r - 30), ch, u);
        *(LAS f32x4*)(U + r * 512 + ch * 8) = (f32x4){u[0], u[1], u[2], u[3]}; *(LAS f32x4*)(U + r * 512 + ch * 8 + 4) = (f32x4){u[4], u[5], u[6], u[7]};
        if (r >= 8) { float* o = a.out + O_NCS + ((size_t)(l * DECB + b) * 30 + (r - 8)) * 512 + ch * 8;
            *(f32x4*)o = (f32x4){u[0], u[1], u[2], u[3]}; *(f32x4*)(o + 4) = (f32x4){u[4], u[5], u[6], u[7]}; } }
    __syncthreads();
    conv_compute<8>(a, l, U, red, stat, (size_t)NPTOK + b * DECT, tid, wave, lane);
    __syncthreads();
}

struct SsmLane { float ar, ai; f32x2 bz[16]; bf16x8 cf[4]; f32x4 dv; float a256r, a256i; };
__device__ __forceinline__ void ssm_setup(const Args& a, int l, int g, int lane, SsmLane& S) {
    const int p = lane, lg = l * 32 + g;
    const double are = (double)a.in[I_ARE][lg * 64 + p], aim = (double)a.in[I_AIM][lg * 64 + p], dt = dexp_((double)a.in[I_LDT][lg]);
    const double mag = dexp_(are * dt); double sn, cs; dsincos_(aim * dt, sn, cs);
    const double abr = mag * cs, abi = mag * sn, den = are * are + aim * aim;
    const double zr = ((abr - 1.0) * are + abi * aim) / den, zi = (abi * are - (abr - 1.0) * aim) / den;
    S.ar = (float)abr; S.ai = (float)abi;
    double pr = abr, pi = abi;
#pragma unroll
    for (int i = 0; i < 8; ++i) { const double nr = pr * pr - pi * pi, ni = 2.0 * pr * pi; pr = nr; pi = ni; }
    S.a256r = (float)pr; S.a256i = (float)pi;
    const float* br = a.in[I_BRE] + (size_t)(lg * 64 + p) * 16; const float* bi = a.in[I_BIM] + (size_t)(lg * 64 + p) * 16;
    const float zrf = (float)zr, zif = (float)zi;
#pragma unroll
    for (int c = 0; c < 16; ++c) { const float x = br[c], y = bi[c]; S.bz[c] = (f32x2){zrf * x - zif * y, zrf * y + zif * x}; }
    const int lr = lane & 15, q4 = lane >> 4;
#pragma unroll
    for (int ks = 0; ks < 4; ++ks) { const int k0 = (ks & 1) * 32 + 8 * q4; const float* src = (ks < 2 ? a.in[I_CRE] : a.in[I_CIM]) + (size_t)(lg * 16 + lr) * 64 + k0; const float sg = ks < 2 ? 1.f : -1.f;
        const f32x4 x0 = *(const f32x4*)src, x1 = *(const f32x4*)(src + 4);
        v4u w; w.x = pk2(sg * x0[0], sg * x0[1]); w.y = pk2(sg * x0[2], sg * x0[3]); w.z = pk2(sg * x1[0], sg * x1[1]); w.w = pk2(sg * x1[2], sg * x1[3]);
        S.cf[ks] = __builtin_bit_cast(bf16x8, w); }
    S.dv = *(const f32x4*)(a.in[I_SD] + l * 512 + g * 16 + 4 * q4);
}
__device__ __forceinline__ float gelu_tanh(float x) { const float z = 0.7978845608028654f * (x + 0.044715f * x * x * x); const float t = 1.f - 2.f * __builtin_amdgcn_rcpf(__expf(2.f * z) + 1.f); return 0.5f * x * (1.f + t); }

template <bool PASS2>
__device__ __forceinline__ void ssm_run(const Args& a, const SsmLane& S, int g, size_t tok0, int nsub, int nvalid, float& hr, float& hi, LAS float* ubuf, LAS bf16* hbuf, int lane) {
    const bf16* P = (const bf16*)(a.ws + WS_P); bf16* YS = (bf16*)(a.ws + WS_YS);
    const int lr = lane & 15, q4 = lane >> 4, st_l = lane >> 2, c4 = (lane & 3) * 4;
    v2u wnext = (v2u){0u, 0u};
    if (st_l < nvalid) wnext = *(const v2u*)(P + (tok0 + st_l) * IN_DIM + C_XS + g * 16 + c4);
#pragma nounroll
    for (int sub = 0; sub < nsub; ++sub) {
        *(LAS f32x4*)(ubuf + st_l * 16 + c4) = (f32x4){lo16(wnext.x), hi16(wnext.x), lo16(wnext.y), hi16(wnext.y)};
        if (sub + 1 < nsub) wnext = *(const v2u*)(P + (tok0 + (sub + 1) * 16 + st_l) * IN_DIM + C_XS + g * 16 + c4);
        WAVE_SYNC();
        f32x4 un[4];
#pragma unroll
        for (int q = 0; q < 4; ++q) un[q] = *(const LAS f32x4*)(ubuf + q * 4);
#pragma unroll
        for (int st = 0; st < 16; ++st) {
            f32x4 uc[4];
#pragma unroll
            for (int q = 0; q < 4; ++q) uc[q] = un[q];
            if (st < 15) {
#pragma unroll
                for (int q = 0; q < 4; ++q) un[q] = *(const LAS f32x4*)(ubuf + (st + 1) * 16 + q * 4);
            }
            if (st < nvalid) {
                f32x2 x2 = (f32x2){0.f, 0.f};
#pragma unroll
                for (int q = 0; q < 4; ++q)
#pragma unroll
                    for (int c = 0; c < 4; ++c) x2 = S.bz[4 * q + c] * (f32x2){uc[q][c], uc[q][c]} + x2;
                const f32x2 t2 = (f32x2){S.ar, S.ar} * (f32x2){hr, hi} + x2;
                const f32x2 n2 = (f32x2){-S.ai, S.ai} * (f32x2){hi, hr} + t2;
                hr = n2.x; hi = n2.y;
            }
            if (PASS2) { hbuf[st * 136 + lane] = (bf16)f2bf(hr); hbuf[st * 136 + 64 + lane] = (bf16)f2bf(hi); }
            __builtin_amdgcn_sched_barrier(0);
        }
        if (PASS2) {
            WAVE_SYNC();
            f32x4 acc = (f32x4){0.f, 0.f, 0.f, 0.f};
#pragma unroll
            for (int ks = 0; ks < 4; ++ks) { const bf16x8 hb = *(const LAS bf16x8*)(hbuf + lr * 136 + 32 * ks + 8 * q4); acc = __builtin_amdgcn_mfma_f32_16x16x32_bf16(S.cf[ks], hb, acc, 0, 0, 0); }
            const f32x4 uv = *(const LAS f32x4*)(ubuf + lr * 16 + 4 * q4);
            if (lr < nvalid) { f32x4 yv = acc + S.dv * uv; v2u w; w.x = pk2(gelu_tanh(yv[0]), gelu_tanh(yv[1])); w.y = pk2(gelu_tanh(yv[2]), gelu_tanh(yv[3]));
                *(v2u*)(YS + (tok0 + sub * 16 + lr) * 512 + g * 16 + 4 * q4) = w; }
        }
        WAVE_SYNC();
    }
}
__device__ __forceinline__ void ssm_prompt_item(const Args& a, int l, int item, LAS unsigned char* lds) {
    int tid_o = threadIdx.x; asm volatile("" : "+v"(tid_o)); const int tid = tid_o, lane = tid & 63, wave = __builtin_amdgcn_readfirstlane(tid >> 6); (void)lane; (void)wave;
    const int g = item & 31, b = item >> 5;
    LAS float* ubuf = (LAS float*)(lds + wave * 5632); LAS bf16* hbuf = (LAS bf16*)(lds + wave * 5632 + 1024); LAS float* ex = (LAS float*)(lds + 8 * 5632);
    SsmLane S; ssm_setup(a, l, g, lane, S);
    const size_t tok0 = (size_t)b * SEQ + 256 * wave;
    float hr = 0.f, hi = 0.f;
    ssm_run<false>(a, S, g, tok0, 16, 16, hr, hi, ubuf, hbuf, lane);
    ex[(wave * 64 + lane) * 2] = hr; ex[(wave * 64 + lane) * 2 + 1] = hi;
    __syncthreads();
    hr = 0.f; hi = 0.f;
    for (int j = 0; j < wave; ++j) { const float er = ex[(j * 64 + lane) * 2], ei = ex[(j * 64 + lane) * 2 + 1]; const float nr = S.a256r * hr - S.a256i * hi + er, ni = S.a256r * hi + S.a256i * hr + ei; hr = nr; hi = ni; }
    ssm_run<true>(a, S, g, tok0, 16, 16, hr, hi, ubuf, hbuf, lane);
    if (wave == 7) { a.out[O_NRP + (size_t)((l * NB + b) * 32 + g) * 64 + lane] = hr; a.out[O_NIP + (size_t)((l * NB + b) * 32 + g) * 64 + lane] = hi; }
    __syncthreads();
}
__device__ __forceinline__ void ssm_sample_item(const Args& a, int l, int item, LAS unsigned char* lds) {
    int tid_o = threadIdx.x; asm volatile("" : "+v"(tid_o)); const int tid = tid_o, lane = tid & 63, wave = __builtin_amdgcn_readfirstlane(tid >> 6); (void)lane; (void)wave;
    const int g = item & 31, bg = item >> 5;
    LAS float* ubuf = (LAS float*)(lds + wave * 5632); LAS bf16* hbuf = (LAS bf16*)(lds + wave * 5632 + 1024);
    SsmLane S; ssm_setup(a, l, g, lane, S);
    for (int bb = 0; bb < 2; ++bb) {
        const int bs = bg * 16 + wave * 2 + bb; const size_t so = (size_t)((l * DECB + bs) * 32 + g) * 64 + lane;
        float hr = a.in[I_SRE][so], hi = a.in[I_SIM][so];
        ssm_run<true>(a, S, g, (size_t)NPTOK + bs * DECT, 1, 8, hr, hi, ubuf, hbuf, lane);
        a.out[O_NRS + so] = hr; a.out[O_NIS + so] = hi;
    }
    __syncthreads();
}

__device__ __forceinline__ void mixer_phase(const Args& a, int l, LAS unsigned char* lds) {
    unsigned* qctr = (unsigned*)(a.ws + WS_CTL + 640 * 1024) + l * 64;
    volatile LAS unsigned* qslot = (volatile LAS unsigned*)(lds + 131072 + 128);
    for (;;) {
        if (threadIdx.x == 0) *qslot = __hip_atomic_fetch_add(qctr, 1u, __ATOMIC_RELAXED, __HIP_MEMORY_SCOPE_AGENT);
        __syncthreads();
        const int it = (int)*qslot;
        __syncthreads();
        if (it >= 1280) break;
        if (0) {}
#ifndef NO_SSMP
        else if (it < 128) ssm_prompt_item(a, l, it, lds);
#endif
#ifndef NO_ATTP
        else if (it < 384) attn_prompt_item(a, l, it - 128, lds);
#endif
#ifndef NO_CONVP
        else if (it < 640) conv_prompt_item(a, l, it - 384, lds);
#endif
#ifndef NO_ATTS
        else if (it < 896) attn_sample_item(a, l, it - 640, lds);
#endif
#ifndef NO_SSMS
        else if (it < 1152) ssm_sample_item(a, l, it - 896, lds);
#endif
#ifndef NO_CONVS
        else if (it < 1280) conv_sample_item(a, l, it - 1152, lds);
#endif
    }
}

#define XB_TMO      128
#define XB_XCNT(j)  (256  + 64 * (j))
#define XB_XSUB(j)  (1280 + 64 * (j))
#define XB_XGEN(j)  (2304 + 64 * (j))
#define XB_TOP      3328
#define XB_TOPGEN   3392
#define XCD_BAR_WORDS 3456
#define XB_SPIN_CAP (1u << 18)

__device__ __forceinline__ unsigned xb_ld(unsigned* p)              { return __hip_atomic_load(p, __ATOMIC_RELAXED, __HIP_MEMORY_SCOPE_AGENT); }
__device__ __forceinline__ unsigned xb_add(unsigned* p, unsigned v) { return __hip_atomic_fetch_add(p, v, __ATOMIC_RELAXED, __HIP_MEMORY_SCOPE_AGENT); }
__device__ __forceinline__ unsigned xb_xcc_id() { return (unsigned)__builtin_amdgcn_s_getreg((3 << 11) | 20) & 0xFu; }
#define XB_SPIN(cond, bar) do { unsigned _sp = 0; while (cond) { __builtin_amdgcn_s_sleep(1); \
    if ((++_sp & 255u) == 0u) { if (xb_ld(&(bar)[XB_TMO])) break; if (_sp > XB_SPIN_CAP) { atomicAdd(&(bar)[XB_TMO], 1u); break; } } } } while (0)

struct XcdBarrier {
    unsigned* bar; unsigned x;
    volatile LAS unsigned* st;
};

__device__ __forceinline__ XcdBarrier xcd_barrier_post(unsigned* bar, volatile LAS unsigned* st) {
    XcdBarrier b; b.bar = bar; b.x = xb_xcc_id(); b.st = st;
    if (threadIdx.x == 0) (void)xb_add(&bar[XB_XCNT(b.x)], 1u);
    return b;
}
__device__ __forceinline__ void xcd_barrier_complete(unsigned* bar, unsigned x, unsigned& nloc, unsigned& nx) {
    const unsigned G = gridDim.x * gridDim.y * gridDim.z;
    unsigned sum, cnt, mine, sp = 0u;
    for (;;) {
        sum = 0u; cnt = 0u; mine = 0u;
#pragma unroll
        for (unsigned j = 0; j < 16; ++j) { const unsigned c = xb_ld(&bar[XB_XCNT(j)]); sum += c; cnt += (c > 0u) ? 1u : 0u; mine = (j == x) ? c : mine; }
        if (sum == G) break;
        __builtin_amdgcn_s_sleep(1);
        if ((++sp & 255u) == 0u) { if (xb_ld(&bar[XB_TMO])) break; if (sp > XB_SPIN_CAP) { atomicAdd(&bar[XB_TMO], 1u); break; } }
    }
    nloc = mine > 0u ? mine : 1u; nx = cnt > 0u ? cnt : 1u;
}

__device__ __forceinline__ void xcd_barrier(const XcdBarrier& b) {
    asm volatile("s_waitcnt vmcnt(0)" ::: "memory");
    __syncthreads();
    if (threadIdx.x == 0) {
        unsigned* bar = b.bar;
        __builtin_amdgcn_s_waitcnt(0);
        unsigned nloc = b.st[0], nx = b.st[1];
        if (nloc == 0u) { xcd_barrier_complete(bar, b.x, nloc, nx); b.st[0] = nloc; b.st[1] = nx; }
        const unsigned old = xb_add(&bar[XB_XSUB(b.x)], 1u);
        const unsigned gen = old / nloc;
        if (old + 1u == (gen + 1u) * nloc) {
            __builtin_amdgcn_fence(__ATOMIC_RELEASE, "agent");
            asm volatile("s_waitcnt vmcnt(0)" ::: "memory");
            const unsigned og = xb_add(&bar[XB_TOP], 1u);
            const unsigned tg = og / nx;
            if (og + 1u == (tg + 1u) * nx) xb_add(&bar[XB_TOPGEN], 1u);
            else XB_SPIN(xb_ld(&bar[XB_TOPGEN]) == tg, bar);
            __builtin_amdgcn_fence(__ATOMIC_ACQUIRE, "agent");
            xb_add(&bar[XB_XGEN(b.x)], 1u);
            asm volatile("s_waitcnt vmcnt(0)" ::: "memory");
        } else {
            XB_SPIN(xb_ld(&bar[XB_XGEN(b.x)]) == gen, bar);
            __builtin_amdgcn_fence(__ATOMIC_ACQUIRE, "agent");
            asm volatile("s_waitcnt vmcnt(0)" ::: "memory");
        }
    }
    __syncthreads();
}

constexpr size_t WS_BAR = 768 * 1024;
constexpr int LDS_ST_OFF = 131072 + 64;

#define IN(k) (lo <= (k) && (k) < hi)
#ifdef PROBE_SEL
#define SEAM(k) do { if (IN(k) && IN((k) + 1)) { xcd_barrier(xbar); } if (blockIdx.x == 0 && threadIdx.x == 0) ((unsigned long long*)(a.ws + WS_CTL + 512 * 1024))[(k) + 1] = __builtin_amdgcn_s_memrealtime(); } while (0)
#else
#define SEAM(k) do { if (IN(k) && IN((k) + 1)) { xcd_barrier(xbar); } } while (0)
#endif
#define GEMM(EPI, E, Aptr, Bptr, M_, N_, K_, S_, SLOTS_, CID_) GEMMS(EPI, E, Aptr, Bptr, M_, N_, K_, S_, SLOTS_, CID_, 0)
#define GEMMS(EPI, E, Aptr, Bptr, M_, N_, K_, S_, SLOTS_, CID_, SEGK_) do { pg8::Gemm g_{(const pg8::bf16_t*)(Aptr), (const pg8::bf16_t*)(Bptr), M_, N_, K_}; pg8::HybridOrder S_o; \
        S_o.init(M_, N_, K_, G, (int)blockIdx.x, S_, (float*)(SLOTS_), (unsigned*)(ws + WS_CTL) + (CID_) * 2048); \
        S_o.segk = SEGK_; pg8::gemm_phase<EPI, pg8::HybridOrder, true, true>(lds, g_, S_o, E); } while (0)
template <int l>
__device__ __forceinline__ void layer_phases(const Args& a, LAS unsigned char* lds, cg::grid_group& grid, const XcdBarrier& xbar, int lo, int hi) {
    const int G = gridDim.x; float* Y = a.out + O_Y;
        const int pb = 2 + 9 * l;
        int tid_l = threadIdx.x; asm volatile("" : "+v"(tid_l));
        unsigned char* ws = a.ws; asm volatile("" : "+s"(ws));
        const int tid = tid_l, lane = tid & 63, wave = __builtin_amdgcn_readfirstlane(tid >> 6), gw = blockIdx.x * 8 + wave, gtid = blockIdx.x * 512 + tid;
        float* mod = (float*)(ws + WS_MOD); bf16* Hb = (bf16*)(ws + WS_H); bf16* Pb = (bf16*)(ws + WS_P); float* MG = (float*)(ws + WS_MG); float* Xb = (float*)(ws + WS_X);
        const unsigned char* wl = ws + WS_WL + (size_t)l * WL_STRIDE;
        const float* xp = l == 0 ? a.in[I_XP] : Xb; const float* xs = l == 0 ? a.in[I_XS] : Xb + (size_t)NPTOK * DM;
        float* xout = l == 0 ? Xb : Y;
#ifndef NO_NORM
        if (IN(pb + 0)) norm_mod_phase(xp, xs, a.in[I_NORM1] + l * DM, mod, l, 0, Hb);
#endif
        SEAM(pb + 0);
#ifndef NO_G1
        if (IN(pb + 1)) { pg8::EpiP E{Pb}; GEMM(pg8::EpiP, E, Hb, wl + WL_IN, NTOK, IN_DIM, DM, SK_G1, ws + WS_WADA, 1 + 8 * l); }
#endif
        SEAM(pb + 1);
#ifndef NO_MIX
        if (IN(pb + 3)) mixer_phase(a, l, lds);
#endif
        SEAM(pb + 3);
#ifndef NO_MERGE
        if (IN(pb + 4)) {
            { pg8::EpiGlu E{(pg8::bf16_t*)MG, Pb}; GEMM(pg8::EpiGlu, E, ws + WS_YS, wl + WL_GA, NTOK, 2 * DM, 512, 1, ws + WS_WADA, 2 + 8 * l); }
            { pg8::EpiMergeMain E{(const pg8::bf16_t*)MG, Pb, Hb}; GEMMS(pg8::EpiMergeMain, E, ws + WS_O, wl + WL_O, NTOK, DM, 1536, 1, ws + WS_WADA, 3 + 8 * l, 16); }
        }
#endif
        SEAM(pb + 4);
#ifndef NO_REST
        if (IN(pb + 5)) { pg8::EpiResid E{xp, xs, mod + l * ADA_N + 2 * DM, Y}; GEMM(pg8::EpiResid, E, Hb, wl + WL_OUT, NTOK, DM, DM, SK_WO, ws + WS_WADA, 6 + 8 * l); }
        SEAM(pb + 5);
        if (IN(pb + 6)) norm_mod_phase(Y, Y + (size_t)NPTOK * DM, a.in[I_NORM2] + l * DM, mod, l, 1, Hb);
        SEAM(pb + 6);
        if (IN(pb + 7)) { pg8::EpiRelu2 E{Pb}; GEMM(pg8::EpiRelu2, E, Hb, wl + WL_F1, NTOK, FF, DM, SK_F1, ws + WS_WADA, 7 + 8 * l); }
        SEAM(pb + 7);
        if (IN(pb + 8)) { pg8::EpiResid E{Y, Y + (size_t)NPTOK * DM, mod + l * ADA_N + 5 * DM, xout}; GEMM(pg8::EpiResid, E, Pb, wl + WL_F2, NTOK, DM, FF, SK_F2, ws + WS_WADA, 8 + 8 * l); }
#endif
        SEAM(pb + 8);
}

__global__ void __launch_bounds__(512, 2) hybrid_fwd(Args a) {
    extern __shared__ __attribute__((aligned(16))) unsigned char lds_raw[];
    LAS unsigned char* lds = (LAS unsigned char*)lds_raw;
    cg::grid_group grid = cg::this_grid();
    const int tid = threadIdx.x, lane = tid & 63, wave = __builtin_amdgcn_readfirstlane(tid >> 6);
    const int G = gridDim.x, gw = blockIdx.x * 8 + wave, NGW = G * 8, gtid = blockIdx.x * 512 + tid, NGT = G * 512;
    unsigned char* ws = a.ws;
    const int lo = a.ph_lo, hi = a.ph_hi;
    if (threadIdx.x < 4) ((LAS unsigned*)(lds + LDS_ST_OFF))[threadIdx.x] = 0u;
    __syncthreads();
    if (a.ph_lo < 0) grid.sync();
    const XcdBarrier xbar = xcd_barrier_post((unsigned*)(a.ws + WS_CTL + WS_BAR), (volatile LAS unsigned*)(lds + LDS_ST_OFF));
    float* mod = (float*)(ws + WS_MOD);
    bf16* Hb = (bf16*)(ws + WS_H); bf16* Pb = (bf16*)(ws + WS_P); float* MG = (float*)(ws + WS_MG); float* Xb = (float*)(ws + WS_X);
    float* Y = a.out + O_Y;
#ifdef PROBE_SEL
    if (blockIdx.x == 0 && threadIdx.x == 0) ((unsigned long long*)(a.ws + WS_CTL + 512 * 1024))[0] = __builtin_amdgcn_s_memrealtime();
#endif
#ifndef NO_P0
    if (IN(0)) { p0_prologue(a, lds, gw, NGW, lane, wave, gtid, NGT); __syncthreads(); }
#endif
    SEAM(0);
#ifndef NO_ADA
    if (IN(1)) { pg8::EpiAda E{mod, a.in[I_BADA]}; GEMM(pg8::EpiAda, E, ws + WS_AC, ws + WS_WADA, 256, 2 * ADA_N, DM, 1, ws + WS_X, 0); convert_idle(a, lds, 0, 96, I_L0_PRO, I_LAYER); }
#endif
    SEAM(1);
    layer_phases<0>(a, lds, grid, xbar, lo, hi);
    layer_phases<1>(a, lds, grid, xbar, lo, hi);
#ifdef PROBE_SEL
    grid.sync();
    if (blockIdx.x == 0 && threadIdx.x == 0) { const unsigned long long* ts = (const unsigned long long*)(a.ws + WS_CTL + 512 * 1024);
        const float us = (float)(ts[PROBE_SEL + 1] - ts[PROBE_SEL]) * 0.01f;
#if PROBE_SEL < 50
        atomicAdd(a.out + O_NIS + 5, us * 0.01f);
#endif
    }
#if PROBE_SEL >= 50
    { const unsigned long long t0 = __builtin_amdgcn_s_memrealtime(); grid.sync(); grid.sync(); grid.sync(); grid.sync(); const unsigned long long t1 = __builtin_amdgcn_s_memrealtime();
      if (blockIdx.x == 0 && threadIdx.x == 0) atomicAdd(a.out + O_NIS + 5, (float)(t1 - t0) * 0.01f * 0.01f); }
#endif
#endif
#undef IN
#undef SEAM
#undef GEMM
}

extern "C" void kernel_launch(void* const* d_in, const int* in_sizes, int n_in, void* d_out, int out_size, void* d_ws, size_t ws_size, hipStream_t stream) {
    static int grid = 0;
    if (grid == 0) {
        if (n_in != 36 || (size_t)out_size != O_END || ws_size < WS_END) { fprintf(stderr, "kernel_launch: unexpected sizes n_in %d out %d ws %zu (need %zu)\n", n_in, out_size, ws_size, (size_t)WS_END); grid = -1; return; }
        int dev = 0, cus = 0, per_cu = 0;
        (void)hipGetDevice(&dev); (void)hipDeviceGetAttribute(&cus, hipDeviceAttributeMultiprocessorCount, dev);
        if (hipFuncSetAttribute((const void*)hybrid_fwd, hipFuncAttributeMaxDynamicSharedMemorySize, LDS_BYTES) != hipSuccess) { fprintf(stderr, "kernel_launch: hipFuncSetAttribute failed\n"); grid = -1; return; }
        if (hipOccupancyMaxActiveBlocksPerMultiprocessor(&per_cu, (const void*)hybrid_fwd, 512, LDS_BYTES) != hipSuccess || per_cu < 1) { fprintf(stderr, "kernel_launch: occupancy query failed (%d)\n", per_cu); per_cu = 1; }
        (void)hipGetLastError();
        if (per_cu > 1) per_cu = 1;
        grid = cus * per_cu;
        fprintf(stderr, "kernel_launch: grid %d (cus %d)\n", grid, cus);
    }
    if (grid < 0) return;
    (void)hipMemsetAsync((char*)d_ws + WS_CTL, 0, CTL_BYTES, stream);
    Args a{};
    for (int i = 0; i < 36; ++i) a.in[i] = (const float*)d_in[i];
    a.out = (float*)d_out; a.ws = (unsigned char*)d_ws;
#if MK_ONE_LAUNCH
    a.ph_lo = 0; a.ph_hi = NPHASE;
    void* args[] = {&a};
    hipError_t e = hipLaunchCooperativeKernel((const void*)hybrid_fwd, dim3(grid), dim3(512), args, LDS_BYTES, stream);
    if (e != hipSuccess) fprintf(stderr, "kernel_launch: cooperative launch failed: %s (grid %d)\n", hipGetErrorString(e), grid);
#else
    for (int k = 0; k < NPHASE; ++k) { a.ph_lo = k; a.ph_hi = k + 1; hipLaunchKernelGGL(hybrid_fwd, dim3(grid), dim3(512), LDS_BYTES, stream, a); }
#endif
}
```

```cpp
#include <hip/hip_runtime.h>
#include <hip/hip_cooperative_groups.h>
#include <cstdio>
#include <cstdint>
namespace cg = cooperative_groups;
namespace pg8 {
#define PG8_LAS __attribute__((address_space(3)))
typedef unsigned short bf16_t;
typedef short bf16x8 __attribute__((ext_vector_type(8)));
typedef float f32x4 __attribute__((ext_vector_type(4)));
typedef unsigned u32x4 __attribute__((ext_vector_type(4)));
constexpr int BM = 256, BK = 64, HALF = 128, HTB = HALF * BK * 2  , STAGE_BYTES = 8 * HTB, NXCD = 8, WGM = 8;

__host__ __device__ __forceinline__ int lds_byte(int r, int c) { const int st = (r >> 4) * 2 + (c >> 5), rr = r & 15, cc = c & 31, ob = rr * 64 + cc * 2; return st * 1024 + (ob ^ (((ob >> 9) & 1) << 5)); }
__host__ __device__ __forceinline__ void stage_rc(int b, int& R, int& C) { const int st = b / 1024, sb = b % 1024, swz = sb ^ (((sb >> 9) & 1) << 5); R = (st >> 1) * 16 + swz / 64; C = (st & 1) * 32 + (swz % 64) / 2; }
__host__ __device__ __forceinline__ int perm32(int rho) { const int n = rho >> 4, i = rho & 15; return 8 * (i >> 2) + 4 * n + (i & 3); }

struct Unit { int pm, pn, k0, nt, tail, part, seg; };
struct Gemm { const bf16_t* A; const bf16_t* Bt; int M, N, K; };

struct HybridOrder {
    int nM, nN, nwg, G, c, R, ntail, S, ntk, npart, segk; float* slots; unsigned* cnt;
    __device__ void init(int M, int N, int K, int G_, int c_, int S_, float* slots_, unsigned* cnt_) { nM = M / BM; nN = N / BM; nwg = nM * nN; G = G_; c = c_; R = nwg / G; ntail = nwg - R * G;
        S = S_; ntk = K / BK; npart = ntk / S; slots = slots_; cnt = cnt_; segk = 0; }
    __device__ void tile_of(int L, Unit& u) const {
        int wgid = L; { const int q = nwg / NXCD, r = nwg % NXCD, xcd = wgid % NXCD, off = wgid / NXCD; wgid = (xcd < r ? xcd * (q + 1) : r * (q + 1) + (xcd - r) * q) + off; }
        const int nig = WGM * nN, gid = wgid / nig, fm = gid * WGM, gsz = (nM - fm) < WGM ? (nM - fm) : WGM;
        u.pm = fm + ((wgid % nig) % gsz); u.pn = (wgid % nig) / gsz;
    }
    __device__ bool next(int i2, Unit& u) const {
        const int i = segk ? (i2 >> 1) : i2, sg = segk ? (i2 & 1) : 0;
        u.seg = 0;
        if (i < R) { tile_of(i * G + c, u); u.k0 = 0; u.nt = ntk; u.tail = -1; u.part = 0; }
        else if (i == R && c < ntail * S) { const int j = c % ntail, p = c / ntail; tile_of(R * G + j, u); u.k0 = p * npart; u.nt = npart; u.tail = S > 1 ? j : -1; u.part = p; }
        else return false;
        if (segk) { if (sg == 0) { u.nt = segk; u.seg = 1; } else { u.k0 = segk; u.nt = ntk - segk; } }
        return true;
    }
    __device__ __forceinline__ void a_ready(const Unit&) const {}
    __device__ __forceinline__ void done(const Unit&) const {}
};

__device__ __forceinline__ unsigned cvt_pk_bf16(float lo, float hi) { unsigned r; asm volatile("v_cvt_pk_bf16_f32 %0, %1, %2" : "=v"(r) : "v"(lo), "v"(hi)); return r; }
typedef float f32x2 __attribute__((ext_vector_type(2)));
template <int NS, class Sched>
__device__ __forceinline__ unsigned tail_exchange_t(f32x4 (&acc)[2][2][4][2], const Unit& u, const Sched& S, int tid) {
    constexpr int RS = 32 / NS; const int part = u.part;
    float* base = S.slots + (size_t)(u.tail * NS) * 65536 + tid * 4;
    float* mine = base + (size_t)part * 65536;
#pragma unroll
    for (int ai = 0; ai < 2; ++ai)
#pragma unroll
        for (int m = 0; m < 4; ++m)
#pragma unroll
            for (int bj = 0; bj < 2; ++bj)
#pragma unroll
                for (int n = 0; n < 2; ++n) { const int r = ((ai * 4 + m) * 2 + bj) * 2 + n; const f32x4 v = acc[ai][bj][m][n]; const float* q = mine + r * 2048;
                    asm volatile("global_store_dwordx4 %0, %1, off sc1" :: "v"(q), "v"(v) : "memory"); }
    asm volatile("s_waitcnt vmcnt(0)" ::: "memory");
    __builtin_amdgcn_s_barrier();
    if (tid == 0) { unsigned* cw = S.cnt + u.tail * 16; __hip_atomic_fetch_add(cw, 1u, __ATOMIC_RELAXED, __HIP_MEMORY_SCOPE_AGENT);
        unsigned sp = 0; while (__hip_atomic_load(cw, __ATOMIC_RELAXED, __HIP_MEMORY_SCOPE_AGENT) < (unsigned)NS) { __builtin_amdgcn_s_sleep(2); if (++sp > (1u << 22)) break; } }
    asm volatile("s_waitcnt vmcnt(0) lgkmcnt(0)" ::: "memory");
    __builtin_amdgcn_s_barrier();
    asm volatile("" ::: "memory");
#pragma unroll
    for (int ai = 0; ai < 2; ++ai)
#pragma unroll
        for (int m = 0; m < 4; ++m)
#pragma unroll
            for (int bj = 0; bj < 2; ++bj)
#pragma unroll
                for (int n = 0; n < 2; ++n) { const int r = ((ai * 4 + m) * 2 + bj) * 2 + n;
                    if (r / RS == part) { f32x4 pv[NS];
#pragma unroll
                        for (int pp = 0; pp < NS; ++pp) { const float* q = base + (size_t)pp * 65536 + r * 2048; asm volatile("global_load_dwordx4 %0, %1, off sc1" : "=v"(pv[pp]) : "v"(q) : "memory"); }
                        if constexpr (NS == 16) asm volatile("s_waitcnt vmcnt(0)" : "+v"(pv[0]), "+v"(pv[1]), "+v"(pv[2]), "+v"(pv[3]), "+v"(pv[4]), "+v"(pv[5]), "+v"(pv[6]), "+v"(pv[7]), "+v"(pv[8 % NS]), "+v"(pv[9 % NS]), "+v"(pv[10 % NS]), "+v"(pv[11 % NS]), "+v"(pv[12 % NS]), "+v"(pv[13 % NS]), "+v"(pv[14 % NS]), "+v"(pv[15 % NS]) :: "memory");
                        else if constexpr (NS == 8) asm volatile("s_waitcnt vmcnt(0)" : "+v"(pv[0]), "+v"(pv[1]), "+v"(pv[2 % NS]), "+v"(pv[3 % NS]), "+v"(pv[4 % NS]), "+v"(pv[5 % NS]), "+v"(pv[6 % NS]), "+v"(pv[7 % NS]) :: "memory");
                        else if constexpr (NS == 4) asm volatile("s_waitcnt vmcnt(0)" : "+v"(pv[0]), "+v"(pv[1]), "+v"(pv[2 % NS]), "+v"(pv[3 % NS]) :: "memory");
                        else asm volatile("s_waitcnt vmcnt(0)" : "+v"(pv[0]), "+v"(pv[1]) :: "memory");
                        f32x4 s = pv[0];
#pragma unroll
                        for (int pp = 1; pp < NS; ++pp) s += pv[pp];
                        acc[ai][bj][m][n] = s; } }
    return (RS >= 32 ? 0xffffffffu : ((1u << RS) - 1u)) << (part * RS);
}
template <class Sched>
__device__ __forceinline__ unsigned tail_exchange(f32x4 (&acc)[2][2][4][2], const Unit& u, const Sched& S, int tid) {
    if (S.S == 8) return tail_exchange_t<8>(acc, u, S, tid);
    if (S.S == 16) return tail_exchange_t<16>(acc, u, S, tid);
    if (S.S == 2) return tail_exchange_t<2>(acc, u, S, tid);
    return tail_exchange_t<4>(acc, u, S, tid);
}
template <class Epi, class Sched, bool ALIGN_EPI = false, bool SP2 = false>
__device__ __forceinline__ void gemm_phase(PG8_LAS unsigned char* lds, const Gemm g, const Sched& S, const Epi& E) {
    int tid_ = threadIdx.x; asm volatile("" : "+v"(tid_));
    const int tid = tid_, wid = __builtin_amdgcn_readfirstlane(tid >> 6), lane = tid & 63, wr = wid >> 2, wc = wid & 3, fr = lane & 15, fq = lane >> 4;
    const int K = g.K;
    unsigned voffA[2], voffB[2];
#pragma unroll
    for (int i = 0; i < 2; ++i) { int R, C; stage_rc(tid * 16 + i * 8192, R, C); const int Rb = Epi::PERM ? ((R & ~31) + perm32(R & 31)) : R;
        voffA[i] = (unsigned)(R * K + C) * 2u; voffB[i] = (unsigned)(Rb * K + C) * 2u; }
    const size_t kstep = (size_t)(BK * 2);
    const size_t hstep = (size_t)HALF * K * 2;
    const size_t tstep = 2 * hstep;
    const unsigned ldsw = (unsigned)wid * 1024u;
    const int aoff = lds_byte(wr * 64 + fr, fq * 8), boff = lds_byte(wc * 32 + fr, fq * 8);
#define PG8_SA(b, h) (((b) * 2 + (h)) * HTB)
#define PG8_SB(b, h) ((4 + (b) * 2 + (h)) * HTB)
#define PG8_STAGE(bufoff, gbase, voff) do { _Pragma("unroll") for (int _i = 0; _i < 2; ++_i) \
        __builtin_amdgcn_global_load_lds((const unsigned*)((const char*)(gbase) + (voff)[_i]), (PG8_LAS unsigned*)(lds + (bufoff) + ldsw + _i * 8192), 16, 0, 0); } while (0)
#define PG8_LDA(dst, b, h) do { _Pragma("unroll") for (int m = 0; m < 4; ++m) _Pragma("unroll") for (int k = 0; k < 2; ++k) dst[m][k] = *(const PG8_LAS bf16x8*)(lds + PG8_SA(b, h) + aoff + m * 2048 + k * 1024); } while (0)
#define PG8_LDB(dst, b, h) do { _Pragma("unroll") for (int n = 0; n < 2; ++n) _Pragma("unroll") for (int k = 0; k < 2; ++k) dst[n][k] = *(const PG8_LAS bf16x8*)(lds + PG8_SB(b, h) + boff + n * 2048 + k * 1024); } while (0)
#define PG8_MMA(ai, bj, At, Bt) do { __builtin_amdgcn_s_setprio(1); _Pragma("unroll") for (int m = 0; m < 4; ++m) _Pragma("unroll") for (int n = 0; n < 2; ++n) _Pragma("unroll") for (int k = 0; k < 2; ++k) \
        acc[ai][bj][m][n] = __builtin_amdgcn_mfma_f32_16x16x32_bf16(Bt[n][k], At[m][k], acc[ai][bj][m][n], 0, 0, 0); __builtin_amdgcn_s_setprio(0); } while (0)
#define PG8_WAIT_V(n) asm volatile("s_waitcnt vmcnt(" #n ")" ::: "memory")
#define PG8_WAIT_L(n) asm volatile("s_waitcnt lgkmcnt(" #n ")" ::: "memory")
#define PG8_BAR __builtin_amdgcn_s_barrier()
#define PG8_SCHED __builtin_amdgcn_sched_barrier(0)
    Unit cur, nxt; int ui = 0;
    if (!S.next(0, cur)) return;
    f32x4 acc[2][2][4][2];
#pragma unroll
    for (int a = 0; a < 2; ++a)
#pragma unroll
        for (int b = 0; b < 2; ++b)
#pragma unroll
            for (int m = 0; m < 4; ++m)
#pragma unroll
                for (int n = 0; n < 2; ++n) acc[a][b][m][n] = (f32x4){0.f, 0.f, 0.f, 0.f};
    bf16x8 At[4][2], B0[2][2], B1[2][2];
    const char* cA = (const char*)g.A + (size_t)cur.pm * tstep + (size_t)cur.k0 * kstep; const char* cB = (const char*)g.Bt + (size_t)cur.pn * tstep + (size_t)cur.k0 * kstep;
    S.a_ready(cur);
    if constexpr (SP2) {
        PG8_STAGE(PG8_SB(0, 0), cB, voffB); PG8_STAGE(PG8_SB(0, 1), cB + hstep, voffB); PG8_STAGE(PG8_SA(0, 0), cA, voffA); PG8_STAGE(PG8_SA(0, 1), cA + hstep, voffA);
        if (wr == 1) PG8_BAR;
        PG8_WAIT_V(2); PG8_BAR;
        PG8_STAGE(PG8_SB(1, 0), cB + kstep, voffB); PG8_STAGE(PG8_SA(1, 0), cA + kstep, voffA); PG8_STAGE(PG8_SB(1, 1), cB + hstep + kstep, voffB);
        PG8_WAIT_V(6); PG8_BAR;
    } else {
        PG8_STAGE(PG8_SB(0, 0), cB, voffB); PG8_STAGE(PG8_SA(0, 0), cA, voffA); PG8_STAGE(PG8_SB(0, 1), cB + hstep, voffB); PG8_STAGE(PG8_SA(0, 1), cA + hstep, voffA);
        if (wr == 1) PG8_BAR;
        PG8_WAIT_V(4); PG8_BAR;
        PG8_STAGE(PG8_SB(1, 0), cB + kstep, voffB); PG8_STAGE(PG8_SA(1, 0), cA + kstep, voffA); PG8_STAGE(PG8_SB(1, 1), cB + hstep + kstep, voffB);
        PG8_WAIT_V(6); PG8_BAR;
    }
    for (;;) {
        const bool has_next = S.next(ui + 1, nxt);
        const char* nA = has_next ? (const char*)g.A + (size_t)nxt.pm * tstep + (size_t)nxt.k0 * kstep : cA; const char* nB = has_next ? (const char*)g.Bt + (size_t)nxt.pn * tstep + (size_t)nxt.k0 * kstep : cB;
        const int nt = cur.nt;
        for (int t = 0; t < nt; t += 2) {
            const bool last = (t == nt - 2);
            const char* a1 = cA + (size_t)(t + 1) * kstep;
            const char* a2 = last ? nA : cA + (size_t)(t + 2) * kstep; const char* b2 = last ? nB : cB + (size_t)(t + 2) * kstep;
            const char* a3 = a2 + kstep; const char* b3 = b2 + kstep;
            if (last && has_next) S.a_ready(nxt);
            if constexpr (SP2) {
            PG8_LDB(B0, 0, 0); PG8_LDB(B1, 0, 1); PG8_SCHED; PG8_LDA(At, 0, 0); PG8_STAGE(PG8_SA(1, 1), a1 + hstep, voffA);
            PG8_WAIT_V(8); PG8_WAIT_L(0); PG8_BAR; PG8_MMA(0, 0, At, B0); PG8_MMA(0, 1, At, B1); PG8_BAR; PG8_SCHED;
            PG8_LDA(At, 0, 1); PG8_STAGE(PG8_SB(0, 0), b2, voffB); PG8_STAGE(PG8_SB(0, 1), b2 + hstep, voffB); PG8_STAGE(PG8_SA(0, 0), a2, voffA);
            PG8_WAIT_V(8); PG8_WAIT_L(0); PG8_BAR; PG8_MMA(1, 0, At, B0); PG8_MMA(1, 1, At, B1); PG8_BAR; PG8_SCHED;
            PG8_LDB(B0, 1, 0); PG8_LDB(B1, 1, 1); PG8_SCHED; PG8_LDA(At, 1, 0); PG8_STAGE(PG8_SA(0, 1), a2 + hstep, voffA);
            PG8_WAIT_V(8); PG8_WAIT_L(0); PG8_BAR; PG8_MMA(0, 0, At, B0); PG8_MMA(0, 1, At, B1); PG8_BAR; PG8_SCHED;
            PG8_LDA(At, 1, 1); PG8_STAGE(PG8_SB(1, 0), b3, voffB); PG8_STAGE(PG8_SB(1, 1), b3 + hstep, voffB); PG8_STAGE(PG8_SA(1, 0), a3, voffA);
            PG8_WAIT_V(8); PG8_WAIT_L(0); PG8_BAR; PG8_MMA(1, 0, At, B0); PG8_MMA(1, 1, At, B1); PG8_BAR; PG8_SCHED;
            } else {
            PG8_LDB(B0, 0, 0); PG8_SCHED; PG8_LDA(At, 0, 0); PG8_STAGE(PG8_SA(1, 1), a1 + hstep, voffA);
            PG8_WAIT_L(8); PG8_BAR; PG8_WAIT_L(0); PG8_MMA(0, 0, At, B0); PG8_BAR; PG8_SCHED;
            PG8_LDB(B1, 0, 1); PG8_STAGE(PG8_SB(0, 0), b2, voffB);
            PG8_BAR; PG8_WAIT_L(0); PG8_MMA(0, 1, At, B1); PG8_BAR;
            PG8_LDA(At, 0, 1); PG8_STAGE(PG8_SA(0, 0), a2, voffA);
            PG8_BAR; PG8_WAIT_L(0); PG8_MMA(1, 0, At, B0); PG8_BAR; PG8_SCHED;
            PG8_STAGE(PG8_SB(0, 1), b2 + hstep, voffB);
            PG8_WAIT_V(6); PG8_BAR; PG8_MMA(1, 1, At, B1); PG8_BAR;
            PG8_LDB(B0, 1, 0); PG8_SCHED; PG8_LDA(At, 1, 0); PG8_STAGE(PG8_SA(0, 1), a2 + hstep, voffA);
            PG8_WAIT_L(8); PG8_BAR; PG8_WAIT_L(0); PG8_MMA(0, 0, At, B0); PG8_BAR; PG8_SCHED;
            PG8_LDB(B1, 1, 1); PG8_STAGE(PG8_SB(1, 0), b3, voffB);
            PG8_BAR; PG8_WAIT_L(0); PG8_MMA(0, 1, At, B1); PG8_BAR;
            PG8_LDA(At, 1, 1); PG8_STAGE(PG8_SA(1, 0), a3, voffA);
            PG8_BAR; PG8_WAIT_L(0); PG8_MMA(1, 0, At, B0); PG8_BAR; PG8_SCHED;
            PG8_STAGE(PG8_SB(1, 1), b3 + hstep, voffB);
            PG8_WAIT_V(6); PG8_BAR; PG8_MMA(1, 1, At, B1); PG8_BAR;
            }
        }
        if constexpr (ALIGN_EPI) { if (wr == 0) PG8_BAR; }
        if (cur.seg == 1) { if constexpr (Epi::MID_T > 0) E.mid(acc, cur, wr, wc, fr, fq); }
        else { unsigned rmask = 0xffffffffu; if (cur.tail >= 0) rmask = tail_exchange(acc, cur, S, tid); E(acc, cur, wr, wc, fr, fq, rmask); }
        if (!has_next) break;
        if (cur.seg != 1)
#pragma unroll
        for (int a = 0; a < 2; ++a)
#pragma unroll
            for (int b = 0; b < 2; ++b)
#pragma unroll
                for (int m = 0; m < 4; ++m)
#pragma unroll
                    for (int n = 0; n < 2; ++n) acc[a][b][m][n] = (f32x4){0.f, 0.f, 0.f, 0.f};
        cur = nxt; cA = nA; cB = nB; ++ui;
        if constexpr (ALIGN_EPI) { if (wr == 1) PG8_BAR; }
    }
    PG8_WAIT_V(0);
    if constexpr (!ALIGN_EPI) { if (wr == 0) PG8_BAR; }
    PG8_BAR;
#undef PG8_SA
#undef PG8_SB
#undef PG8_STAGE
#undef PG8_LDA
#undef PG8_LDB
#undef PG8_MMA
#undef PG8_WAIT_V
#undef PG8_WAIT_L
#undef PG8_BAR
#undef PG8_SCHED
}
}

#define LAS __attribute__((address_space(3)))
typedef unsigned short bf16;
typedef unsigned v4u __attribute__((ext_vector_type(4)));
typedef unsigned v2u __attribute__((ext_vector_type(2)));
typedef float f32x4 __attribute__((ext_vector_type(4)));
typedef float f32x2 __attribute__((ext_vector_type(2)));
typedef short bf16x8 __attribute__((ext_vector_type(8)));
typedef short s16x4 __attribute__((ext_vector_type(4)));

#ifndef MK_ONE_LAUNCH
#define MK_ONE_LAUNCH 1
#endif

constexpr int DM = 2048, NTOK = 9216, NPTOK = 8192, SEQ = 2048, NB = 4, DECB = 128, DECT = 8;
constexpr int IN_DIM = 9216, FF = 8192, ADA_N = 12288;
constexpr int C_K = 1024, C_V = 1280, C_XA = 1536, C_XB = 2048, C_XS = 2560, C_G = 3072;
constexpr int NMODROW = 132;
constexpr int NPHASE = 20;
constexpr int SK_G1 = 16, SK_MG = 1, SK_WO = 8, SK_F1 = 2, SK_F2 = 8;

constexpr size_t MiB = 1u << 20;
constexpr size_t WS_CTL = 0, CTL_BYTES = 1 * MiB;
constexpr size_t WS_ROPE = 1 * MiB, WS_AC = 2 * MiB, WS_MOD = 3 * MiB, WS_WADA = 16 * MiB;
constexpr size_t WS_WL = 112 * MiB, WL_STRIDE = 118 * MiB;
constexpr size_t WL_IN = 0, WL_O = 36 * MiB, WL_CO = 40 * MiB, WL_GA = 42 * MiB, WL_GB = 44 * MiB, WL_OUT = 46 * MiB, WL_F1 = 54 * MiB, WL_F2 = 86 * MiB;
constexpr size_t WS_H = 348 * MiB;
constexpr size_t WS_P = 384 * MiB;
constexpr size_t WS_QN = 546 * MiB, WS_KN = 564 * MiB, WS_O = 569 * MiB, WS_YC = 587 * MiB, WS_YS = 596 * MiB;
constexpr size_t WS_MG = 605 * MiB;
constexpr size_t WS_X = 677 * MiB;
constexpr size_t WS_SLOT2 = 749 * MiB;
constexpr size_t WS_END = 781 * MiB;

constexpr size_t O_Y = 0;
constexpr size_t O_NKP = (size_t)NTOK * DM;
constexpr size_t O_NVP = O_NKP + 2 * 4 * 128 * 256;
constexpr size_t O_NCP = O_NVP + 2 * 4 * 128 * 256;
constexpr size_t O_NRP = O_NCP + 2 * 4 * 30 * 512;
constexpr size_t O_NIP = O_NRP + 2 * 4 * 32 * 64;
constexpr size_t O_NKS = O_NIP + 2 * 4 * 32 * 64;
constexpr size_t O_NVS = O_NKS + (size_t)2 * 128 * 128 * 256;
constexpr size_t O_NCS = O_NVS + (size_t)2 * 128 * 128 * 256;
constexpr size_t O_NRS = O_NCS + (size_t)2 * 128 * 30 * 512;
constexpr size_t O_NIS = O_NRS + (size_t)2 * 128 * 32 * 64;
constexpr size_t O_END = O_NIS + (size_t)2 * 128 * 32 * 64;

constexpr int LDS_BYTES = 135168;

struct Args { const float* in[36]; float* out; unsigned char* ws; int ph_lo, ph_hi; };

enum { I_XP = 0, I_XS, I_CP, I_CS, I_CK, I_CV, I_SCONV, I_SRE, I_SIM, I_WADA, I_BADA, I_NORM1, I_WIN, I_QN, I_KN, I_SINK, I_WO, I_CW, I_CB, I_CLG, I_CLB, I_WCO,
       I_ARE, I_AIM, I_LDT, I_BRE, I_BIM, I_CRE, I_CIM, I_SD, I_WGA, I_WGB, I_WOUT, I_NORM2, I_WF1, I_WF2 };

__device__ __forceinline__ float bf2f(unsigned b) { return __uint_as_float(b << 16); }
__device__ __forceinline__ unsigned pk2(float lo, float hi) { unsigned r; asm("v_cvt_pk_bf16_f32 %0, %1, %2" : "=v"(r) : "v"(lo), "v"(hi)); return r; }
__device__ __forceinline__ unsigned f2bf(float f) { return pk2(f, 0.f) & 0xffffu; }
__device__ __forceinline__ float lo16(unsigned w) { return __uint_as_float(w << 16); }
__device__ __forceinline__ float hi16(unsigned w) { return __uint_as_float(w & 0xffff0000u); }
__device__ __forceinline__ float sigm(float x) { return __builtin_amdgcn_rcpf(1.f + __expf(-x)); }
__device__ __forceinline__ float wave_sum(float v) {
#pragma unroll
    for (int o = 1; o < 64; o <<= 1) v += __shfl_xor(v, o);
    return v;
}
#define LDS_WAIT() asm volatile("s_waitcnt lgkmcnt(0)" ::: "memory")
#define WAVE_SYNC() do { asm volatile("s_waitcnt lgkmcnt(0)" ::: "memory"); __builtin_amdgcn_wave_barrier(); asm volatile("" ::: "memory"); } while (0)

__device__ __forceinline__ double dexp_(double x) {
    const double kf = rint(x * 1.4426950408889634);
    double r = fma(-kf, 6.93147180369123816490e-01, x); r = fma(-kf, 1.90821492927058770002e-10, r);
    double p = 1.0 / 6227020800.0;
    p = fma(p, r, 1.0 / 479001600.0); p = fma(p, r, 1.0 / 39916800.0); p = fma(p, r, 1.0 / 3628800.0); p = fma(p, r, 1.0 / 362880.0);
    p = fma(p, r, 1.0 / 40320.0); p = fma(p, r, 1.0 / 5040.0); p = fma(p, r, 1.0 / 720.0); p = fma(p, r, 1.0 / 120.0);
    p = fma(p, r, 1.0 / 24.0); p = fma(p, r, 1.0 / 6.0); p = fma(p, r, 0.5); p = fma(p, r, 1.0); p = fma(p, r, 1.0);
    const long long k = (long long)kf;
    return p * __longlong_as_double((1023ll + k) << 52);
}
__device__ __forceinline__ void dsincos_(double x, double& sn, double& cs) {
    const double kf = rint(x * 0.15915494309189535);
    double r = fma(-kf, 6.283185307179586, x); r = fma(-kf, 2.4492935982947064e-16, r);
    const double s = r * 0.125, z = s * s;
    double ps = -1.0 / 355687428096000.0;
    ps = fma(ps, z, 1.0 / 1307674368000.0); ps = fma(ps, z, -1.0 / 6227020800.0); ps = fma(ps, z, 1.0 / 39916800.0); ps = fma(ps, z, -1.0 / 362880.0);
    ps = fma(ps, z, 1.0 / 5040.0); ps = fma(ps, z, -1.0 / 120.0); ps = fma(ps, z, 1.0 / 6.0);
    double a = s - s * z * ps;
    double pc = 1.0 / 20922789888000.0;
    pc = fma(pc, z, -1.0 / 87178291200.0); pc = fma(pc, z, 1.0 / 479001600.0); pc = fma(pc, z, -1.0 / 3628800.0); pc = fma(pc, z, 1.0 / 40320.0);
    pc = fma(pc, z, -1.0 / 720.0); pc = fma(pc, z, 1.0 / 24.0); pc = fma(pc, z, -0.5);
    double b = fma(pc, z, 1.0);
#pragma unroll
    for (int i = 0; i < 3; ++i) { const double a2 = 2.0 * a * b, b2 = 1.0 - 2.0 * a * a; a = a2; b = b2; }
    sn = a; cs = b;
}

namespace pg8 {
#define EPI_FOREACH4(...) \
    _Pragma("unroll") for (int ai = 0; ai < 2; ++ai) _Pragma("unroll") for (int m = 0; m < 4; ++m) { const int row = u.pm * BM + ai * HALF + wr * 64 + m * 16 + fr; \
    _Pragma("unroll") for (int bj = 0; bj < 2; ++bj) _Pragma("unroll") for (int n = 0; n < 2; ++n) { const int col = u.pn * BM + bj * HALF + wc * 32 + n * 16 + 4 * fq; const f32x4 v = acc[ai][bj][m][n]; if ((rmask >> (((ai * 4 + m) * 2 + bj) * 2 + n)) & 1u) { __VA_ARGS__ } } if (m & 1) { asm volatile("" ::: "memory"); __builtin_amdgcn_sched_barrier(0); } }
#define EPI_FOREACH8(...) \
    _Pragma("unroll") for (int ai = 0; ai < 2; ++ai) _Pragma("unroll") for (int m = 0; m < 4; ++m) { const int row = u.pm * BM + ai * HALF + wr * 64 + m * 16 + fr; \
    _Pragma("unroll") for (int bj = 0; bj < 2; ++bj) { const int col = u.pn * BM + bj * HALF + wc * 32 + 8 * fq; const f32x4 v0 = acc[ai][bj][m][0], v1 = acc[ai][bj][m][1]; if ((rmask >> (((ai * 4 + m) * 2 + bj) * 2)) & 1u) { __VA_ARGS__ } } if (m & 1) { asm volatile("" ::: "memory"); __builtin_amdgcn_sched_barrier(0); } }
#define EPI_SIG const f32x4 (&acc)[2][2][4][2], const Unit& u, int wr, int wc, int fr, int fq, unsigned rmask

__device__ __forceinline__ int mod_row(int row) { return row < NPTOK ? (row >> 11) : 4 + ((row - NPTOK) >> 3); }
__device__ __forceinline__ v4u pack8(const f32x4 a, const f32x4 b) { v4u w; w.x = cvt_pk_bf16(a[0], a[1]); w.y = cvt_pk_bf16(a[2], a[3]); w.z = cvt_pk_bf16(b[0], b[1]); w.w = cvt_pk_bf16(b[2], b[3]); return w; }

struct EpiAda {
    static constexpr bool PERM = false, AFTER_DRAIN = false; static constexpr int MID_T = -1; float* mod; const float* bias;
    __device__ __forceinline__ void operator()(EPI_SIG) const {
        EPI_FOREACH4( if (row < NMODROW) { const f32x4 bv = *(const f32x4*)(bias + col); *(f32x4*)(mod + row * (2 * ADA_N) + col) = v + bv; } )
    }
};
struct EpiP {
    static constexpr bool PERM = true, AFTER_DRAIN = false; static constexpr int MID_T = -1; bf16_t* P;
    __device__ __forceinline__ void operator()(EPI_SIG) const {
        const bool sg = (u.pn * BM) >= C_G;
        EPI_FOREACH8( f32x4 a = v0, b = v1; if (sg) {
            _Pragma("unroll") for (int i = 0; i < 4; ++i) { a[i] = sigm(a[i]); b[i] = sigm(b[i]); } }
            *(v4u*)(P + (unsigned)(row * IN_DIM + col)) = pack8(a, b); )
    }
};
struct EpiStoreF32 {
    static constexpr bool PERM = false, AFTER_DRAIN = false; static constexpr int MID_T = -1; float* MG;
    __device__ __forceinline__ void operator()(EPI_SIG) const { EPI_FOREACH4( *(f32x4*)(MG + (unsigned)(row * DM + col)) = v; ) }
};
__device__ __forceinline__ f32x4 gate4(const bf16_t* P, int row, int col, int br) {
    const v2u g = *(const v2u*)(P + (unsigned)(row * IN_DIM + C_G + br * DM + col)); return (f32x4){lo16(g.x), hi16(g.x), lo16(g.y), hi16(g.y)};
}
struct EpiGluB {
    static constexpr bool PERM = false, AFTER_DRAIN = false; static constexpr int MID_T = -1; float* MG; const bf16_t* P;
    __device__ __forceinline__ void operator()(EPI_SIG) const {
        EPI_FOREACH4( float* p = MG + (unsigned)(row * DM + col); const f32x4 a = *(const f32x4*)p; const f32x4 g = gate4(P, row, col, 2); f32x4 o;
            _Pragma("unroll") for (int i = 0; i < 4; ++i) o[i] = g[i] * a[i] * sigm(v[i]);
            *(f32x4*)p = o; )
    }
};
struct EpiAccG {
    static constexpr bool PERM = false, AFTER_DRAIN = false; static constexpr int MID_T = -1; float* MG; const bf16_t* P; int br;
    __device__ __forceinline__ void operator()(EPI_SIG) const {
        EPI_FOREACH4( float* p = MG + (unsigned)(row * DM + col); const f32x4 a = *(const f32x4*)p; const f32x4 g = gate4(P, row, col, br); *(f32x4*)p = a + g * v; )
    }
};
struct EpiMergeFinal {
    static constexpr bool PERM = false, AFTER_DRAIN = false; static constexpr int MID_T = -1; const float* MG; const bf16_t* P; bf16_t* MGb; int br;
    __device__ __forceinline__ void operator()(EPI_SIG) const {
        EPI_FOREACH4( const f32x4 a = *(const f32x4*)(MG + (unsigned)(row * DM + col)); const f32x4 g = gate4(P, row, col, br); const f32x4 o = a + g * v;
            v2u w; w.x = cvt_pk_bf16(o[0], o[1]); w.y = cvt_pk_bf16(o[2], o[3]); *(v2u*)(MGb + (unsigned)(row * DM + col)) = w; )
    }
};
struct EpiGlu {
    static constexpr bool PERM = false, AFTER_DRAIN = false; static constexpr int MID_T = -1; bf16_t* MGa; const bf16_t* P;
    __device__ __forceinline__ void operator()(EPI_SIG) const {
        _Pragma("unroll") for (int ai = 0; ai < 2; ++ai) _Pragma("unroll") for (int m = 0; m < 4; ++m) { const int row = u.pm * BM + ai * HALF + wr * 64 + m * 16 + fr;
            _Pragma("unroll") for (int bj = 0; bj < 2; ++bj) { if ((rmask >> (((ai * 4 + m) * 2 + bj) * 2)) & 1u) {
                const int j = u.pn * 128 + bj * 64 + wc * 16 + 4 * fq; const f32x4 av = acc[ai][bj][m][0], bv = acc[ai][bj][m][1]; const f32x4 g = gate4(P, row, j, 2); f32x4 o;
                _Pragma("unroll") for (int i = 0; i < 4; ++i) o[i] = g[i] * av[i] * sigm(bv[i]);
                v2u w; w.x = cvt_pk_bf16(o[0], o[1]); w.y = cvt_pk_bf16(o[2], o[3]); *(v2u*)(MGa + (unsigned)(row * DM + j)) = w; } }
            if (m & 1) { asm volatile("" ::: "memory"); __builtin_amdgcn_sched_barrier(0); } }
    }
};
struct EpiMergeMain {
    static constexpr bool PERM = false, AFTER_DRAIN = false; static constexpr int MID_T = 16; const bf16_t* MGa; const bf16_t* P; bf16_t* MGb;
    __device__ __forceinline__ void mid(f32x4 (&acc)[2][2][4][2], const Unit& u, int wr, int wc, int fr, int fq) const {
        _Pragma("unroll") for (int ai = 0; ai < 2; ++ai) _Pragma("unroll") for (int m = 0; m < 4; ++m) { const int row = u.pm * BM + ai * HALF + wr * 64 + m * 16 + fr;
            _Pragma("unroll") for (int bj = 0; bj < 2; ++bj) _Pragma("unroll") for (int n = 0; n < 2; ++n) { const int col = u.pn * BM + bj * HALF + wc * 32 + n * 16 + 4 * fq;
                const f32x4 g0 = gate4(P, row, col, 0), g1 = gate4(P, row, col, 1); f32x4 r;
                _Pragma("unroll") for (int i = 0; i < 4; ++i) r[i] = g0[i] * __builtin_amdgcn_rcpf(fmaxf(g1[i], 1e-30f));
                acc[ai][bj][m][n] = acc[ai][bj][m][n] * r; }
            if (m & 1) { asm volatile("" ::: "memory"); __builtin_amdgcn_sched_barrier(0); } }
    }
    __device__ __forceinline__ void operator()(EPI_SIG) const {
        EPI_FOREACH4( const f32x4 g1 = gate4(P, row, col, 1); const v2u mw = *(const v2u*)(MGa + (unsigned)(row * DM + col)); const f32x4 mg = (f32x4){lo16(mw.x), hi16(mw.x), lo16(mw.y), hi16(mw.y)};
            const f32x4 o = g1 * v + mg; v2u w; w.x = cvt_pk_bf16(o[0], o[1]); w.y = cvt_pk_bf16(o[2], o[3]); *(v2u*)(MGb + (unsigned)(row * DM + col)) = w; )
    }
};
struct EpiResid {
    static constexpr bool PERM = false, AFTER_DRAIN = false; static constexpr int MID_T = -1; const float* xp; const float* xs; const float* gate; float* out;
    __device__ __forceinline__ void operator()(EPI_SIG) const {
        const bool smp = u.pm * BM >= NPTOK; const float* xb = smp ? xs : xp; const int rb = smp ? NPTOK : 0;
        EPI_FOREACH4( const f32x4 x = *(const f32x4*)(xb + (unsigned)((row - rb) * DM + col));
            const int mr = smp ? 4 + ((row - NPTOK) >> 3) : (row >> 11);
            const f32x4 g = *(const f32x4*)(gate + (unsigned)(mr * (2 * ADA_N) + col)); *(f32x4*)(out + (unsigned)(row * DM + col)) = x + g * v; )
    }
};
struct EpiRelu2 {
    static constexpr bool PERM = true, AFTER_DRAIN = false; static constexpr int MID_T = -1; bf16_t* F;
    __device__ __forceinline__ void operator()(EPI_SIG) const {
        EPI_FOREACH8( f32x4 a = v0, b = v1;
            _Pragma("unroll") for (int i = 0; i < 4; ++i) { const float x = fmaxf(a[i], 0.f), y = fmaxf(b[i], 0.f); a[i] = x * x; b[i] = y * y; }
            *(v4u*)(F + (unsigned)(row * FF + col)) = pack8(a, b); )
    }
};
}

__device__ __forceinline__ void p0_transpose_item(const float* W, int K, int N, bf16* WT, int pitch, int koff, int row_off, int sel, LAS float* scr, int item, int lane) {
    const int nblk = N / 32, kb = item / nblk, nb = item % nblk, k0 = 64 * kb, n0 = 32 * nb;
#pragma unroll 16
    for (int i = 0; i < 32; ++i) { const int kk = 2 * i + (lane >> 5); scr[kk * 33 + (lane & 31)] = __builtin_nontemporal_load(W + (size_t)(k0 + kk) * N + n0 + (lane & 31)); }
    LDS_WAIT(); asm volatile("" ::: "memory");
    const int c = lane & 7;
#pragma unroll
    for (int j = 0; j < 4; ++j) { const int n = (lane >> 3) + 8 * j; const LAS float* s = scr + (8 * c) * 33 + n;
        v4u o; o.x = pk2(s[0 * 33], s[1 * 33]); o.y = pk2(s[2 * 33], s[3 * 33]); o.z = pk2(s[4 * 33], s[5 * 33]); o.w = pk2(s[6 * 33], s[7 * 33]);
        const int ng = n0 + n, drow = sel < 0 ? row_off + ng : 32 * (ng >> 4) + 16 * sel + (ng & 15);
        *(v4u*)(WT + (size_t)drow * pitch + koff + k0 + 8 * c) = o; }
    LDS_WAIT(); asm volatile("" ::: "memory");
}

constexpr int I_ADA = (DM / 64) * (ADA_N / 32), I_IN = (DM / 64) * (IN_DIM / 32), I_O = (1024 / 64) * (DM / 32), I_CO = (512 / 64) * (DM / 32), I_G = I_CO,
              I_OUT = (DM / 64) * (DM / 32), I_F1 = (DM / 64) * (FF / 32), I_F2 = (FF / 64) * (DM / 32);
constexpr int I_LAYER = I_IN + I_O + I_CO + 2 * I_G + I_OUT + I_F1 + I_F2, I_L0_PRO = I_LAYER - 12800;
__device__ __forceinline__ void convert_layer_item(const Args& a, int l, int r, LAS float* scr, int lane) {
    bf16* wl = (bf16*)(a.ws + WS_WL + (size_t)l * WL_STRIDE);
    if (r < I_IN) { p0_transpose_item(a.in[I_WIN] + (size_t)l * DM * IN_DIM, DM, IN_DIM, wl + WL_IN / 2, DM, 0, 0, -1, scr, r, lane); return; } r -= I_IN;
    if (r < I_O) { p0_transpose_item(a.in[I_WO] + (size_t)l * 1024 * DM, 1024, DM, wl + WL_O / 2, 1536, 0, 0, -1, scr, r, lane); return; } r -= I_O;
    if (r < I_CO) { p0_transpose_item(a.in[I_WCO] + (size_t)l * 512 * DM, 512, DM, wl + WL_O / 2, 1536, 1024, 0, -1, scr, r, lane); return; } r -= I_CO;
    if (r < I_G) { p0_transpose_item(a.in[I_WGA] + (size_t)l * 512 * DM, 512, DM, wl + WL_GA / 2, 512, 0, 0, 0, scr, r, lane); return; } r -= I_G;
    if (r < I_G) { p0_transpose_item(a.in[I_WGB] + (size_t)l * 512 * DM, 512, DM, wl + WL_GA / 2, 512, 0, 0, 1, scr, r, lane); return; } r -= I_G;
    if (r < I_OUT) { p0_transpose_item(a.in[I_WOUT] + (size_t)l * DM * DM, DM, DM, wl + WL_OUT / 2, DM, 0, 0, -1, scr, r, lane); return; } r -= I_OUT;
    if (r < I_F1) { p0_transpose_item(a.in[I_WF1] + (size_t)l * DM * FF, DM, FF, wl + WL_F1 / 2, DM, 0, 0, -1, scr, r, lane); return; } r -= I_F1;
    p0_transpose_item(a.in[I_WF2] + (size_t)l * FF * DM, FF, DM, wl + WL_F2 / 2, FF, 0, 0, -1, scr, r, lane);
}
__device__ __forceinline__ void convert_idle(const Args& a, LAS unsigned char* lds, int l, int c0, int i0, int i1) {
    int tid_o = threadIdx.x; asm volatile("" : "+v"(tid_o)); const int lane = tid_o & 63, wave = __builtin_amdgcn_readfirstlane(tid_o >> 6);
    const int c = (int)blockIdx.x - c0; if (c < 0) return;
    LAS float* scr = (LAS float*)(lds + wave * 16384);
    const int nw = ((int)gridDim.x - c0) * 8;
    for (int it = i0 + c * 8 + wave; it < i1; it += nw) convert_layer_item(a, l, it, scr, lane);
}

__device__ __forceinline__ void p0_prologue(const Args& a, LAS unsigned char* lds, int gw, int NGW, int lane, int wave, int gtid, int NGT) {
    LAS float* scr = (LAS float*)(lds + wave * 16384);
    unsigned char* ws = a.ws;
    for (int it = gw; it < 2 * I_ADA + I_L0_PRO; it += NGW) {
        if (it < 2 * I_ADA) { const int l = it / I_ADA, r = it - l * I_ADA; p0_transpose_item(a.in[I_WADA] + (size_t)l * DM * ADA_N, DM, ADA_N, (bf16*)(ws + WS_WADA), DM, 0, l * ADA_N, -1, scr, r, lane); }
        else convert_layer_item(a, 0, it - 2 * I_ADA, scr, lane);
    }
    for (int it = gw; it < I_LAYER; it += NGW) convert_layer_item(a, 1, it, scr, lane);
    unsigned* AC = (unsigned*)(ws + WS_AC);
    for (int i = gtid; i < 256 * DM / 2; i += NGT) {
        const int row = i / (DM / 2), c2 = (i % (DM / 2)) * 2; unsigned w = 0u;
        if (row < NMODROW) { const float* src = row < 4 ? a.in[I_CP] + row * DM + c2 : a.in[I_CS] + (row - 4) * DM + c2; const float x = src[0], y = src[1]; w = pk2(x * sigm(x), y * sigm(y)); }
        AC[i] = w;
    }
    f32x2* RT = (f32x2*)(ws + WS_ROPE);
    for (int i = gtid; i < 2056 * 8; i += NGT) {
        const int pi = i >> 3, fi = i & 7; const double pos = pi < 2048 ? (double)pi : (double)(8192 + pi - 2048);
        const double invf = dexp_(-(double)fi * 0.125 * 13.122363377404328);
        double sn, cs; dsincos_(pos * invf, sn, cs); RT[i] = (f32x2){(float)cs, (float)sn};
    }
}

__device__ __forceinline__ void norm_mod_phase(const float* xp, const float* xs, const float* normw, const float* mod, int l, int second, bf16* H) {
    int tid_o = threadIdx.x; asm volatile("" : "+v"(tid_o)); const int tid = tid_o, lane = tid & 63, wave = __builtin_amdgcn_readfirstlane(tid >> 6); (void)lane; (void)wave;
    const int NGW = gridDim.x * 8, gw = blockIdx.x * 8 + wave;
    for (int row0 = gw; row0 < NTOK; row0 += 2 * NGW) {
        const int row1 = row0 + NGW; const bool has1 = row1 < NTOK; const int r1 = has1 ? row1 : row0;
        const float* xr0 = row0 < NPTOK ? xp + (size_t)row0 * DM : xs + (size_t)(row0 - NPTOK) * DM;
        const float* xr1 = r1 < NPTOK ? xp + (size_t)r1 * DM : xs + (size_t)(r1 - NPTOK) * DM;
        f32x4 v0[8], v1[8]; float s0 = 0.f, s1 = 0.f;
#pragma unroll
        for (int j = 0; j < 8; ++j) { v0[j] = *(const f32x4*)(xr0 + 4 * (lane + 64 * j)); v1[j] = *(const f32x4*)(xr1 + 4 * (lane + 64 * j)); }
#pragma unroll
        for (int j = 0; j < 8; ++j) { s0 += (v0[j][0] * v0[j][0] + v0[j][1] * v0[j][1]) + (v0[j][2] * v0[j][2] + v0[j][3] * v0[j][3]); s1 += (v1[j][0] * v1[j][0] + v1[j][1] * v1[j][1]) + (v1[j][2] * v1[j][2] + v1[j][3] * v1[j][3]); }
        s0 = wave_sum(s0); s1 = wave_sum(s1);
        const float rs0 = rsqrtf(s0 * (1.f / DM) + 1e-6f), rs1 = rsqrtf(s1 * (1.f / DM) + 1e-6f);
        const float* sh0 = mod + (size_t)pg8::mod_row(row0) * (2 * ADA_N) + l * ADA_N + (second ? 3 : 0) * DM; const float* sh1 = mod + (size_t)pg8::mod_row(r1) * (2 * ADA_N) + l * ADA_N + (second ? 3 : 0) * DM;
#pragma unroll
        for (int j = 0; j < 8; ++j) { const int c = 4 * (lane + 64 * j); const f32x4 nw = *(const f32x4*)(normw + c);
            { const f32x4 sc = *(const f32x4*)(sh0 + DM + c), sh = *(const f32x4*)(sh0 + c); const f32x4 y = (v0[j] * rs0) * nw * (sc + 1.f) + sh; v2u w; w.x = pk2(y[0], y[1]); w.y = pk2(y[2], y[3]); *(v2u*)(H + (size_t)row0 * DM + c) = w; }
            if (has1) { const f32x4 sc = *(const f32x4*)(sh1 + DM + c), sh = *(const f32x4*)(sh1 + c); const f32x4 y = (v1[j] * rs1) * nw * (sc + 1.f) + sh; v2u w; w.x = pk2(y[0], y[1]); w.y = pk2(y[2], y[3]); *(v2u*)(H + (size_t)row1 * DM + c) = w; } }
    }
}

__device__ __forceinline__ void unpack8(const v4u r, float (&x)[8]) { x[0] = lo16(r.x); x[1] = hi16(r.x); x[2] = lo16(r.y); x[3] = hi16(r.y); x[4] = lo16(r.z); x[5] = hi16(r.z); x[6] = lo16(r.w); x[7] = hi16(r.w); }
__device__ __forceinline__ v4u pack8f(const float (&x)[8]) { v4u w; w.x = pk2(x[0], x[1]); w.y = pk2(x[2], x[3]); w.z = pk2(x[4], x[5]); w.w = pk2(x[6], x[7]); return w; }
template <int NKT>
__device__ __forceinline__ void attn_qgroup(const LAS bf16* Ks, int kst, const LAS bf16* Vt, int vst, const bf16* qrow, const float* qg, const f32x2* rt, int qi, bool hasprev, float sink, bf16* orow, bool store_ok, int lane) {
    static_assert(NKT % 2 == 0, "key tiles come in pairs");
    const int lr = lane & 15, q4 = lane >> 4;
    bf16x8 qf0, qf1;
    { float x0[8], x1[8]; unpack8(*(const v4u*)(qrow + 8 * q4), x0); unpack8(*(const v4u*)(qrow + 32 + 8 * q4), x1);
      float ss = 0.f;
#pragma unroll
      for (int e = 0; e < 8; ++e) ss += x0[e] * x0[e] + x1[e] * x1[e];
      ss += __shfl_xor(ss, 16); ss += __shfl_xor(ss, 32);
      const float rstd = rsqrtf(ss * (1.f / 64.f) + 1e-6f);
#pragma unroll
      for (int e = 0; e < 8; ++e) { x0[e] = x0[e] * rstd * qg[8 * q4 + e]; x1[e] = x1[e] * rstd * qg[32 + 8 * q4 + e]; }
#pragma unroll
      for (int e = 0; e < 8; ++e) { const float other = __shfl_xor(x0[e], 16); const f32x2 cs = rt[e];
          if (q4 == 0) x0[e] = x0[e] * cs.x - other * cs.y; else if (q4 == 1) x0[e] = x0[e] * cs.x + other * cs.y; }
#pragma unroll
      for (int e = 0; e < 8; ++e) { x0[e] *= 0.125f; x1[e] *= 0.125f; }
      qf0 = __builtin_bit_cast(bf16x8, pack8f(x0)); qf1 = __builtin_bit_cast(bf16x8, pack8f(x1)); }
    f32x4 s[NKT];
#pragma unroll
    for (int kt = 0; kt < NKT; ++kt) {
        const LAS bf16* kp = Ks + (16 * kt + lr) * kst + 8 * q4;
        const bf16x8 k0 = *(const LAS bf16x8*)kp, k1 = *(const LAS bf16x8*)(kp + 32);
        f32x4 z = (f32x4){0.f, 0.f, 0.f, 0.f};
        z = __builtin_amdgcn_mfma_f32_16x16x32_bf16(k0, qf0, z, 0, 0, 0);
        z = __builtin_amdgcn_mfma_f32_16x16x32_bf16(k1, qf1, z, 0, 0, 0);
        s[kt] = z;
        if ((kt & 3) == 3) __builtin_amdgcn_sched_barrier(0);
    }
    float m = sink;
#pragma unroll
    for (int kt = 0; kt < NKT; ++kt)
#pragma unroll
        for (int i = 0; i < 4; ++i) { const int kj = 16 * kt + 4 * q4 + i; const bool ok = (kj > qi) && (kj <= qi + 128) && (hasprev || kj >= 128);
            const float v = ok ? s[kt][i] : -INFINITY; s[kt][i] = v; m = fmaxf(m, v); }
    m = fmaxf(m, __shfl_xor(m, 16)); m = fmaxf(m, __shfl_xor(m, 32));
    float sum = 0.f;
#pragma unroll
    for (int kt = 0; kt < NKT; ++kt)
#pragma unroll
        for (int i = 0; i < 4; ++i) { const float p = __expf(s[kt][i] - m); s[kt][i] = p; sum += p; }
    sum += __shfl_xor(sum, 16); sum += __shfl_xor(sum, 32);
    const float inv = 1.f / (sum + __expf(sink - m));
    f32x4 o[4];
#pragma unroll
    for (int dt = 0; dt < 4; ++dt) o[dt] = (f32x4){0.f, 0.f, 0.f, 0.f};
#pragma unroll
    for (int kp = 0; kp < NKT / 2; ++kp) {
        v4u pw; pw.x = pk2(s[2 * kp][0], s[2 * kp][1]); pw.y = pk2(s[2 * kp][2], s[2 * kp][3]); pw.z = pk2(s[2 * kp + 1][0], s[2 * kp + 1][1]); pw.w = pk2(s[2 * kp + 1][2], s[2 * kp + 1][3]);
        const bf16x8 pb = __builtin_bit_cast(bf16x8, pw);
#pragma unroll
        for (int dt = 0; dt < 4; ++dt) {
            const LAS bf16* vp = Vt + (16 * dt + lr) * vst + 32 * kp + 4 * q4;
            const v2u lo = *(const LAS v2u*)vp, hi = *(const LAS v2u*)(vp + 16);
            v4u vw; vw.x = lo.x; vw.y = lo.y; vw.z = hi.x; vw.w = hi.y;
            o[dt] = __builtin_amdgcn_mfma_f32_16x16x32_bf16(__builtin_bit_cast(bf16x8, vw), pb, o[dt], 0, 0, 0);
        }
    }
    if (store_ok) {
#pragma unroll
        for (int dt = 0; dt < 4; ++dt) { v2u w; w.x = pk2(o[dt][0] * inv, o[dt][1] * inv); w.y = pk2(o[dt][2] * inv, o[dt][3] * inv); *(v2u*)(orow + 16 * dt + 4 * q4) = w; }
    }
}

constexpr int AP_KST = 72, AP_VST = 264;
constexpr int AS_KST = 72, AS_VST = 168, AS_NK = 160;

__device__ __forceinline__ void knorm_rope8(float (&x)[8], int ch, const float* kg, const f32x2* rt) {
    float ss = 0.f;
#pragma unroll
    for (int e = 0; e < 8; ++e) ss += x[e] * x[e];
    ss += __shfl_xor(ss, 1); ss += __shfl_xor(ss, 2); ss += __shfl_xor(ss, 4);
    const float rstd = rsqrtf(ss * (1.f / 64.f) + 1e-6f);
#pragma unroll
    for (int e = 0; e < 8; ++e) x[e] = x[e] * rstd * kg[ch * 8 + e];
#pragma unroll
    for (int e = 0; e < 8; ++e) { const float other = __shfl_xor(x[e], 1); const f32x2 cs = rt[e];
        if (ch == 0) x[e] = x[e] * cs.x - other * cs.y; else if (ch == 1) x[e] = x[e] * cs.x + other * cs.y; }
}
__device__ __forceinline__ void attn_prompt_item(const Args& a, int l, int item, LAS unsigned char* lds) {
    int tid_o = threadIdx.x; asm volatile("" : "+v"(tid_o)); const int tid = tid_o, lane = tid & 63, wave = __builtin_amdgcn_readfirstlane(tid >> 6); (void)lane; (void)wave;
    unsigned char* ws = a.ws; asm volatile("" : "+s"(ws)); const bf16* P = (const bf16*)(ws + WS_P); bf16* O = (bf16*)(ws + WS_O); const f32x2* RT = (const f32x2*)(ws + WS_ROPE);
    const float* qg = a.in[I_QN] + l * 64; const float* kg = a.in[I_KN] + l * 64;
    const int kvh = item & 3, n = (item >> 2) & 15, b = item >> 6;
    LAS bf16* Ks = (LAS bf16*)lds; LAS bf16* Vt = (LAS bf16*)(lds + 256 * AP_KST * 2);
#pragma unroll
    for (int i = 0; i < 4; ++i) { const int c = tid + 512 * i, r = c >> 3, ch = c & 7, pos = 128 * (n - 1) + r, pc = pos >= 0 ? pos : 0;
        v4u val = (v4u){0u, 0u, 0u, 0u}; if (pos >= 0) val = *(const v4u*)(P + (size_t)(b * SEQ + pos) * IN_DIM + C_K + kvh * 64 + ch * 8);
        float x[8]; unpack8(val, x); knorm_rope8(x, ch, kg, RT + pc * 8);
        *(LAS v4u*)(Ks + r * AP_KST + ch * 8) = pack8f(x);
        if (n == 15 && r >= 128) { float* o = a.out + O_NKP + ((size_t)(l * NB + b) * 128 + (r - 128)) * 256 + kvh * 64 + ch * 8;
            *(f32x4*)o = (f32x4){x[0], x[1], x[2], x[3]}; *(f32x4*)(o + 4) = (f32x4){x[4], x[5], x[6], x[7]}; } }
#pragma unroll
    for (int i = 0; i < 4; ++i) { const int c = tid + 512 * i, key = c & 255, ch = c >> 8, pos = 128 * (n - 1) + key;
        v4u val = (v4u){0u, 0u, 0u, 0u}; if (pos >= 0) val = *(const v4u*)(P + (size_t)(b * SEQ + pos) * IN_DIM + C_V + kvh * 64 + ch * 8);
        LAS bf16* d = Vt + (ch * 8) * AP_VST + key;
        d[0 * AP_VST] = (bf16)(val.x & 0xffffu); d[1 * AP_VST] = (bf16)(val.x >> 16); d[2 * AP_VST] = (bf16)(val.y & 0xffffu); d[3 * AP_VST] = (bf16)(val.y >> 16);
        d[4 * AP_VST] = (bf16)(val.z & 0xffffu); d[5 * AP_VST] = (bf16)(val.z >> 16); d[6 * AP_VST] = (bf16)(val.w & 0xffffu); d[7 * AP_VST] = (bf16)(val.w >> 16);
        if (n == 15 && key >= 128) { float* o = a.out + O_NVP + ((size_t)(l * NB + b) * 128 + (key - 128)) * 256 + kvh * 64 + ch * 8;
            *(f32x4*)o = (f32x4){lo16(val.x), hi16(val.x), lo16(val.y), hi16(val.y)}; *(f32x4*)(o + 4) = (f32x4){lo16(val.z), hi16(val.z), lo16(val.w), hi16(val.w)}; } }
    __syncthreads();
    const int g = wave >> 1, half = wave & 1, head = kvh * 4 + g; const float sink = a.in[I_SINK][l * 16 + head];
#pragma nounroll
    for (int qg_i = 0; qg_i < 4; ++qg_i) {
        const int qi = 64 * half + 16 * qg_i + (lane & 15); const size_t tok = (size_t)b * SEQ + 128 * n + qi;
        attn_qgroup<16>(Ks, AP_KST, Vt, AP_VST, P + tok * IN_DIM + head * 64, qg, RT + (128 * n + qi) * 8, qi, n > 0, sink, O + tok * 1536 + head * 64, true, lane);
    }
    __syncthreads();
}

__device__ __forceinline__ void attn_sample_item(const Args& a, int l, int item, LAS unsigned char* lds) {
    int tid_o = threadIdx.x; asm volatile("" : "+v"(tid_o)); const int tid = tid_o, lane = tid & 63, wave = __builtin_amdgcn_readfirstlane(tid >> 6); (void)lane; (void)wave;
    unsigned char* ws = a.ws; asm volatile("" : "+s"(ws)); const bf16* P = (const bf16*)(ws + WS_P); bf16* O = (bf16*)(ws + WS_O); const f32x2* RT = (const f32x2*)(ws + WS_ROPE);
    const float* qg = a.in[I_QN] + l * 64; const float* kg = a.in[I_KN] + l * 64;
    const int pair = item & 1, b = item >> 1;
    LAS bf16* Ks = (LAS bf16*)lds; LAS bf16* Vt = (LAS bf16*)(lds + 2 * AS_NK * AS_KST * 2);
    const float* ck = a.in[I_CK] + (size_t)(l * DECB + b) * 128 * 256; const float* cv = a.in[I_CV] + (size_t)(l * DECB + b) * 128 * 256;
    float* onk = a.out + O_NKS + (size_t)(l * DECB + b) * 128 * 256; float* onv = a.out + O_NVS + (size_t)(l * DECB + b) * 128 * 256;
#pragma unroll
    for (int i = 0; i < 8; ++i) { const int c = tid + 512 * i, kk = c >> 11, rem = c & 2047, r = rem >> 4, ch4 = rem & 15;
        const f32x4 v = *(const f32x4*)(ck + (size_t)r * 256 + (2 * pair + kk) * 64 + ch4 * 4); v2u w; w.x = pk2(v[0], v[1]); w.y = pk2(v[2], v[3]);
        *(LAS v2u*)(Ks + (kk * AS_NK + r) * AS_KST + ch4 * 4) = w;
        if (r >= 8) *(f32x4*)(onk + (size_t)(r - 8) * 256 + (2 * pair + kk) * 64 + ch4 * 4) = v; }
    { const int kk = tid >> 8, rem = tid & 255, r = 128 + (rem >> 3), ch = rem & 7, t = r < 136 ? r - 128 : 0;
      v4u val = (v4u){0u, 0u, 0u, 0u}; if (r < 136) val = *(const v4u*)(P + (size_t)(NPTOK + b * DECT + t) * IN_DIM + C_K + (2 * pair + kk) * 64 + ch * 8);
      float x[8]; unpack8(val, x); knorm_rope8(x, ch, kg, RT + (2048 + t) * 8);
      *(LAS v4u*)(Ks + (kk * AS_NK + r) * AS_KST + ch * 8) = pack8f(x);
      if (r < 136) { float* o = onk + (size_t)(120 + t) * 256 + (2 * pair + kk) * 64 + ch * 8; *(f32x4*)o = (f32x4){x[0], x[1], x[2], x[3]}; *(f32x4*)(o + 4) = (f32x4){x[4], x[5], x[6], x[7]}; } }
#pragma unroll
    for (int i = 0; i < 8; ++i) { const int c = tid + 512 * i, key = c & 127, kk = (c >> 7) & 1, ch4 = c >> 8;
        const f32x4 v = *(const f32x4*)(cv + (size_t)key * 256 + (2 * pair + kk) * 64 + ch4 * 4);
        LAS bf16* d = Vt + (kk * 64 + ch4 * 4) * AS_VST + key;
        d[0] = (bf16)f2bf(v[0]); d[AS_VST] = (bf16)f2bf(v[1]); d[2 * AS_VST] = (bf16)f2bf(v[2]); d[3 * AS_VST] = (bf16)f2bf(v[3]);
        if (key >= 8) *(f32x4*)(onv + (size_t)(key - 8) * 256 + (2 * pair + kk) * 64 + ch4 * 4) = v; }
#pragma unroll
    for (int i = 0; i < 8; ++i) { const int c = tid + 512 * i, col = 128 + (c & 31), d = (c >> 5) & 63, kk = c >> 11; bf16 val = 0;
        if (col < 136) { val = P[(size_t)(NPTOK + b * DECT + (col - 128)) * IN_DIM + C_V + (2 * pair + kk) * 64 + d]; onv[(size_t)(120 + col - 128) * 256 + (2 * pair + kk) * 64 + d] = bf2f(val); }
        Vt[(kk * 64 + d) * AS_VST + col] = val; }
    __syncthreads();
    const int kk = wave >> 2, g = wave & 3, kvh = 2 * pair + kk, head = kvh * 4 + g; const float sink = a.in[I_SINK][l * 16 + head];
    const int qi = lane & 15, qld = qi < 8 ? qi : 7; const size_t tok = (size_t)NPTOK + b * DECT + qld;
    attn_qgroup<10>(Ks + kk * AS_NK * AS_KST, AS_KST, Vt + kk * 64 * AS_VST, AS_VST, P + tok * IN_DIM + head * 64, qg, RT + (2048 + qld) * 8, qi, true, sink, O + tok * 1536 + head * 64, qi < 8, lane);
    __syncthreads();
}

template <int TT>
__device__ __forceinline__ void conv_compute(const Args& a, int l, LAS float* U, LAS float* red, LAS float* stat, size_t tok0, int tid, int wave, int lane) {
    const int c = tid;
    float w[31];
#pragma unroll
    for (int j = 0; j < 31; ++j) w[j] = a.in[I_CW][(size_t)(l * 31 + j) * 512 + c];
    const float bias = a.in[I_CB][l * 512 + c];
    float y[TT];
#pragma unroll
    for (int tb = 0; tb < TT / 8; ++tb) {
        float win[38];
#pragma unroll
        for (int r = 0; r < 38; ++r) win[r] = U[(tb * 8 + r) * 512 + c];
#pragma unroll
        for (int t = 0; t < 8; ++t) { float acc = bias;
#pragma unroll
            for (int j = 0; j < 31; ++j) acc = fmaf(w[j], win[t + j], acc);
            y[tb * 8 + t] = acc; }
    }
#pragma unroll
    for (int t = 0; t < TT; ++t) { const float s1 = wave_sum(y[t]), s2 = wave_sum(y[t] * y[t]); if (lane == 0) { red[(wave * 32 + t) * 2] = s1; red[(wave * 32 + t) * 2 + 1] = s2; } }
    __syncthreads();
    if (tid < TT * 2) { const int t = tid >> 1, k = tid & 1; float s = 0.f;
#pragma unroll
        for (int ww = 0; ww < 8; ++ww) s += red[(ww * 32 + t) * 2 + k];
        stat[t * 2 + k] = s; }
    __syncthreads();
    const float lg = a.in[I_CLG][l * 512 + c], lb = a.in[I_CLB][l * 512 + c];
    bf16* YC = (bf16*)(a.ws + WS_O) + 1024;
#pragma unroll
    for (int t = 0; t < TT; ++t) { const float mean = stat[t * 2] * (1.f / 512.f), var = stat[t * 2 + 1] * (1.f / 512.f) - mean * mean, rstd = rsqrtf(fmaxf(var, 0.f) + 1e-6f);
        const float v = (y[t] - mean) * rstd * lg + lb; YC[(tok0 + t) * 1536 + c] = (bf16)f2bf(v * sigm(v)); }
}
__device__ __forceinline__ void glu8(const bf16* P, size_t tok, int ch, float (&u)[8]) {
    const v4u av = *(const v4u*)(P + tok * IN_DIM + C_XA + ch * 8), bv = *(const v4u*)(P + tok * IN_DIM + C_XB + ch * 8);
    u[0] = lo16(av.x) * sigm(lo16(bv.x)); u[1] = hi16(av.x) * sigm(hi16(bv.x)); u[2] = lo16(av.y) * sigm(lo16(bv.y)); u[3] = hi16(av.y) * sigm(hi16(bv.y));
    u[4] = lo16(av.z) * sigm(lo16(bv.z)); u[5] = hi16(av.z) * sigm(hi16(bv.z)); u[6] = lo16(av.w) * sigm(lo16(bv.w)); u[7] = hi16(av.w) * sigm(hi16(bv.w));
}
__device__ __forceinline__ void conv_prompt_item(const Args& a, int l, int item, LAS unsigned char* lds) {
    int tid_o = threadIdx.x; asm volatile("" : "+v"(tid_o)); const int tid = tid_o, lane = tid & 63, wave = __builtin_amdgcn_readfirstlane(tid >> 6); (void)lane; (void)wave;
    const bf16* P = (const bf16*)(a.ws + WS_P);
    LAS float* U = (LAS float*)lds; LAS float* red = U + 62 * 512; LAS float* stat = red + 512;
    const int b = item >> 6, tile = item & 63, t0 = tile * 32;
#pragma unroll 4
    for (int c = tid; c < 62 * 64; c += 512) { const int r = c >> 6, ch = c & 63, t = t0 - 30 + r; float u[8];
        if (t >= 0) glu8(P, (size_t)b * SEQ + t, ch, u); else {
#pragma unroll
            for (int e = 0; e < 8; ++e) u[e] = 0.f; }
        *(LAS f32x4*)(U + r * 512 + ch * 8) = (f32x4){u[0], u[1], u[2], u[3]}; *(LAS f32x4*)(U + r * 512 + ch * 8 + 4) = (f32x4){u[4], u[5], u[6], u[7]};
        if (tile == 63 && t >= SEQ - 30) { float* o = a.out + O_NCP + ((size_t)(l * NB + b) * 30 + (t - (SEQ - 30))) * 512 + ch * 8;
            *(f32x4*)o = (f32x4){u[0], u[1], u[2], u[3]}; *(f32x4*)(o + 4) = (f32x4){u[4], u[5], u[6], u[7]}; } }
    __syncthreads();
    conv_compute<32>(a, l, U, red, stat, (size_t)b * SEQ + t0, tid, wave, lane);
    __syncthreads();
}
__device__ __forceinline__ void conv_sample_item(const Args& a, int l, int item, LAS unsigned char* lds) {
    int tid_o = threadIdx.x; asm volatile("" : "+v"(tid_o)); const int tid = tid_o, lane = tid & 63, wave = __builtin_amdgcn_readfirstlane(tid >> 6); (void)lane; (void)wave;
    const bf16* P = (const bf16*)(a.ws + WS_P);
    LAS float* U = (LAS float*)lds; LAS float* red = U + 62 * 512; LAS float* stat = red + 512;
    const int b = item; const float* sc = a.in[I_SCONV] + (size_t)(l * DECB + b) * 30 * 512;
#pragma unroll 5
    for (int c = tid; c < 38 * 64; c += 512) { const int r = c >> 6, ch = c & 63; float u[8];
        if (r < 30) { const f32x4 x0 = *(const f32x4*)(sc + r * 512 + ch * 8), x1 = *(const f32x4*)(sc + r * 512 + ch * 8 + 4);
            u[0] = x0[0]; u[1] = x0[1]; u[2] = x0[2]; u[3] = x0[3]; u[4] = x1[0]; u[5] = x1[1]; u[6] = x1[2]; u[7] = x1[3]; }
        else glu8(P, (size_t)NPTOK + b * DECT + (r - 30), ch, u);
        *(LAS f32x4*)(U + r * 512 + ch * 8) = (f32x4){u[0], u[1], u[2], u[3]}; *(LAS f32x4*)(U + r * 512 + ch * 8 + 4) = (f32x4){u[4], u[5], u[6], u[7]};
        if (r >= 8) { float* o = a.out + O_NCS + ((size_t)(l * DECB + b) * 30 + (r - 8)) * 512 + ch * 8;
            *(f32x4*)o = (f32x4){u[0], u[1], u[2], u[3]}; *(f32x4*)(o + 4) = (f32x4){u[4], u[5], u[6], u[7]}; } }
    __syncthreads();
    conv_compute<8>(a, l, U, red, stat, (size_t)NPTOK + b * DECT, tid, wave, lane);
    __syncthreads();
}

struct SsmLane { float ar, ai; f32x2 bz[16]; bf16x8 cf[4]; f32x4 dv; float a256r, a256i; };
__device__ __forceinline__ void ssm_setup(const Args& a, int l, int g, int lane, SsmLane& S) {
    const int p = lane, lg = l * 32 + g;
    const double are = (double)a.in[I_ARE][lg * 64 + p], aim = (double)a.in[I_AIM][lg * 64 + p], dt = dexp_((double)a.in[I_LDT][lg]);
    const double mag = dexp_(are * dt); double sn, cs; dsincos_(aim * dt, sn, cs);
    const double abr = mag * cs, abi = mag * sn, den = are * are + aim * aim;
    const double zr = ((abr - 1.0) * are + abi * aim) / den, zi = (abi * are - (abr - 1.0) * aim) / den;
    S.ar = (float)abr; S.ai = (float)abi;
    double pr = abr, pi = abi;
#pragma unroll
    for (int i = 0; i < 8; ++i) { const double nr = pr * pr - pi * pi, ni = 2.0 * pr * pi; pr = nr; pi = ni; }
    S.a256r = (float)pr; S.a256i = (float)pi;
    const float* br = a.in[I_BRE] + (size_t)(lg * 64 + p) * 16; const float* bi = a.in[I_BIM] + (size_t)(lg * 64 + p) * 16;
    const float zrf = (float)zr, zif = (float)zi;
#pragma unroll
    for (int c = 0; c < 16; ++c) { const float x = br[c], y = bi[c]; S.bz[c] = (f32x2){zrf * x - zif * y, zrf * y + zif * x}; }
    const int lr = lane & 15, q4 = lane >> 4;
#pragma unroll
    for (int ks = 0; ks < 4; ++ks) { const int k0 = (ks & 1) * 32 + 8 * q4; const float* src = (ks < 2 ? a.in[I_CRE] : a.in[I_CIM]) + (size_t)(lg * 16 + lr) * 64 + k0; const float sg = ks < 2 ? 1.f : -1.f;
        const f32x4 x0 = *(const f32x4*)src, x1 = *(const f32x4*)(src + 4);
        v4u w; w.x = pk2(sg * x0[0], sg * x0[1]); w.y = pk2(sg * x0[2], sg * x0[3]); w.z = pk2(sg * x1[0], sg * x1[1]); w.w = pk2(sg * x1[2], sg * x1[3]);
        S.cf[ks] = __builtin_bit_cast(bf16x8, w); }
    S.dv = *(const f32x4*)(a.in[I_SD] + l * 512 + g * 16 + 4 * q4);
}
__device__ __forceinline__ float gelu_tanh(float x) { const float z = 0.7978845608028654f * (x + 0.044715f * x * x * x); const float t = 1.f - 2.f * __builtin_amdgcn_rcpf(__expf(2.f * z) + 1.f); return 0.5f * x * (1.f + t); }

template <bool PASS2>
__device__ __forceinline__ void ssm_run(const Args& a, const SsmLane& S, int g, size_t tok0, int nsub, int nvalid, float& hr, float& hi, LAS float* ubuf, LAS bf16* hbuf, int lane) {
    const bf16* P = (const bf16*)(a.ws + WS_P); bf16* YS = (bf16*)(a.ws + WS_YS);
    const int lr = lane & 15, q4 = lane >> 4, st_l = lane >> 2, c4 = (lane & 3) * 4;
    v2u wnext = (v2u){0u, 0u};
    if (st_l < nvalid) wnext = *(const v2u*)(P + (tok0 + st_l) * IN_DIM + C_XS + g * 16 + c4);
#pragma nounroll
    for (int sub = 0; sub < nsub; ++sub) {
        *(LAS f32x4*)(ubuf + st_l * 16 + c4) = (f32x4){lo16(wnext.x), hi16(wnext.x), lo16(wnext.y), hi16(wnext.y)};
        if (sub + 1 < nsub) wnext = *(const v2u*)(P + (tok0 + (sub + 1) * 16 + st_l) * IN_DIM + C_XS + g * 16 + c4);
        WAVE_SYNC();
        f32x4 un[4];
#pragma unroll
        for (int q = 0; q < 4; ++q) un[q] = *(const LAS f32x4*)(ubuf + q * 4);
#pragma unroll
        for (int st = 0; st < 16; ++st) {
            f32x4 uc[4];
#pragma unroll
            for (int q = 0; q < 4; ++q) uc[q] = un[q];
            if (st < 15) {
#pragma unroll
                for (int q = 0; q < 4; ++q) un[q] = *(const LAS f32x4*)(ubuf + (st + 1) * 16 + q * 4);
            }
            if (st < nvalid) {
                f32x2 x2 = (f32x2){0.f, 0.f};
#pragma unroll
                for (int q = 0; q < 4; ++q)
#pragma unroll
                    for (int c = 0; c < 4; ++c) x2 = S.bz[4 * q + c] * (f32x2){uc[q][c], uc[q][c]} + x2;
                const f32x2 t2 = (f32x2){S.ar, S.ar} * (f32x2){hr, hi} + x2;
                const f32x2 n2 = (f32x2){-S.ai, S.ai} * (f32x2){hi, hr} + t2;
                hr = n2.x; hi = n2.y;
            }
            if (PASS2) { const unsigned hw = pk2(hr, hi); hbuf[st * 136 + lane] = (bf16)(hw & 0xffffu); hbuf[st * 136 + 64 + lane] = (bf16)(hw >> 16); }
            __builtin_amdgcn_sched_barrier(0);
        }
        if (PASS2) {
            WAVE_SYNC();
            f32x4 acc = (f32x4){0.f, 0.f, 0.f, 0.f};
#pragma unroll
            for (int ks = 0; ks < 4; ++ks) { const bf16x8 hb = *(const LAS bf16x8*)(hbuf + lr * 136 + 32 * ks + 8 * q4); acc = __builtin_amdgcn_mfma_f32_16x16x32_bf16(S.cf[ks], hb, acc, 0, 0, 0); }
            const f32x4 uv = *(const LAS f32x4*)(ubuf + lr * 16 + 4 * q4);
            if (lr < nvalid) { f32x4 yv = acc + S.dv * uv; v2u w; w.x = pk2(gelu_tanh(yv[0]), gelu_tanh(yv[1])); w.y = pk2(gelu_tanh(yv[2]), gelu_tanh(yv[3]));
                *(v2u*)(YS + (tok0 + sub * 16 + lr) * 512 + g * 16 + 4 * q4) = w; }
        }
        WAVE_SYNC();
    }
}
__device__ __forceinline__ void ssm_prompt_item(const Args& a, int l, int item, LAS unsigned char* lds) {
    int tid_o = threadIdx.x; asm volatile("" : "+v"(tid_o)); const int tid = tid_o, lane = tid & 63, wave = __builtin_amdgcn_readfirstlane(tid >> 6); (void)lane; (void)wave;
    const int g = item & 31, b = item >> 5;
    LAS float* ubuf = (LAS float*)(lds + wave * 5632); LAS bf16* hbuf = (LAS bf16*)(lds + wave * 5632 + 1024); LAS float* ex = (LAS float*)(lds + 8 * 5632);
    SsmLane S; ssm_setup(a, l, g, lane, S);
    const size_t tok0 = (size_t)b * SEQ + 256 * wave;
    float hr = 0.f, hi = 0.f;
    ssm_run<false>(a, S, g, tok0, 16, 16, hr, hi, ubuf, hbuf, lane);
    ex[(wave * 64 + lane) * 2] = hr; ex[(wave * 64 + lane) * 2 + 1] = hi;
    __syncthreads();
    hr = 0.f; hi = 0.f;
    for (int j = 0; j < wave; ++j) { const float er = ex[(j * 64 + lane) * 2], ei = ex[(j * 64 + lane) * 2 + 1]; const float nr = S.a256r * hr - S.a256i * hi + er, ni = S.a256r * hi + S.a256i * hr + ei; hr = nr; hi = ni; }
    ssm_run<true>(a, S, g, tok0, 16, 16, hr, hi, ubuf, hbuf, lane);
    if (wave == 7) { a.out[O_NRP + (size_t)((l * NB + b) * 32 + g) * 64 + lane] = hr; a.out[O_NIP + (size_t)((l * NB + b) * 32 + g) * 64 + lane] = hi; }
    __syncthreads();
}
__device__ __forceinline__ void ssm_sample_item(const Args& a, int l, int item, LAS unsigned char* lds) {
    int tid_o = threadIdx.x; asm volatile("" : "+v"(tid_o)); const int tid = tid_o, lane = tid & 63, wave = __builtin_amdgcn_readfirstlane(tid >> 6); (void)lane; (void)wave;
    const int g = item & 31, bg = item >> 5;
    LAS float* ubuf = (LAS float*)(lds + wave * 5632); LAS bf16* hbuf = (LAS bf16*)(lds + wave * 5632 + 1024);
    SsmLane S; ssm_setup(a, l, g, lane, S);
    for (int bb = 0; bb < 2; ++bb) {
        const int bs = bg * 16 + wave * 2 + bb; const size_t so = (size_t)((l * DECB + bs) * 32 + g) * 64 + lane;
        float hr = a.in[I_SRE][so], hi = a.in[I_SIM][so];
        ssm_run<true>(a, S, g, (size_t)NPTOK + bs * DECT, 1, 8, hr, hi, ubuf, hbuf, lane);
        a.out[O_NRS + so] = hr; a.out[O_NIS + so] = hi;
    }
    __syncthreads();
}

__device__ __forceinline__ void mixer_phase(const Args& a, int l, LAS unsigned char* lds) {
    unsigned* qctr = (unsigned*)(a.ws + WS_CTL + 640 * 1024) + l * 64;
    volatile LAS unsigned* qslot = (volatile LAS unsigned*)(lds + 131072 + 128);
    for (;;) {
        if (threadIdx.x == 0) *qslot = __hip_atomic_fetch_add(qctr, 1u, __ATOMIC_RELAXED, __HIP_MEMORY_SCOPE_AGENT);
        __syncthreads();
        const int it = (int)*qslot;
        __syncthreads();
        if (it >= 1280) break;
        if (0) {}
#ifndef NO_SSMP
        else if (it < 128) ssm_prompt_item(a, l, it, lds);
#endif
#ifndef NO_ATTP
        else if (it < 384) attn_prompt_item(a, l, it - 128, lds);
#endif
#ifndef NO_CONVP
        else if (it < 640) conv_prompt_item(a, l, it - 384, lds);
#endif
#ifndef NO_ATTS
        else if (it < 896) attn_sample_item(a, l, it - 640, lds);
#endif
#ifndef NO_SSMS
        else if (it < 1152) ssm_sample_item(a, l, it - 896, lds);
#endif
#ifndef NO_CONVS
        else if (it < 1280) conv_sample_item(a, l, it - 1152, lds);
#endif
    }
}

#define XB_TMO      128
#define XB_XCNT(j)  (256  + 64 * (j))
#define XB_XSUB(j)  (1280 + 64 * (j))
#define XB_XGEN(j)  (2304 + 64 * (j))
#define XB_TOP      3328
#define XB_TOPGEN   3392
#define XCD_BAR_WORDS 3456
#define XB_SPIN_CAP (1u << 18)

__device__ __forceinline__ unsigned xb_ld(unsigned* p)              { return __hip_atomic_load(p, __ATOMIC_RELAXED, __HIP_MEMORY_SCOPE_AGENT); }
__device__ __forceinline__ unsigned xb_add(unsigned* p, unsigned v) { return __hip_atomic_fetch_add(p, v, __ATOMIC_RELAXED, __HIP_MEMORY_SCOPE_AGENT); }
__device__ __forceinline__ unsigned xb_xcc_id() { return (unsigned)__builtin_amdgcn_s_getreg((3 << 11) | 20) & 0xFu; }
#define XB_SPIN(cond, bar) do { unsigned _sp = 0; while (cond) { __builtin_amdgcn_s_sleep(1); \
    if ((++_sp & 255u) == 0u) { if (xb_ld(&(bar)[XB_TMO])) break; if (_sp > XB_SPIN_CAP) { atomicAdd(&(bar)[XB_TMO], 1u); break; } } } } while (0)

struct XcdBarrier {
    unsigned* bar; unsigned x;
    volatile LAS unsigned* st;
};

__device__ __forceinline__ XcdBarrier xcd_barrier_post(unsigned* bar, volatile LAS unsigned* st) {
    XcdBarrier b; b.bar = bar; b.x = xb_xcc_id(); b.st = st;
    if (threadIdx.x == 0) (void)xb_add(&bar[XB_XCNT(b.x)], 1u);
    return b;
}
__device__ __forceinline__ void xcd_barrier_complete(unsigned* bar, unsigned x, unsigned& nloc, unsigned& nx) {
    const unsigned G = gridDim.x * gridDim.y * gridDim.z;
    unsigned sum, cnt, mine, sp = 0u;
    for (;;) {
        sum = 0u; cnt = 0u; mine = 0u;
#pragma unroll
        for (unsigned j = 0; j < 16; ++j) { const unsigned c = xb_ld(&bar[XB_XCNT(j)]); sum += c; cnt += (c > 0u) ? 1u : 0u; mine = (j == x) ? c : mine; }
        if (sum == G) break;
        __builtin_amdgcn_s_sleep(1);
        if ((++sp & 255u) == 0u) { if (xb_ld(&bar[XB_TMO])) break; if (sp > XB_SPIN_CAP) { atomicAdd(&bar[XB_TMO], 1u); break; } }
    }
    nloc = mine > 0u ? mine : 1u; nx = cnt > 0u ? cnt : 1u;
}

__device__ __forceinline__ void xcd_barrier(const XcdBarrier& b) {
    asm volatile("s_waitcnt vmcnt(0)" ::: "memory");
    __syncthreads();
    if (threadIdx.x == 0) {
        unsigned* bar = b.bar;
        __builtin_amdgcn_s_waitcnt(0);
        unsigned nloc = b.st[0], nx = b.st[1];
        if (nloc == 0u) { xcd_barrier_complete(bar, b.x, nloc, nx); b.st[0] = nloc; b.st[1] = nx; }
        const unsigned old = xb_add(&bar[XB_XSUB(b.x)], 1u);
        const unsigned gen = old / nloc;
        if (old + 1u == (gen + 1u) * nloc) {
            __builtin_amdgcn_fence(__ATOMIC_RELEASE, "agent");
            asm volatile("s_waitcnt vmcnt(0)" ::: "memory");
            const unsigned og = xb_add(&bar[XB_TOP], 1u);
            const unsigned tg = og / nx;
            if (og + 1u == (tg + 1u) * nx) xb_add(&bar[XB_TOPGEN], 1u);
            else XB_SPIN(xb_ld(&bar[XB_TOPGEN]) == tg, bar);
            __builtin_amdgcn_fence(__ATOMIC_ACQUIRE, "agent");
            xb_add(&bar[XB_XGEN(b.x)], 1u);
            asm volatile("s_waitcnt vmcnt(0)" ::: "memory");
        } else {
            XB_SPIN(xb_ld(&bar[XB_XGEN(b.x)]) == gen, bar);
            __builtin_amdgcn_fence(__ATOMIC_ACQUIRE, "agent");
            asm volatile("s_waitcnt vmcnt(0)" ::: "memory");
        }
    }
    __syncthreads();
}

constexpr size_t WS_BAR = 768 * 1024;
constexpr int LDS_ST_OFF = 131072 + 64;

#define IN(k) (lo <= (k) && (k) < hi)
#ifdef PROBE_SEL
#define SEAM(k) do { if (IN(k) && IN((k) + 1)) { xcd_barrier(xbar); } if (blockIdx.x == 0 && threadIdx.x == 0) ((unsigned long long*)(a.ws + WS_CTL + 512 * 1024))[(k) + 1] = __builtin_amdgcn_s_memrealtime(); } while (0)
#else
#define SEAM(k) do { if (IN(k) && IN((k) + 1)) { xcd_barrier(xbar); } } while (0)
#endif
#define GEMM(EPI, E, Aptr, Bptr, M_, N_, K_, S_, SLOTS_, CID_) GEMMS(EPI, E, Aptr, Bptr, M_, N_, K_, S_, SLOTS_, CID_, 0)
#define GEMMS(EPI, E, Aptr, Bptr, M_, N_, K_, S_, SLOTS_, CID_, SEGK_) do { pg8::Gemm g_{(const pg8::bf16_t*)(Aptr), (const pg8::bf16_t*)(Bptr), M_, N_, K_}; pg8::HybridOrder S_o; \
        S_o.init(M_, N_, K_, G, (int)blockIdx.x, S_, (float*)(SLOTS_), (unsigned*)(ws + WS_CTL) + (CID_) * 2048); \
        S_o.segk = SEGK_; pg8::gemm_phase<EPI, pg8::HybridOrder, true, true>(lds, g_, S_o, E); } while (0)
template <int l>
__device__ __forceinline__ void layer_phases(const Args& a, LAS unsigned char* lds, cg::grid_group& grid, const XcdBarrier& xbar, int lo, int hi) {
    const int G = gridDim.x; float* Y = a.out + O_Y;
        const int pb = 2 + 9 * l;
        int tid_l = threadIdx.x; asm volatile("" : "+v"(tid_l));
        unsigned char* ws = a.ws; asm volatile("" : "+s"(ws));
        const int tid = tid_l, lane = tid & 63, wave = __builtin_amdgcn_readfirstlane(tid >> 6), gw = blockIdx.x * 8 + wave, gtid = blockIdx.x * 512 + tid;
        float* mod = (float*)(ws + WS_MOD); bf16* Hb = (bf16*)(ws + WS_H); bf16* Pb = (bf16*)(ws + WS_P); float* MG = (float*)(ws + WS_MG); float* Xb = (float*)(ws + WS_X);
        const unsigned char* wl = ws + WS_WL + (size_t)l * WL_STRIDE;
        const float* xp = l == 0 ? a.in[I_XP] : Xb; const float* xs = l == 0 ? a.in[I_XS] : Xb + (size_t)NPTOK * DM;
        float* xout = l == 0 ? Xb : Y;
#ifndef NO_NORM
        if (IN(pb + 0)) norm_mod_phase(xp, xs, a.in[I_NORM1] + l * DM, mod, l, 0, Hb);
#endif
        SEAM(pb + 0);
#ifndef NO_G1
        if (IN(pb + 1)) { pg8::EpiP E{Pb}; GEMM(pg8::EpiP, E, Hb, wl + WL_IN, NTOK, IN_DIM, DM, SK_G1, ws + WS_WADA, 1 + 8 * l); }
#endif
        SEAM(pb + 1);
#ifndef NO_MIX
        if (IN(pb + 3)) mixer_phase(a, l, lds);
#endif
        SEAM(pb + 3);
#ifndef NO_MERGE
        if (IN(pb + 4)) {
            { pg8::EpiGlu E{(pg8::bf16_t*)MG, Pb}; GEMM(pg8::EpiGlu, E, ws + WS_YS, wl + WL_GA, NTOK, 2 * DM, 512, 1, ws + WS_WADA, 2 + 8 * l); }
            { pg8::EpiMergeMain E{(const pg8::bf16_t*)MG, Pb, Hb}; GEMMS(pg8::EpiMergeMain, E, ws + WS_O, wl + WL_O, NTOK, DM, 1536, 1, ws + WS_WADA, 3 + 8 * l, 16); }
        }
#endif
        SEAM(pb + 4);
#ifndef NO_REST
        if (IN(pb + 5)) { pg8::EpiResid E{xp, xs, mod + l * ADA_N + 2 * DM, Y}; GEMM(pg8::EpiResid, E, Hb, wl + WL_OUT, NTOK, DM, DM, SK_WO, ws + WS_WADA, 6 + 8 * l); }
        SEAM(pb + 5);
        if (IN(pb + 6)) norm_mod_phase(Y, Y + (size_t)NPTOK * DM, a.in[I_NORM2] + l * DM, mod, l, 1, Hb);
        SEAM(pb + 6);
        if (IN(pb + 7)) { pg8::EpiRelu2 E{Pb}; GEMM(pg8::EpiRelu2, E, Hb, wl + WL_F1, NTOK, FF, DM, SK_F1, ws + WS_WADA, 7 + 8 * l); }
        SEAM(pb + 7);
        if (IN(pb + 8)) { pg8::EpiResid E{Y, Y + (size_t)NPTOK * DM, mod + l * ADA_N + 5 * DM, xout}; GEMM(pg8::EpiResid, E, Pb, wl + WL_F2, NTOK, DM, FF, SK_F2, ws + WS_WADA, 8 + 8 * l); }
#endif
        SEAM(pb + 8);
}

__global__ void __launch_bounds__(512, 2) hybrid_fwd(Args a) {
    extern __shared__ __attribute__((aligned(16))) unsigned char lds_raw[];
    LAS unsigned char* lds = (LAS unsigned char*)lds_raw;
    cg::grid_group grid = cg::this_grid();
    const int tid = threadIdx.x, lane = tid & 63, wave = __builtin_amdgcn_readfirstlane(tid >> 6);
    const int G = gridDim.x, gw = blockIdx.x * 8 + wave, NGW = G * 8, gtid = blockIdx.x * 512 + tid, NGT = G * 512;
    unsigned char* ws = a.ws;
    const int lo = a.ph_lo, hi = a.ph_hi;
    if (threadIdx.x < 4) ((LAS unsigned*)(lds + LDS_ST_OFF))[threadIdx.x] = 0u;
    __syncthreads();
    if (a.ph_lo < 0) grid.sync();
    const XcdBarrier xbar = xcd_barrier_post((unsigned*)(a.ws + WS_CTL + WS_BAR), (volatile LAS unsigned*)(lds + LDS_ST_OFF));
    float* mod = (float*)(ws + WS_MOD);
    bf16* Hb = (bf16*)(ws + WS_H); bf16* Pb = (bf16*)(ws + WS_P); float* MG = (float*)(ws + WS_MG); float* Xb = (float*)(ws + WS_X);
    float* Y = a.out + O_Y;
#ifdef PROBE_SEL
    if (blockIdx.x == 0 && threadIdx.x == 0) ((unsigned long long*)(a.ws + WS_CTL + 512 * 1024))[0] = __builtin_amdgcn_s_memrealtime();
#endif
#ifndef NO_P0
    if (IN(0)) { p0_prologue(a, lds, gw, NGW, lane, wave, gtid, NGT); __syncthreads(); }
#endif
    SEAM(0);
#ifndef NO_ADA
    if (IN(1)) { pg8::EpiAda E{mod, a.in[I_BADA]}; GEMM(pg8::EpiAda, E, ws + WS_AC, ws + WS_WADA, 256, 2 * ADA_N, DM, 1, ws + WS_X, 0); convert_idle(a, lds, 0, 96, I_L0_PRO, I_LAYER); }
#endif
    SEAM(1);
    layer_phases<0>(a, lds, grid, xbar, lo, hi);
    layer_phases<1>(a, lds, grid, xbar, lo, hi);
#ifdef PROBE_SEL
    grid.sync();
    if (blockIdx.x == 0 && threadIdx.x == 0) { const unsigned long long* ts = (const unsigned long long*)(a.ws + WS_CTL + 512 * 1024);
        const float us = (float)(ts[PROBE_SEL + 1] - ts[PROBE_SEL]) * 0.01f;
#if PROBE_SEL < 50
        atomicAdd(a.out + O_NIS + 5, us * 0.01f);
#endif
    }
#if PROBE_SEL >= 50
    { const unsigned long long t0 = __builtin_amdgcn_s_memrealtime(); grid.sync(); grid.sync(); grid.sync(); grid.sync(); const unsigned long long t1 = __builtin_amdgcn_s_memrealtime();
      if (blockIdx.x == 0 && threadIdx.x == 0) atomicAdd(a.out + O_NIS + 5, (float)(t1 - t0) * 0.01f * 0.01f); }
#endif
#endif
#undef IN
#undef SEAM
#undef GEMM
}

extern "C" void kernel_launch(void* const* d_in, const int* in_sizes, int n_in, void* d_out, int out_size, void* d_ws, size_t ws_size, hipStream_t stream) {
    static int grid = 0;
    if (grid == 0) {
        if (n_in != 36 || (size_t)out_size != O_END || ws_size < WS_END) { fprintf(stderr, "kernel_launch: unexpected sizes n_in %d out %d ws %zu (need %zu)\n", n_in, out_size, ws_size, (size_t)WS_END); grid = -1; return; }
        int dev = 0, cus = 0, per_cu = 0;
        (void)hipGetDevice(&dev); (void)hipDeviceGetAttribute(&cus, hipDeviceAttributeMultiprocessorCount, dev);
        if (hipFuncSetAttribute((const void*)hybrid_fwd, hipFuncAttributeMaxDynamicSharedMemorySize, LDS_BYTES) != hipSuccess) { fprintf(stderr, "kernel_launch: hipFuncSetAttribute failed\n"); grid = -1; return; }
        if (hipOccupancyMaxActiveBlocksPerMultiprocessor(&per_cu, (const void*)hybrid_fwd, 512, LDS_BYTES) != hipSuccess || per_cu < 1) { fprintf(stderr, "kernel_launch: occupancy query failed (%d)\n", per_cu); per_cu = 1; }
        (void)hipGetLastError();
        if (per_cu > 1) per_cu = 1;
        grid = cus * per_cu;
        fprintf(stderr, "kernel_launch: grid %d (cus %d)\n", grid, cus);
    }
    if (grid < 0) return;
    (void)hipMemsetAsync((char*)d_ws + WS_CTL, 0, CTL_BYTES, stream);
    Args a{};
    for (int i = 0; i < 36; ++i) a.in[i] = (const float*)d_in[i];
    a.out = (float*)d_out; a.ws = (unsigned char*)d_ws;
#if MK_ONE_LAUNCH
    a.ph_lo = 0; a.ph_hi = NPHASE;
    void* args[] = {&a};
    hipError_t e = hipLaunchCooperativeKernel((const void*)hybrid_fwd, dim3(grid), dim3(512), args, LDS_BYTES, stream);
    if (e != hipSuccess) fprintf(stderr, "kernel_launch: cooperative launch failed: %s (grid %d)\n", hipGetErrorString(e), grid);
#else
    for (int k = 0; k < NPHASE; ++k) { a.ph_lo = k; a.ph_hi = k + 1; hipLaunchKernelGGL(hybrid_fwd, dim3(grid), dim3(512), LDS_BYTES, stream, a); }
#endif
}
```

```cpp
#include <hip/hip_runtime.h>
#include <hip/hip_cooperative_groups.h>
#include <cstdio>
#include <cstdint>
namespace cg = cooperative_groups;
namespace pg8 {
#define PG8_LAS __attribute__((address_space(3)))
typedef unsigned short bf16_t;
typedef short bf16x8 __attribute__((ext_vector_type(8)));
typedef float f32x4 __attribute__((ext_vector_type(4)));
typedef unsigned u32x4 __attribute__((ext_vector_type(4)));
constexpr int BM = 256, BK = 64, HALF = 128, HTB = HALF * BK * 2  , STAGE_BYTES = 8 * HTB, NXCD = 8, WGM = 8;

__host__ __device__ __forceinline__ int lds_byte(int r, int c) { const int st = (r >> 4) * 2 + (c >> 5), rr = r & 15, cc = c & 31, ob = rr * 64 + cc * 2; return st * 1024 + (ob ^ (((ob >> 9) & 1) << 5)); }
__host__ __device__ __forceinline__ void stage_rc(int b, int& R, int& C) { const int st = b / 1024, sb = b % 1024, swz = sb ^ (((sb >> 9) & 1) << 5); R = (st >> 1) * 16 + swz / 64; C = (st & 1) * 32 + (swz % 64) / 2; }
__host__ __device__ __forceinline__ int perm32(int rho) { const int n = rho >> 4, i = rho & 15; return 8 * (i >> 2) + 4 * n + (i & 3); }

struct Unit { int pm, pn, k0, nt, tail, part, seg; };
struct Gemm { const bf16_t* A; const bf16_t* Bt; int M, N, K; };

struct HybridOrder {
    int nM, nN, nwg, G, c, R, ntail, S, ntk, npart, segk; float* slots; unsigned* cnt;
    __device__ void init(int M, int N, int K, int G_, int c_, int S_, float* slots_, unsigned* cnt_) { nM = M / BM; nN = N / BM; nwg = nM * nN; G = G_; c = c_; R = nwg / G; ntail = nwg - R * G;
        S = S_; ntk = K / BK; npart = ntk / S; slots = slots_; cnt = cnt_; segk = 0; }
    __device__ void tile_of(int L, Unit& u) const {
        int wgid = L; { const int q = nwg / NXCD, r = nwg % NXCD, xcd = wgid % NXCD, off = wgid / NXCD; wgid = (xcd < r ? xcd * (q + 1) : r * (q + 1) + (xcd - r) * q) + off; }
        const int nig = WGM * nN, gid = wgid / nig, fm = gid * WGM, gsz = (nM - fm) < WGM ? (nM - fm) : WGM;
        u.pm = fm + ((wgid % nig) % gsz); u.pn = (wgid % nig) / gsz;
    }
    __device__ bool next(int i2, Unit& u) const {
        const int i = segk ? (i2 >> 1) : i2, sg = segk ? (i2 & 1) : 0;
        u.seg = 0;
        if (i < R) { tile_of(i * G + c, u); u.k0 = 0; u.nt = ntk; u.tail = -1; u.part = 0; }
        else if (i == R && c < ntail * S) { const int j = c % ntail, p = c / ntail; tile_of(R * G + j, u); u.k0 = p * npart; u.nt = npart; u.tail = S > 1 ? j : -1; u.part = p; }
        else return false;
        if (segk) { if (sg == 0) { u.nt = segk; u.seg = 1; } else { u.k0 = segk; u.nt = ntk - segk; } }
        return true;
    }
    __device__ __forceinline__ void a_ready(const Unit&) const {}
    __device__ __forceinline__ void done(const Unit&) const {}
};

__device__ __forceinline__ unsigned cvt_pk_bf16(float lo, float hi) { unsigned r; asm volatile("v_cvt_pk_bf16_f32 %0, %1, %2" : "=v"(r) : "v"(lo), "v"(hi)); return r; }
typedef float f32x2 __attribute__((ext_vector_type(2)));
template <int NS, class Sched>
__device__ __forceinline__ unsigned tail_exchange_t(f32x4 (&acc)[2][2][4][2], const Unit& u, const Sched& S, int tid) {
    constexpr int RS = 32 / NS; const int part = u.part;
    float* base = S.slots + (size_t)(u.tail * NS) * 65536 + tid * 4;
    float* mine = base + (size_t)part * 65536;
#pragma unroll
    for (int ai = 0; ai < 2; ++ai)
#pragma unroll
        for (int m = 0; m < 4; ++m)
#pragma unroll
            for (int bj = 0; bj < 2; ++bj)
#pragma unroll
                for (int n = 0; n < 2; ++n) { const int r = ((ai * 4 + m) * 2 + bj) * 2 + n; const f32x4 v = acc[ai][bj][m][n]; const float* q = mine + r * 2048;
                    if (r / RS != part) asm volatile("global_store_dwordx4 %0, %1, off sc1" :: "v"(q), "v"(v) : "memory"); }
    asm volatile("s_waitcnt vmcnt(0)" ::: "memory");
    __builtin_amdgcn_s_barrier();
    if (tid == 0) { unsigned* cw = S.cnt + u.tail * 16; __hip_atomic_fetch_add(cw, 1u, __ATOMIC_RELAXED, __HIP_MEMORY_SCOPE_AGENT);
        unsigned sp = 0; while (__hip_atomic_load(cw, __ATOMIC_RELAXED, __HIP_MEMORY_SCOPE_AGENT) < (unsigned)NS) { __builtin_amdgcn_s_sleep(2); if (++sp > (1u << 22)) break; } }
    asm volatile("s_waitcnt vmcnt(0) lgkmcnt(0)" ::: "memory");
    __builtin_amdgcn_s_barrier();
    asm volatile("" ::: "memory");
#pragma unroll
    for (int ai = 0; ai < 2; ++ai)
#pragma unroll
        for (int m = 0; m < 4; ++m)
#pragma unroll
            for (int bj = 0; bj < 2; ++bj)
#pragma unroll
                for (int n = 0; n < 2; ++n) { const int r = ((ai * 4 + m) * 2 + bj) * 2 + n;
                    if (r / RS == part) { f32x4 pv[NS];
#pragma unroll
                        for (int pp = 0; pp < NS; ++pp) { const float* q = base + (size_t)pp * 65536 + r * 2048; asm volatile("global_load_dwordx4 %0, %1, off sc1" : "=v"(pv[pp]) : "v"(q) : "memory"); }
                        if constexpr (NS == 16) asm volatile("s_waitcnt vmcnt(0)" : "+v"(pv[0]), "+v"(pv[1]), "+v"(pv[2]), "+v"(pv[3]), "+v"(pv[4]), "+v"(pv[5]), "+v"(pv[6]), "+v"(pv[7]), "+v"(pv[8 % NS]), "+v"(pv[9 % NS]), "+v"(pv[10 % NS]), "+v"(pv[11 % NS]), "+v"(pv[12 % NS]), "+v"(pv[13 % NS]), "+v"(pv[14 % NS]), "+v"(pv[15 % NS]) :: "memory");
                        else if constexpr (NS == 8) asm volatile("s_waitcnt vmcnt(0)" : "+v"(pv[0]), "+v"(pv[1]), "+v"(pv[2 % NS]), "+v"(pv[3 % NS]), "+v"(pv[4 % NS]), "+v"(pv[5 % NS]), "+v"(pv[6 % NS]), "+v"(pv[7 % NS]) :: "memory");
                        else if constexpr (NS == 4) asm volatile("s_waitcnt vmcnt(0)" : "+v"(pv[0]), "+v"(pv[1]), "+v"(pv[2 % NS]), "+v"(pv[3 % NS]) :: "memory");
                        else asm volatile("s_waitcnt vmcnt(0)" : "+v"(pv[0]), "+v"(pv[1]) :: "memory");
                        f32x4 s = acc[ai][bj][m][n];
#pragma unroll
                        for (int pp = 0; pp < NS; ++pp) { const f32x4 z = (f32x4){0.f, 0.f, 0.f, 0.f}; s += (pp != part) ? pv[pp] : z; }
                        acc[ai][bj][m][n] = s; } }
    return (RS >= 32 ? 0xffffffffu : ((1u << RS) - 1u)) << (part * RS);
}
template <class Sched>
__device__ __forceinline__ unsigned tail_exchange(f32x4 (&acc)[2][2][4][2], const Unit& u, const Sched& S, int tid) {
    if (S.S == 8) return tail_exchange_t<8>(acc, u, S, tid);
    if (S.S == 16) return tail_exchange_t<16>(acc, u, S, tid);
    if (S.S == 2) return tail_exchange_t<2>(acc, u, S, tid);
    return tail_exchange_t<4>(acc, u, S, tid);
}
template <class Epi, class Sched, bool ALIGN_EPI = false, bool SP2 = false>
__device__ __forceinline__ void gemm_phase(PG8_LAS unsigned char* lds, const Gemm g, const Sched& S, const Epi& E) {
    int tid_ = threadIdx.x; asm volatile("" : "+v"(tid_));
    const int tid = tid_, wid = __builtin_amdgcn_readfirstlane(tid >> 6), lane = tid & 63, wr = wid >> 2, wc = wid & 3, fr = lane & 15, fq = lane >> 4;
    const int K = g.K;
    unsigned voffA[2], voffB[2];
#pragma unroll
    for (int i = 0; i < 2; ++i) { int R, C; stage_rc(tid * 16 + i * 8192, R, C); const int Rb = Epi::PERM ? ((R & ~31) + perm32(R & 31)) : R;
        voffA[i] = (unsigned)(R * K + C) * 2u; voffB[i] = (unsigned)(Rb * K + C) * 2u; }
    const size_t kstep = (size_t)(BK * 2);
    const size_t hstep = (size_t)HALF * K * 2;
    const size_t tstep = 2 * hstep;
    const unsigned ldsw = (unsigned)wid * 1024u;
    const int aoff = lds_byte(wr * 64 + fr, fq * 8), boff = lds_byte(wc * 32 + fr, fq * 8);
#define PG8_SA(b, h) (((b) * 2 + (h)) * HTB)
#define PG8_SB(b, h) ((4 + (b) * 2 + (h)) * HTB)
#define PG8_STAGE(bufoff, gbase, voff) do { _Pragma("unroll") for (int _i = 0; _i < 2; ++_i) \
        __builtin_amdgcn_global_load_lds((const unsigned*)((const char*)(gbase) + (voff)[_i]), (PG8_LAS unsigned*)(lds + (bufoff) + ldsw + _i * 8192), 16, 0, 0); } while (0)
#define PG8_LDA(dst, b, h) do { _Pragma("unroll") for (int m = 0; m < 4; ++m) _Pragma("unroll") for (int k = 0; k < 2; ++k) dst[m][k] = *(const PG8_LAS bf16x8*)(lds + PG8_SA(b, h) + aoff + m * 2048 + k * 1024); } while (0)
#define PG8_LDB(dst, b, h) do { _Pragma("unroll") for (int n = 0; n < 2; ++n) _Pragma("unroll") for (int k = 0; k < 2; ++k) dst[n][k] = *(const PG8_LAS bf16x8*)(lds + PG8_SB(b, h) + boff + n * 2048 + k * 1024); } while (0)
#define PG8_MMA(ai, bj, At, Bt) do { __builtin_amdgcn_s_setprio(1); _Pragma("unroll") for (int m = 0; m < 4; ++m) _Pragma("unroll") for (int n = 0; n < 2; ++n) _Pragma("unroll") for (int k = 0; k < 2; ++k) \
        acc[ai][bj][m][n] = __builtin_amdgcn_mfma_f32_16x16x32_bf16(Bt[n][k], At[m][k], acc[ai][bj][m][n], 0, 0, 0); __builtin_amdgcn_s_setprio(0); } while (0)
#define PG8_WAIT_V(n) asm volatile("s_waitcnt vmcnt(" #n ")" ::: "memory")
#define PG8_WAIT_L(n) asm volatile("s_waitcnt lgkmcnt(" #n ")" ::: "memory")
#define PG8_BAR __builtin_amdgcn_s_barrier()
#define PG8_SCHED __builtin_amdgcn_sched_barrier(0)
    Unit cur, nxt; int ui = 0;
    if (!S.next(0, cur)) return;
    f32x4 acc[2][2][4][2];
#pragma unroll
    for (int a = 0; a < 2; ++a)
#pragma unroll
        for (int b = 0; b < 2; ++b)
#pragma unroll
            for (int m = 0; m < 4; ++m)
#pragma unroll
                for (int n = 0; n < 2; ++n) acc[a][b][m][n] = (f32x4){0.f, 0.f, 0.f, 0.f};
    bf16x8 At[4][2], B0[2][2], B1[2][2];
    const char* cA = (const char*)g.A + (size_t)cur.pm * tstep + (size_t)cur.k0 * kstep; const char* cB = (const char*)g.Bt + (size_t)cur.pn * tstep + (size_t)cur.k0 * kstep;
    S.a_ready(cur);
    if constexpr (SP2) {
        PG8_STAGE(PG8_SB(0, 0), cB, voffB); PG8_STAGE(PG8_SB(0, 1), cB + hstep, voffB); PG8_STAGE(PG8_SA(0, 0), cA, voffA); PG8_STAGE(PG8_SA(0, 1), cA + hstep, voffA);
        if (wr == 1) PG8_BAR;
        PG8_WAIT_V(2); PG8_BAR;
        PG8_STAGE(PG8_SB(1, 0), cB + kstep, voffB); PG8_STAGE(PG8_SA(1, 0), cA + kstep, voffA); PG8_STAGE(PG8_SB(1, 1), cB + hstep + kstep, voffB);
        PG8_WAIT_V(6); PG8_BAR;
    } else {
        PG8_STAGE(PG8_SB(0, 0), cB, voffB); PG8_STAGE(PG8_SA(0, 0), cA, voffA); PG8_STAGE(PG8_SB(0, 1), cB + hstep, voffB); PG8_STAGE(PG8_SA(0, 1), cA + hstep, voffA);
        if (wr == 1) PG8_BAR;
        PG8_WAIT_V(4); PG8_BAR;
        PG8_STAGE(PG8_SB(1, 0), cB + kstep, voffB); PG8_STAGE(PG8_SA(1, 0), cA + kstep, voffA); PG8_STAGE(PG8_SB(1, 1), cB + hstep + kstep, voffB);
        PG8_WAIT_V(6); PG8_BAR;
    }
    for (;;) {
        const bool has_next = S.next(ui + 1, nxt);
        const char* nA = has_next ? (const char*)g.A + (size_t)nxt.pm * tstep + (size_t)nxt.k0 * kstep : cA; const char* nB = has_next ? (const char*)g.Bt + (size_t)nxt.pn * tstep + (size_t)nxt.k0 * kstep : cB;
        const int nt = cur.nt;
        for (int t = 0; t < nt; t += 2) {
            const bool last = (t == nt - 2);
            const char* a1 = cA + (size_t)(t + 1) * kstep;
            const char* a2 = last ? nA : cA + (size_t)(t + 2) * kstep; const char* b2 = last ? nB : cB + (size_t)(t + 2) * kstep;
            const char* a3 = a2 + kstep; const char* b3 = b2 + kstep;
            if (last && has_next) S.a_ready(nxt);
            if constexpr (SP2) {
            PG8_LDB(B0, 0, 0); PG8_LDB(B1, 0, 1); PG8_SCHED; PG8_LDA(At, 0, 0); PG8_STAGE(PG8_SA(1, 1), a1 + hstep, voffA);
            PG8_WAIT_V(8); PG8_WAIT_L(0); PG8_BAR; PG8_MMA(0, 0, At, B0); PG8_MMA(0, 1, At, B1); PG8_BAR; PG8_SCHED;
            PG8_LDA(At, 0, 1); PG8_STAGE(PG8_SB(0, 0), b2, voffB); PG8_STAGE(PG8_SB(0, 1), b2 + hstep, voffB); PG8_STAGE(PG8_SA(0, 0), a2, voffA);
            PG8_WAIT_V(8); PG8_WAIT_L(0); PG8_BAR; PG8_MMA(1, 0, At, B0); PG8_MMA(1, 1, At, B1); PG8_BAR; PG8_SCHED;
            PG8_LDB(B0, 1, 0); PG8_LDB(B1, 1, 1); PG8_SCHED; PG8_LDA(At, 1, 0); PG8_STAGE(PG8_SA(0, 1), a2 + hstep, voffA);
            PG8_WAIT_V(8); PG8_WAIT_L(0); PG8_BAR; PG8_MMA(0, 0, At, B0); PG8_MMA(0, 1, At, B1); PG8_BAR; PG8_SCHED;
            PG8_LDA(At, 1, 1); PG8_STAGE(PG8_SB(1, 0), b3, voffB); PG8_STAGE(PG8_SB(1, 1), b3 + hstep, voffB); PG8_STAGE(PG8_SA(1, 0), a3, voffA);
            PG8_WAIT_V(8); PG8_WAIT_L(0); PG8_BAR; PG8_MMA(1, 0, At, B0); PG8_MMA(1, 1, At, B1); PG8_BAR; PG8_SCHED;
            } else {
            PG8_LDB(B0, 0, 0); PG8_SCHED; PG8_LDA(At, 0, 0); PG8_STAGE(PG8_SA(1, 1), a1 + hstep, voffA);
            PG8_WAIT_L(8); PG8_BAR; PG8_WAIT_L(0); PG8_MMA(0, 0, At, B0); PG8_BAR; PG8_SCHED;
            PG8_LDB(B1, 0, 1); PG8_STAGE(PG8_SB(0, 0), b2, voffB);
            PG8_BAR; PG8_WAIT_L(0); PG8_MMA(0, 1, At, B1); PG8_BAR;
            PG8_LDA(At, 0, 1); PG8_STAGE(PG8_SA(0, 0), a2, voffA);
            PG8_BAR; PG8_WAIT_L(0); PG8_MMA(1, 0, At, B0); PG8_BAR; PG8_SCHED;
            PG8_STAGE(PG8_SB(0, 1), b2 + hstep, voffB);
            PG8_WAIT_V(6); PG8_BAR; PG8_MMA(1, 1, At, B1); PG8_BAR;
            PG8_LDB(B0, 1, 0); PG8_SCHED; PG8_LDA(At, 1, 0); PG8_STAGE(PG8_SA(0, 1), a2 + hstep, voffA);
            PG8_WAIT_L(8); PG8_BAR; PG8_WAIT_L(0); PG8_MMA(0, 0, At, B0); PG8_BAR; PG8_SCHED;
            PG8_LDB(B1, 1, 1); PG8_STAGE(PG8_SB(1, 0), b3, voffB);
            PG8_BAR; PG8_WAIT_L(0); PG8_MMA(0, 1, At, B1); PG8_BAR;
            PG8_LDA(At, 1, 1); PG8_STAGE(PG8_SA(1, 0), a3, voffA);
            PG8_BAR; PG8_WAIT_L(0); PG8_MMA(1, 0, At, B0); PG8_BAR; PG8_SCHED;
            PG8_STAGE(PG8_SB(1, 1), b3 + hstep, voffB);
            PG8_WAIT_V(6); PG8_BAR; PG8_MMA(1, 1, At, B1); PG8_BAR;
            }
        }
        if constexpr (ALIGN_EPI) { if (wr == 0) PG8_BAR; }
        if (cur.seg == 1) { if constexpr (Epi::MID_T > 0) E.mid(acc, cur, wr, wc, fr, fq); }
        else { unsigned rmask = 0xffffffffu; if (cur.tail >= 0) rmask = tail_exchange(acc, cur, S, tid); E(acc, cur, wr, wc, fr, fq, rmask); }
        if (!has_next) break;
        if (cur.seg != 1)
#pragma unroll
        for (int a = 0; a < 2; ++a)
#pragma unroll
            for (int b = 0; b < 2; ++b)
#pragma unroll
                for (int m = 0; m < 4; ++m)
#pragma unroll
                    for (int n = 0; n < 2; ++n) acc[a][b][m][n] = (f32x4){0.f, 0.f, 0.f, 0.f};
        cur = nxt; cA = nA; cB = nB; ++ui;
        if constexpr (ALIGN_EPI) { if (wr == 1) PG8_BAR; }
    }
    PG8_WAIT_V(0);
    if constexpr (!ALIGN_EPI) { if (wr == 0) PG8_BAR; }
    PG8_BAR;
#undef PG8_SA
#undef PG8_SB
#undef PG8_STAGE
#undef PG8_LDA
#undef PG8_LDB
#undef PG8_MMA
#undef PG8_WAIT_V
#undef PG8_WAIT_L
#undef PG8_BAR
#undef PG8_SCHED
}
}

#define LAS __attribute__((address_space(3)))
typedef unsigned short bf16;
typedef unsigned v4u __attribute__((ext_vector_type(4)));
typedef unsigned v2u __attribute__((ext_vector_type(2)));
typedef float f32x4 __attribute__((ext_vector_type(4)));
typedef float f32x2 __attribute__((ext_vector_type(2)));
typedef short bf16x8 __attribute__((ext_vector_type(8)));
typedef short s16x4 __attribute__((ext_vector_type(4)));

#ifndef MK_ONE_LAUNCH
#define MK_ONE_LAUNCH 1
#endif

constexpr int DM = 2048, NTOK = 9216, NPTOK = 8192, SEQ = 2048, NB = 4, DECB = 128, DECT = 8;
constexpr int IN_DIM = 9216, FF = 8192, ADA_N = 12288;
constexpr int C_K = 1024, C_V = 1280, C_XA = 1536, C_XB = 2048, C_XS = 2560, C_G = 3072;
constexpr int NMODROW = 132;
constexpr int NPHASE = 20;
constexpr int SK_G1 = 16, SK_MG = 1, SK_WO = 8, SK_F1 = 2, SK_F2 = 8;

constexpr size_t MiB = 1u << 20;
constexpr size_t WS_CTL = 0, CTL_BYTES = 1 * MiB;
constexpr size_t WS_ROPE = 1 * MiB, WS_AC = 2 * MiB, WS_MOD = 3 * MiB, WS_WADA = 16 * MiB;
constexpr size_t WS_WL = 112 * MiB, WL_STRIDE = 118 * MiB;
constexpr size_t WL_IN = 0, WL_O = 36 * MiB, WL_CO = 40 * MiB, WL_GA = 42 * MiB, WL_GB = 44 * MiB, WL_OUT = 46 * MiB, WL_F1 = 54 * MiB, WL_F2 = 86 * MiB;
constexpr size_t WS_H = 348 * MiB;
constexpr size_t WS_P = 384 * MiB;
constexpr size_t WS_QN = 546 * MiB, WS_KN = 564 * MiB, WS_O = 569 * MiB, WS_YC = 587 * MiB, WS_YS = 596 * MiB;
constexpr size_t WS_MG = 605 * MiB;
constexpr size_t WS_X = 677 * MiB;
constexpr size_t WS_SLOT2 = 749 * MiB;
constexpr size_t WS_END = 781 * MiB;

constexpr size_t O_Y = 0;
constexpr size_t O_NKP = (size_t)NTOK * DM;
constexpr size_t O_NVP = O_NKP + 2 * 4 * 128 * 256;
constexpr size_t O_NCP = O_NVP + 2 * 4 * 128 * 256;
constexpr size_t O_NRP = O_NCP + 2 * 4 * 30 * 512;
constexpr size_t O_NIP = O_NRP + 2 * 4 * 32 * 64;
constexpr size_t O_NKS = O_NIP + 2 * 4 * 32 * 64;
constexpr size_t O_NVS = O_NKS + (size_t)2 * 128 * 128 * 256;
constexpr size_t O_NCS = O_NVS + (size_t)2 * 128 * 128 * 256;
constexpr size_t O_NRS = O_NCS + (size_t)2 * 128 * 30 * 512;
constexpr size_t O_NIS = O_NRS + (size_t)2 * 128 * 32 * 64;
constexpr size_t O_END = O_NIS + (size_t)2 * 128 * 32 * 64;

constexpr int LDS_BYTES = 135168;

struct Args { const float* in[36]; float* out; unsigned char* ws; int ph_lo, ph_hi; };

enum { I_XP = 0, I_XS, I_CP, I_CS, I_CK, I_CV, I_SCONV, I_SRE, I_SIM, I_WADA, I_BADA, I_NORM1, I_WIN, I_QN, I_KN, I_SINK, I_WO, I_CW, I_CB, I_CLG, I_CLB, I_WCO,
       I_ARE, I_AIM, I_LDT, I_BRE, I_BIM, I_CRE, I_CIM, I_SD, I_WGA, I_WGB, I_WOUT, I_NORM2, I_WF1, I_WF2 };

__device__ __forceinline__ float bf2f(unsigned b) { return __uint_as_float(b << 16); }
__device__ __forceinline__ unsigned pk2(float lo, float hi) { unsigned r; asm("v_cvt_pk_bf16_f32 %0, %1, %2" : "=v"(r) : "v"(lo), "v"(hi)); return r; }
__device__ __forceinline__ unsigned f2bf(float f) { return pk2(f, 0.f) & 0xffffu; }
__device__ __forceinline__ float lo16(unsigned w) { return __uint_as_float(w << 16); }
__device__ __forceinline__ float hi16(unsigned w) { return __uint_as_float(w & 0xffff0000u); }
__device__ __forceinline__ float sigm(float x) { return __builtin_amdgcn_rcpf(1.f + __expf(-x)); }
__device__ __forceinline__ float wave_sum(float v) {
#pragma unroll
    for (int o = 1; o < 64; o <<= 1) v += __shfl_xor(v, o);
    return v;
}
#define LDS_WAIT() asm volatile("s_waitcnt lgkmcnt(0)" ::: "memory")
#define WAVE_SYNC() do { asm volatile("s_waitcnt lgkmcnt(0)" ::: "memory"); __builtin_amdgcn_wave_barrier(); asm volatile("" ::: "memory"); } while (0)

__device__ __forceinline__ double dexp_(double x) {
    const double kf = rint(x * 1.4426950408889634);
    double r = fma(-kf, 6.93147180369123816490e-01, x); r = fma(-kf, 1.90821492927058770002e-10, r);
    double p = 1.0 / 6227020800.0;
    p = fma(p, r, 1.0 / 479001600.0); p = fma(p, r, 1.0 / 39916800.0); p = fma(p, r, 1.0 / 3628800.0); p = fma(p, r, 1.0 / 362880.0);
    p = fma(p, r, 1.0 / 40320.0); p = fma(p, r, 1.0 / 5040.0); p = fma(p, r, 1.0 / 720.0); p = fma(p, r, 1.0 / 120.0);
    p = fma(p, r, 1.0 / 24.0); p = fma(p, r, 1.0 / 6.0); p = fma(p, r, 0.5); p = fma(p, r, 1.0); p = fma(p, r, 1.0);
    const long long k = (long long)kf;
    return p * __longlong_as_double((1023ll + k) << 52);
}
__device__ __forceinline__ void dsincos_(double x, double& sn, double& cs) {
    const double kf = rint(x * 0.15915494309189535);
    double r = fma(-kf, 6.283185307179586, x); r = fma(-kf, 2.4492935982947064e-16, r);
    const double s = r * 0.125, z = s * s;
    double ps = -1.0 / 355687428096000.0;
    ps = fma(ps, z, 1.0 / 1307674368000.0); ps = fma(ps, z, -1.0 / 6227020800.0); ps = fma(ps, z, 1.0 / 39916800.0); ps = fma(ps, z, -1.0 / 362880.0);
    ps = fma(ps, z, 1.0 / 5040.0); ps = fma(ps, z, -1.0 / 120.0); ps = fma(ps, z, 1.0 / 6.0);
    double a = s - s * z * ps;
    double pc = 1.0 / 20922789888000.0;
    pc = fma(pc, z, -1.0 / 87178291200.0); pc = fma(pc, z, 1.0 / 479001600.0); pc = fma(pc, z, -1.0 / 3628800.0); pc = fma(pc, z, 1.0 / 40320.0);
    pc = fma(pc, z, -1.0 / 720.0); pc = fma(pc, z, 1.0 / 24.0); pc = fma(pc, z, -0.5);
    double b = fma(pc, z, 1.0);
#pragma unroll
    for (int i = 0; i < 3; ++i) { const double a2 = 2.0 * a * b, b2 = 1.0 - 2.0 * a * a; a = a2; b = b2; }
    sn = a; cs = b;
}

namespace pg8 {
#define EPI_FOREACH4(...) \
    _Pragma("unroll") for (int ai = 0; ai < 2; ++ai) _Pragma("unroll") for (int m = 0; m < 4; ++m) { const int row = u.pm * BM + ai * HALF + wr * 64 + m * 16 + fr; \
    _Pragma("unroll") for (int bj = 0; bj < 2; ++bj) _Pragma("unroll") for (int n = 0; n < 2; ++n) { const int col = u.pn * BM + bj * HALF + wc * 32 + n * 16 + 4 * fq; const f32x4 v = acc[ai][bj][m][n]; if ((rmask >> (((ai * 4 + m) * 2 + bj) * 2 + n)) & 1u) { __VA_ARGS__ } } if (m & 1) { asm volatile("" ::: "memory"); __builtin_amdgcn_sched_barrier(0); } }
#define EPI_FOREACH8(...) \
    _Pragma("unroll") for (int ai = 0; ai < 2; ++ai) _Pragma("unroll") for (int m = 0; m < 4; ++m) { const int row = u.pm * BM + ai * HALF + wr * 64 + m * 16 + fr; \
    _Pragma("unroll") for (int bj = 0; bj < 2; ++bj) { const int col = u.pn * BM + bj * HALF + wc * 32 + 8 * fq; const f32x4 v0 = acc[ai][bj][m][0], v1 = acc[ai][bj][m][1]; if ((rmask >> (((ai * 4 + m) * 2 + bj) * 2)) & 1u) { __VA_ARGS__ } } if (m & 1) { asm volatile("" ::: "memory"); __builtin_amdgcn_sched_barrier(0); } }
#define EPI_SIG const f32x4 (&acc)[2][2][4][2], const Unit& u, int wr, int wc, int fr, int fq, unsigned rmask

__device__ __forceinline__ int mod_row(int row) { return row < NPTOK ? (row >> 11) : 4 + ((row - NPTOK) >> 3); }
__device__ __forceinline__ v4u pack8(const f32x4 a, const f32x4 b) { v4u w; w.x = cvt_pk_bf16(a[0], a[1]); w.y = cvt_pk_bf16(a[2], a[3]); w.z = cvt_pk_bf16(b[0], b[1]); w.w = cvt_pk_bf16(b[2], b[3]); return w; }

struct EpiAda {
    static constexpr bool PERM = false, AFTER_DRAIN = false; static constexpr int MID_T = -1; float* mod; const float* bias;
    __device__ __forceinline__ void operator()(EPI_SIG) const {
        EPI_FOREACH4( if (row < NMODROW) { const f32x4 bv = *(const f32x4*)(bias + col); *(f32x4*)(mod + row * (2 * ADA_N) + col) = v + bv; } )
    }
};
struct EpiP {
    static constexpr bool PERM = true, AFTER_DRAIN = false; static constexpr int MID_T = -1; bf16_t* P;
    __device__ __forceinline__ void operator()(EPI_SIG) const {
        const bool sg = (u.pn * BM) >= C_G;
        EPI_FOREACH8( f32x4 a = v0, b = v1; if (sg) {
            _Pragma("unroll") for (int i = 0; i < 4; ++i) { a[i] = sigm(a[i]); b[i] = sigm(b[i]); } }
            *(v4u*)(P + (unsigned)(row * IN_DIM + col)) = pack8(a, b); )
    }
};
struct EpiStoreF32 {
    static constexpr bool PERM = false, AFTER_DRAIN = false; static constexpr int MID_T = -1; float* MG;
    __device__ __forceinline__ void operator()(EPI_SIG) const { EPI_FOREACH4( *(f32x4*)(MG + (unsigned)(row * DM + col)) = v; ) }
};
__device__ __forceinline__ f32x4 gate4(const bf16_t* P, int row, int col, int br) {
    const v2u g = *(const v2u*)(P + (unsigned)(row * IN_DIM + C_G + br * DM + col)); return (f32x4){lo16(g.x), hi16(g.x), lo16(g.y), hi16(g.y)};
}
struct EpiGluB {
    static constexpr bool PERM = false, AFTER_DRAIN = false; static constexpr int MID_T = -1; float* MG; const bf16_t* P;
    __device__ __forceinline__ void operator()(EPI_SIG) const {
        EPI_FOREACH4( float* p = MG + (unsigned)(row * DM + col); const f32x4 a = *(const f32x4*)p; const f32x4 g = gate4(P, row, col, 2); f32x4 o;
            _Pragma("unroll") for (int i = 0; i < 4; ++i) o[i] = g[i] * a[i] * sigm(v[i]);
            *(f32x4*)p = o; )
    }
};
struct EpiAccG {
    static constexpr bool PERM = false, AFTER_DRAIN = false; static constexpr int MID_T = -1; float* MG; const bf16_t* P; int br;
    __device__ __forceinline__ void operator()(EPI_SIG) const {
        EPI_FOREACH4( float* p = MG + (unsigned)(row * DM + col); const f32x4 a = *(const f32x4*)p; const f32x4 g = gate4(P, row, col, br); *(f32x4*)p = a + g * v; )
    }
};
struct EpiMergeFinal {
    static constexpr bool PERM = false, AFTER_DRAIN = false; static constexpr int MID_T = -1; const float* MG; const bf16_t* P; bf16_t* MGb; int br;
    __device__ __forceinline__ void operator()(EPI_SIG) const {
        EPI_FOREACH4( const f32x4 a = *(const f32x4*)(MG + (unsigned)(row * DM + col)); const f32x4 g = gate4(P, row, col, br); const f32x4 o = a + g * v;
            v2u w; w.x = cvt_pk_bf16(o[0], o[1]); w.y = cvt_pk_bf16(o[2], o[3]); *(v2u*)(MGb + (unsigned)(row * DM + col)) = w; )
    }
};
struct EpiGlu {
    static constexpr bool PERM = false, AFTER_DRAIN = false; static constexpr int MID_T = -1; bf16_t* MGa; const bf16_t* P;
    __device__ __forceinline__ void operator()(EPI_SIG) const {
        _Pragma("unroll") for (int ai = 0; ai < 2; ++ai) _Pragma("unroll") for (int m = 0; m < 4; ++m) { const int row = u.pm * BM + ai * HALF + wr * 64 + m * 16 + fr;
            _Pragma("unroll") for (int bj = 0; bj < 2; ++bj) { if ((rmask >> (((ai * 4 + m) * 2 + bj) * 2)) & 1u) {
                const int j = u.pn * 128 + bj * 64 + wc * 16 + 4 * fq; const f32x4 av = acc[ai][bj][m][0], bv = acc[ai][bj][m][1]; const f32x4 g = gate4(P, row, j, 2); f32x4 o;
                _Pragma("unroll") for (int i = 0; i < 4; ++i) o[i] = g[i] * av[i] * sigm(bv[i]);
                v2u w; w.x = cvt_pk_bf16(o[0], o[1]); w.y = cvt_pk_bf16(o[2], o[3]); *(v2u*)(MGa + (unsigned)(row * DM + j)) = w; } }
            if (m & 1) { asm volatile("" ::: "memory"); __builtin_amdgcn_sched_barrier(0); } }
    }
};
struct EpiMergeMain {
    static constexpr bool PERM = false, AFTER_DRAIN = false; static constexpr int MID_T = 16; const bf16_t* MGa; const bf16_t* P; bf16_t* MGb;
    __device__ __forceinline__ void mid(f32x4 (&acc)[2][2][4][2], const Unit& u, int wr, int wc, int fr, int fq) const {
        _Pragma("unroll") for (int ai = 0; ai < 2; ++ai) _Pragma("unroll") for (int m = 0; m < 4; ++m) { const int row = u.pm * BM + ai * HALF + wr * 64 + m * 16 + fr;
            _Pragma("unroll") for (int bj = 0; bj < 2; ++bj) _Pragma("unroll") for (int n = 0; n < 2; ++n) { const int col = u.pn * BM + bj * HALF + wc * 32 + n * 16 + 4 * fq;
                const f32x4 g0 = gate4(P, row, col, 0), g1 = gate4(P, row, col, 1); f32x4 r;
                _Pragma("unroll") for (int i = 0; i < 4; ++i) r[i] = g0[i] * __builtin_amdgcn_rcpf(fmaxf(g1[i], 1e-30f));
                acc[ai][bj][m][n] = acc[ai][bj][m][n] * r; }
            if (m & 1) { asm volatile("" ::: "memory"); __builtin_amdgcn_sched_barrier(0); } }
    }
    __device__ __forceinline__ void operator()(EPI_SIG) const {
        EPI_FOREACH4( const f32x4 g1 = gate4(P, row, col, 1); const v2u mw = *(const v2u*)(MGa + (unsigned)(row * DM + col)); const f32x4 mg = (f32x4){lo16(mw.x), hi16(mw.x), lo16(mw.y), hi16(mw.y)};
            const f32x4 o = g1 * v + mg; v2u w; w.x = cvt_pk_bf16(o[0], o[1]); w.y = cvt_pk_bf16(o[2], o[3]); *(v2u*)(MGb + (unsigned)(row * DM + col)) = w; )
    }
};
struct EpiResid {
    static constexpr bool PERM = false, AFTER_DRAIN = false; static constexpr int MID_T = -1; const float* xp; const float* xs; const float* gate; float* out;
    __device__ __forceinline__ void operator()(EPI_SIG) const {
        const bool smp = u.pm * BM >= NPTOK; const float* xb = smp ? xs : xp; const int rb = smp ? NPTOK : 0;
        EPI_FOREACH4( const f32x4 x = *(const f32x4*)(xb + (unsigned)((row - rb) * DM + col));
            const int mr = smp ? 4 + ((row - NPTOK) >> 3) : (row >> 11);
            const f32x4 g = *(const f32x4*)(gate + (unsigned)(mr * (2 * ADA_N) + col)); *(f32x4*)(out + (unsigned)(row * DM + col)) = x + g * v; )
    }
};
struct EpiRelu2 {
    static constexpr bool PERM = true, AFTER_DRAIN = false; static constexpr int MID_T = -1; bf16_t* F;
    __device__ __forceinline__ void operator()(EPI_SIG) const {
        EPI_FOREACH8( f32x4 a = v0, b = v1;
            _Pragma("unroll") for (int i = 0; i < 4; ++i) { const float x = fmaxf(a[i], 0.f), y = fmaxf(b[i], 0.f); a[i] = x * x; b[i] = y * y; }
            *(v4u*)(F + (unsigned)(row * FF + col)) = pack8(a, b); )
    }
};
}

__device__ __forceinline__ void p0_transpose_item(const float* W, int K, int N, bf16* WT, int pitch, int koff, int row_off, int sel, LAS float* scr, int item, int lane) {
    const int nblk = N / 32, kb = item / nblk, nb = item % nblk, k0 = 64 * kb, n0 = 32 * nb;
#pragma unroll 16
    for (int i = 0; i < 32; ++i) { const int kk = 2 * i + (lane >> 5); scr[kk * 33 + (lane & 31)] = __builtin_nontemporal_load(W + (size_t)(k0 + kk) * N + n0 + (lane & 31)); }
    LDS_WAIT(); asm volatile("" ::: "memory");
    const int c = lane & 7;
#pragma unroll
    for (int j = 0; j < 4; ++j) { const int n = (lane >> 3) + 8 * j; const LAS float* s = scr + (8 * c) * 33 + n;
        v4u o; o.x = pk2(s[0 * 33], s[1 * 33]); o.y = pk2(s[2 * 33], s[3 * 33]); o.z = pk2(s[4 * 33], s[5 * 33]); o.w = pk2(s[6 * 33], s[7 * 33]);
        const int ng = n0 + n, drow = sel < 0 ? row_off + ng : 32 * (ng >> 4) + 16 * sel + (ng & 15);
        *(v4u*)(WT + (size_t)drow * pitch + koff + k0 + 8 * c) = o; }
    LDS_WAIT(); asm volatile("" ::: "memory");
}

constexpr int I_ADA = (DM / 64) * (ADA_N / 32), I_IN = (DM / 64) * (IN_DIM / 32), I_O = (1024 / 64) * (DM / 32), I_CO = (512 / 64) * (DM / 32), I_G = I_CO,
              I_OUT = (DM / 64) * (DM / 32), I_F1 = (DM / 64) * (FF / 32), I_F2 = (FF / 64) * (DM / 32);
constexpr int I_LAYER = I_IN + I_O + I_CO + 2 * I_G + I_OUT + I_F1 + I_F2, I_L0_PRO = I_LAYER - 12800;
__device__ __forceinline__ void convert_layer_item(const Args& a, int l, int r, LAS float* scr, int lane) {
    bf16* wl = (bf16*)(a.ws + WS_WL + (size_t)l * WL_STRIDE);
    if (r < I_IN) { p0_transpose_item(a.in[I_WIN] + (size_t)l * DM * IN_DIM, DM, IN_DIM, wl + WL_IN / 2, DM, 0, 0, -1, scr, r, lane); return; } r -= I_IN;
    if (r < I_O) { p0_transpose_item(a.in[I_WO] + (size_t)l * 1024 * DM, 1024, DM, wl + WL_O / 2, 1536, 0, 0, -1, scr, r, lane); return; } r -= I_O;
    if (r < I_CO) { p0_transpose_item(a.in[I_WCO] + (size_t)l * 512 * DM, 512, DM, wl + WL_O / 2, 1536, 1024, 0, -1, scr, r, lane); return; } r -= I_CO;
    if (r < I_G) { p0_transpose_item(a.in[I_WGA] + (size_t)l * 512 * DM, 512, DM, wl + WL_GA / 2, 512, 0, 0, 0, scr, r, lane); return; } r -= I_G;
    if (r < I_G) { p0_transpose_item(a.in[I_WGB] + (size_t)l * 512 * DM, 512, DM, wl + WL_GA / 2, 512, 0, 0, 1, scr, r, lane); return; } r -= I_G;
    if (r < I_OUT) { p0_transpose_item(a.in[I_WOUT] + (size_t)l * DM * DM, DM, DM, wl + WL_OUT / 2, DM, 0, 0, -1, scr, r, lane); return; } r -= I_OUT;
    if (r < I_F1) { p0_transpose_item(a.in[I_WF1] + (size_t)l * DM * FF, DM, FF, wl + WL_F1 / 2, DM, 0, 0, -1, scr, r, lane); return; } r -= I_F1;
    p0_transpose_item(a.in[I_WF2] + (size_t)l * FF * DM, FF, DM, wl + WL_F2 / 2, FF, 0, 0, -1, scr, r, lane);
}
__device__ __forceinline__ void convert_idle(const Args& a, LAS unsigned char* lds, int l, int c0, int i0, int i1) {
    int tid_o = threadIdx.x; asm volatile("" : "+v"(tid_o)); const int lane = tid_o & 63, wave = __builtin_amdgcn_readfirstlane(tid_o >> 6);
    const int c = (int)blockIdx.x - c0; if (c < 0) return;
    LAS float* scr = (LAS float*)(lds + wave * 16384);
    const int nw = ((int)gridDim.x - c0) * 8;
    for (int it = i0 + c * 8 + wave; it < i1; it += nw) convert_layer_item(a, l, it, scr, lane);
}

__device__ __forceinline__ void p0_prologue(const Args& a, LAS unsigned char* lds, int gw, int NGW, int lane, int wave, int gtid, int NGT) {
    LAS float* scr = (LAS float*)(lds + wave * 16384);
    unsigned char* ws = a.ws;
    for (int it = gw; it < 2 * I_ADA + I_L0_PRO; it += NGW) {
        if (it < 2 * I_ADA) { const int l = it / I_ADA, r = it - l * I_ADA; p0_transpose_item(a.in[I_WADA] + (size_t)l * DM * ADA_N, DM, ADA_N, (bf16*)(ws + WS_WADA), DM, 0, l * ADA_N, -1, scr, r, lane); }
        else convert_layer_item(a, 0, it - 2 * I_ADA, scr, lane);
    }
    for (int it = gw; it < I_LAYER; it += NGW) convert_layer_item(a, 1, it, scr, lane);
    unsigned* AC = (unsigned*)(ws + WS_AC);
    for (int i = gtid; i < 256 * DM / 2; i += NGT) {
        const int row = i / (DM / 2), c2 = (i % (DM / 2)) * 2; unsigned w = 0u;
        if (row < NMODROW) { const float* src = row < 4 ? a.in[I_CP] + row * DM + c2 : a.in[I_CS] + (row - 4) * DM + c2; const float x = src[0], y = src[1]; w = pk2(x * sigm(x), y * sigm(y)); }
        AC[i] = w;
    }
    f32x2* RT = (f32x2*)(ws + WS_ROPE);
    for (int i = gtid; i < 2056 * 8; i += NGT) {
        const int pi = i >> 3, fi = i & 7; const double pos = pi < 2048 ? (double)pi : (double)(8192 + pi - 2048);
        const double invf = dexp_(-(double)fi * 0.125 * 13.122363377404328);
        double sn, cs; dsincos_(pos * invf, sn, cs); RT[i] = (f32x2){(float)cs, (float)sn};
    }
}

__device__ __forceinline__ void norm_mod_phase(const float* xp, const float* xs, const float* normw, const float* mod, int l, int second, bf16* H) {
    int tid_o = threadIdx.x; asm volatile("" : "+v"(tid_o)); const int tid = tid_o, lane = tid & 63, wave = __builtin_amdgcn_readfirstlane(tid >> 6); (void)lane; (void)wave;
    const int NGW = gridDim.x * 8, gw = blockIdx.x * 8 + wave;
    for (int row0 = gw; row0 < NTOK; row0 += 2 * NGW) {
        const int row1 = row0 + NGW; const bool has1 = row1 < NTOK; const int r1 = has1 ? row1 : row0;
        const float* xr0 = row0 < NPTOK ? xp + (size_t)row0 * DM : xs + (size_t)(row0 - NPTOK) * DM;
        const float* xr1 = r1 < NPTOK ? xp + (size_t)r1 * DM : xs + (size_t)(r1 - NPTOK) * DM;
        f32x4 v0[8], v1[8]; float s0 = 0.f, s1 = 0.f;
#pragma unroll
        for (int j = 0; j < 8; ++j) { v0[j] = *(const f32x4*)(xr0 + 4 * (lane + 64 * j)); v1[j] = *(const f32x4*)(xr1 + 4 * (lane + 64 * j)); }
#pragma unroll
        for (int j = 0; j < 8; ++j) { s0 += (v0[j][0] * v0[j][0] + v0[j][1] * v0[j][1]) + (v0[j][2] * v0[j][2] + v0[j][3] * v0[j][3]); s1 += (v1[j][0] * v1[j][0] + v1[j][1] * v1[j][1]) + (v1[j][2] * v1[j][2] + v1[j][3] * v1[j][3]); }
        s0 = wave_sum(s0); s1 = wave_sum(s1);
        const float rs0 = rsqrtf(s0 * (1.f / DM) + 1e-6f), rs1 = rsqrtf(s1 * (1.f / DM) + 1e-6f);
        const float* sh0 = mod + (size_t)pg8::mod_row(row0) * (2 * ADA_N) + l * ADA_N + (second ? 3 : 0) * DM; const float* sh1 = mod + (size_t)pg8::mod_row(r1) * (2 * ADA_N) + l * ADA_N + (second ? 3 : 0) * DM;
#pragma unroll
        for (int j = 0; j < 8; ++j) { const int c = 4 * (lane + 64 * j); const f32x4 nw = *(const f32x4*)(normw + c);
            { const f32x4 sc = *(const f32x4*)(sh0 + DM + c), sh = *(const f32x4*)(sh0 + c); const f32x4 y = (v0[j] * rs0) * nw * (sc + 1.f) + sh; v2u w; w.x = pk2(y[0], y[1]); w.y = pk2(y[2], y[3]); *(v2u*)(H + (size_t)row0 * DM + c) = w; }
            if (has1) { const f32x4 sc = *(const f32x4*)(sh1 + DM + c), sh = *(const f32x4*)(sh1 + c); const f32x4 y = (v1[j] * rs1) * nw * (sc + 1.f) + sh; v2u w; w.x = pk2(y[0], y[1]); w.y = pk2(y[2], y[3]); *(v2u*)(H + (size_t)row1 * DM + c) = w; } }
    }
}

__device__ __forceinline__ void unpack8(const v4u r, float (&x)[8]) { x[0] = lo16(r.x); x[1] = hi16(r.x); x[2] = lo16(r.y); x[3] = hi16(r.y); x[4] = lo16(r.z); x[5] = hi16(r.z); x[6] = lo16(r.w); x[7] = hi16(r.w); }
__device__ __forceinline__ v4u pack8f(const float (&x)[8]) { v4u w; w.x = pk2(x[0], x[1]); w.y = pk2(x[2], x[3]); w.z = pk2(x[4], x[5]); w.w = pk2(x[6], x[7]); return w; }
template <int NKT>
__device__ __forceinline__ void attn_qgroup(const LAS bf16* Ks, int kst, const LAS bf16* Vt, int vst, const bf16* qrow, const float* qg, const f32x2* rt, int qi, bool hasprev, float sink, bf16* orow, bool store_ok, int lane) {
    static_assert(NKT % 2 == 0, "key tiles come in pairs");
    const int lr = lane & 15, q4 = lane >> 4;
    bf16x8 qf0, qf1;
    { float x0[8], x1[8]; unpack8(*(const v4u*)(qrow + 8 * q4), x0); unpack8(*(const v4u*)(qrow + 32 + 8 * q4), x1);
      float ss = 0.f;
#pragma unroll
      for (int e = 0; e < 8; ++e) ss += x0[e] * x0[e] + x1[e] * x1[e];
      ss += __shfl_xor(ss, 16); ss += __shfl_xor(ss, 32);
      const float rstd = rsqrtf(ss * (1.f / 64.f) + 1e-6f);
#pragma unroll
      for (int e = 0; e < 8; ++e) { x0[e] = x0[e] * rstd * qg[8 * q4 + e]; x1[e] = x1[e] * rstd * qg[32 + 8 * q4 + e]; }
#pragma unroll
      for (int e = 0; e < 8; ++e) { const float other = __shfl_xor(x0[e], 16); const f32x2 cs = rt[e];
          if (q4 == 0) x0[e] = x0[e] * cs.x - other * cs.y; else if (q4 == 1) x0[e] = x0[e] * cs.x + other * cs.y; }
#pragma unroll
      for (int e = 0; e < 8; ++e) { x0[e] *= 0.125f; x1[e] *= 0.125f; }
      qf0 = __builtin_bit_cast(bf16x8, pack8f(x0)); qf1 = __builtin_bit_cast(bf16x8, pack8f(x1)); }
    f32x4 s[NKT];
#pragma unroll
    for (int kt = 0; kt < NKT; ++kt) {
        const LAS bf16* kp = Ks + (16 * kt + lr) * kst + 8 * q4;
        const bf16x8 k0 = *(const LAS bf16x8*)kp, k1 = *(const LAS bf16x8*)(kp + 32);
        f32x4 z = (f32x4){0.f, 0.f, 0.f, 0.f};
        z = __builtin_amdgcn_mfma_f32_16x16x32_bf16(k0, qf0, z, 0, 0, 0);
        z = __builtin_amdgcn_mfma_f32_16x16x32_bf16(k1, qf1, z, 0, 0, 0);
        s[kt] = z;
        if ((kt & 3) == 3) __builtin_amdgcn_sched_barrier(0);
    }
    float m = sink;
#pragma unroll
    for (int kt = 0; kt < NKT; ++kt)
#pragma unroll
        for (int i = 0; i < 4; ++i) { const int kj = 16 * kt + 4 * q4 + i; const bool ok = (kj > qi) && (kj <= qi + 128) && (hasprev || kj >= 128);
            const float v = ok ? s[kt][i] : -INFINITY; s[kt][i] = v; m = fmaxf(m, v); }
    m = fmaxf(m, __shfl_xor(m, 16)); m = fmaxf(m, __shfl_xor(m, 32));
    float sum = 0.f;
#pragma unroll
    for (int kt = 0; kt < NKT; ++kt)
#pragma unroll
        for (int i = 0; i < 4; ++i) { const float p = __expf(s[kt][i] - m); s[kt][i] = p; sum += p; }
    sum += __shfl_xor(sum, 16); sum += __shfl_xor(sum, 32);
    const float inv = 1.f / (sum + __expf(sink - m));
    f32x4 o[4];
#pragma unroll
    for (int dt = 0; dt < 4; ++dt) o[dt] = (f32x4){0.f, 0.f, 0.f, 0.f};
#pragma unroll
    for (int kp = 0; kp < NKT / 2; ++kp) {
        v4u pw; pw.x = pk2(s[2 * kp][0], s[2 * kp][1]); pw.y = pk2(s[2 * kp][2], s[2 * kp][3]); pw.z = pk2(s[2 * kp + 1][0], s[2 * kp + 1][1]); pw.w = pk2(s[2 * kp + 1][2], s[2 * kp + 1][3]);
        const bf16x8 pb = __builtin_bit_cast(bf16x8, pw);
#pragma unroll
        for (int dt = 0; dt < 4; ++dt) {
            const LAS bf16* vp = Vt + (16 * dt + lr) * vst + 32 * kp + 4 * q4;
            const v2u lo = *(const LAS v2u*)vp, hi = *(const LAS v2u*)(vp + 16);
            v4u vw; vw.x = lo.x; vw.y = lo.y; vw.z = hi.x; vw.w = hi.y;
            o[dt] = __builtin_amdgcn_mfma_f32_16x16x32_bf16(__builtin_bit_cast(bf16x8, vw), pb, o[dt], 0, 0, 0);
        }
    }
    if (store_ok) {
#pragma unroll
        for (int dt = 0; dt < 4; ++dt) { v2u w; w.x = pk2(o[dt][0] * inv, o[dt][1] * inv); w.y = pk2(o[dt][2] * inv, o[dt][3] * inv); *(v2u*)(orow + 16 * dt + 4 * q4) = w; }
    }
}

constexpr int AP_KST = 72, AP_VST = 264;
constexpr int AS_KST = 72, AS_VST = 168, AS_NK = 160;

__device__ __forceinline__ void knorm_rope8(float (&x)[8], int ch, const float* kg, const f32x2* rt) {
    float ss = 0.f;
#pragma unroll
    for (int e = 0; e < 8; ++e) ss += x[e] * x[e];
    ss += __shfl_xor(ss, 1); ss += __shfl_xor(ss, 2); ss += __shfl_xor(ss, 4);
    const float rstd = rsqrtf(ss * (1.f / 64.f) + 1e-6f);
#pragma unroll
    for (int e = 0; e < 8; ++e) x[e] = x[e] * rstd * kg[ch * 8 + e];
#pragma unroll
    for (int e = 0; e < 8; ++e) { const float other = __shfl_xor(x[e], 1); const f32x2 cs = rt[e];
        if (ch == 0) x[e] = x[e] * cs.x - other * cs.y; else if (ch == 1) x[e] = x[e] * cs.x + other * cs.y; }
}
__device__ __forceinline__ void attn_prompt_item(const Args& a, int l, int item, LAS unsigned char* lds) {
    int tid_o = threadIdx.x; asm volatile("" : "+v"(tid_o)); const int tid = tid_o, lane = tid & 63, wave = __builtin_amdgcn_readfirstlane(tid >> 6); (void)lane; (void)wave;
    unsigned char* ws = a.ws; asm volatile("" : "+s"(ws)); const bf16* P = (const bf16*)(ws + WS_P); bf16* O = (bf16*)(ws + WS_O); const f32x2* RT = (const f32x2*)(ws + WS_ROPE);
    const float* qg = a.in[I_QN] + l * 64; const float* kg = a.in[I_KN] + l * 64;
    const int kvh = item & 3, n = (item >> 2) & 15, b = item >> 6;
    LAS bf16* Ks = (LAS bf16*)lds; LAS bf16* Vt = (LAS bf16*)(lds + 256 * AP_KST * 2);
#pragma unroll
    for (int i = 0; i < 4; ++i) { const int c = tid + 512 * i, r = c >> 3, ch = c & 7, pos = 128 * (n - 1) + r, pc = pos >= 0 ? pos : 0;
        v4u val = (v4u){0u, 0u, 0u, 0u}; if (pos >= 0) val = *(const v4u*)(P + (size_t)(b * SEQ + pos) * IN_DIM + C_K + kvh * 64 + ch * 8);
        float x[8]; unpack8(val, x); knorm_rope8(x, ch, kg, RT + pc * 8);
        *(LAS v4u*)(Ks + r * AP_KST + ch * 8) = pack8f(x);
        if (n == 15 && r >= 128) { float* o = a.out + O_NKP + ((size_t)(l * NB + b) * 128 + (r - 128)) * 256 + kvh * 64 + ch * 8;
            *(f32x4*)o = (f32x4){x[0], x[1], x[2], x[3]}; *(f32x4*)(o + 4) = (f32x4){x[4], x[5], x[6], x[7]}; } }
#pragma unroll
    for (int i = 0; i < 4; ++i) { const int c = tid + 512 * i, key = c & 255, ch = c >> 8, pos = 128 * (n - 1) + key;
        v4u val = (v4u){0u, 0u, 0u, 0u}; if (pos >= 0) val = *(const v4u*)(P + (size_t)(b * SEQ + pos) * IN_DIM + C_V + kvh * 64 + ch * 8);
        LAS bf16* d = Vt + (ch * 8) * AP_VST + key;
        d[0 * AP_VST] = (bf16)(val.x & 0xffffu); d[1 * AP_VST] = (bf16)(val.x >> 16); d[2 * AP_VST] = (bf16)(val.y & 0xffffu); d[3 * AP_VST] = (bf16)(val.y >> 16);
        d[4 * AP_VST] = (bf16)(val.z & 0xffffu); d[5 * AP_VST] = (bf16)(val.z >> 16); d[6 * AP_VST] = (bf16)(val.w & 0xffffu); d[7 * AP_VST] = (bf16)(val.w >> 16);
        if (n == 15 && key >= 128) { float* o = a.out + O_NVP + ((size_t)(l * NB + b) * 128 + (key - 128)) * 256 + kvh * 64 + ch * 8;
            *(f32x4*)o = (f32x4){lo16(val.x), hi16(val.x), lo16(val.y), hi16(val.y)}; *(f32x4*)(o + 4) = (f32x4){lo16(val.z), hi16(val.z), lo16(val.w), hi16(val.w)}; } }
    __syncthreads();
    const int g = wave >> 1, half = wave & 1, head = kvh * 4 + g; const float sink = a.in[I_SINK][l * 16 + head];
#pragma nounroll
    for (int qg_i = 0; qg_i < 4; ++qg_i) {
        const int qi = 64 * half + 16 * qg_i + (lane & 15); const size_t tok = (size_t)b * SEQ + 128 * n + qi;
        attn_qgroup<16>(Ks, AP_KST, Vt, AP_VST, P + tok * IN_DIM + head * 64, qg, RT + (128 * n + qi) * 8, qi, n > 0, sink, O + tok * 1536 + head * 64, true, lane);
    }
    __syncthreads();
}

__device__ __forceinline__ void attn_sample_item(const Args& a, int l, int item, LAS unsigned char* lds) {
    int tid_o = threadIdx.x; asm volatile("" : "+v"(tid_o)); const int tid = tid_o, lane = tid & 63, wave = __builtin_amdgcn_readfirstlane(tid >> 6); (void)lane; (void)wave;
    unsigned char* ws = a.ws; asm volatile("" : "+s"(ws)); const bf16* P = (const bf16*)(ws + WS_P); bf16* O = (bf16*)(ws + WS_O); const f32x2* RT = (const f32x2*)(ws + WS_ROPE);
    const float* qg = a.in[I_QN] + l * 64; const float* kg = a.in[I_KN] + l * 64;
    const int pair = item & 1, b = item >> 1;
    LAS bf16* Ks = (LAS bf16*)lds; LAS bf16* Vt = (LAS bf16*)(lds + 2 * AS_NK * AS_KST * 2);
    const float* ck = a.in[I_CK] + (size_t)(l * DECB + b) * 128 * 256; const float* cv = a.in[I_CV] + (size_t)(l * DECB + b) * 128 * 256;
    float* onk = a.out + O_NKS + (size_t)(l * DECB + b) * 128 * 256; float* onv = a.out + O_NVS + (size_t)(l * DECB + b) * 128 * 256;
#pragma unroll
    for (int i = 0; i < 8; ++i) { const int c = tid + 512 * i, kk = c >> 11, rem = c & 2047, r = rem >> 4, ch4 = rem & 15;
        const f32x4 v = *(const f32x4*)(ck + (size_t)r * 256 + (2 * pair + kk) * 64 + ch4 * 4); v2u w; w.x = pk2(v[0], v[1]); w.y = pk2(v[2], v[3]);
        *(LAS v2u*)(Ks + (kk * AS_NK + r) * AS_KST + ch4 * 4) = w;
        if (r >= 8) *(f32x4*)(onk + (size_t)(r - 8) * 256 + (2 * pair + kk) * 64 + ch4 * 4) = v; }
    { const int kk = tid >> 8, rem = tid & 255, r = 128 + (rem >> 3), ch = rem & 7, t = r < 136 ? r - 128 : 0;
      v4u val = (v4u){0u, 0u, 0u, 0u}; if (r < 136) val = *(const v4u*)(P + (size_t)(NPTOK + b * DECT + t) * IN_DIM + C_K + (2 * pair + kk) * 64 + ch * 8);
      float x[8]; unpack8(val, x); knorm_rope8(x, ch, kg, RT + (2048 + t) * 8);
      *(LAS v4u*)(Ks + (kk * AS_NK + r) * AS_KST + ch * 8) = pack8f(x);
      if (r < 136) { float* o = onk + (size_t)(120 + t) * 256 + (2 * pair + kk) * 64 + ch * 8; *(f32x4*)o = (f32x4){x[0], x[1], x[2], x[3]}; *(f32x4*)(o + 4) = (f32x4){x[4], x[5], x[6], x[7]}; } }
#pragma unroll
    for (int i = 0; i < 8; ++i) { const int c = tid + 512 * i, key = c & 127, kk = (c >> 7) & 1, ch4 = c >> 8;
        const f32x4 v = *(const f32x4*)(cv + (size_t)key * 256 + (2 * pair + kk) * 64 + ch4 * 4);
        LAS bf16* d = Vt + (kk * 64 + ch4 * 4) * AS_VST + key;
        d[0] = (bf16)f2bf(v[0]); d[AS_VST] = (bf16)f2bf(v[1]); d[2 * AS_VST] = (bf16)f2bf(v[2]); d[3 * AS_VST] = (bf16)f2bf(v[3]);
        if (key >= 8) *(f32x4*)(onv + (size_t)(key - 8) * 256 + (2 * pair + kk) * 64 + ch4 * 4) = v; }
#pragma unroll
    for (int i = 0; i < 8; ++i) { const int c = tid + 512 * i, col = 128 + (c & 31), d = (c >> 5) & 63, kk = c >> 11; bf16 val = 0;
        if (col < 136) { val = P[(size_t)(NPTOK + b * DECT + (col - 128)) * IN_DIM + C_V + (2 * pair + kk) * 64 + d]; onv[(size_t)(120 + col - 128) * 256 + (2 * pair + kk) * 64 + d] = bf2f(val); }
        Vt[(kk * 64 + d) * AS_VST + col] = val; }
    __syncthreads();
    const int kk = wave >> 2, g = wave & 3, kvh = 2 * pair + kk, head = kvh * 4 + g; const float sink = a.in[I_SINK][l * 16 + head];
    const int qi = lane & 15, qld = qi < 8 ? qi : 7; const size_t tok = (size_t)NPTOK + b * DECT + qld;
    attn_qgroup<10>(Ks + kk * AS_NK * AS_KST, AS_KST, Vt + kk * 64 * AS_VST, AS_VST, P + tok * IN_DIM + head * 64, qg, RT + (2048 + qld) * 8, qi, true, sink, O + tok * 1536 + head * 64, qi < 8, lane);
    __syncthreads();
}

template <int TT>
__device__ __forceinline__ void conv_compute(const Args& a, int l, LAS float* U, LAS float* red, LAS float* stat, size_t tok0, int tid, int wave, int lane) {
    const int c = tid;
    float w[31];
#pragma unroll
    for (int j = 0; j < 31; ++j) w[j] = a.in[I_CW][(size_t)(l * 31 + j) * 512 + c];
    const float bias = a.in[I_CB][l * 512 + c];
    float y[TT];
#pragma unroll
    for (int tb = 0; tb < TT / 8; ++tb) {
        float win[38];
#pragma unroll
        for (int r = 0; r < 38; ++r) win[r] = U[(tb * 8 + r) * 512 + c];
#pragma unroll
        for (int t = 0; t < 8; ++t) { float acc = bias;
#pragma unroll
            for (int j = 0; j < 31; ++j) acc = fmaf(w[j], win[t + j], acc);
            y[tb * 8 + t] = acc; }
    }
#pragma unroll
    for (int t = 0; t < TT; ++t) { const float s1 = wave_sum(y[t]), s2 = wave_sum(y[t] * y[t]); if (lane == 0) { red[(wave * 32 + t) * 2] = s1; red[(wave * 32 + t) * 2 + 1] = s2; } }
    __syncthreads();
    if (tid < TT * 2) { const int t = tid >> 1, k = tid & 1; float s = 0.f;
#pragma unroll
        for (int ww = 0; ww < 8; ++ww) s += red[(ww * 32 + t) * 2 + k];
        stat[t * 2 + k] = s; }
    __syncthreads();
    const float lg = a.in[I_CLG][l * 512 + c], lb = a.in[I_CLB][l * 512 + c];
    bf16* YC = (bf16*)(a.ws + WS_O) + 1024;
#pragma unroll
    for (int t = 0; t < TT; ++t) { const float mean = stat[t * 2] * (1.f / 512.f), var = stat[t * 2 + 1] * (1.f / 512.f) - mean * mean, rstd = rsqrtf(fmaxf(var, 0.f) + 1e-6f);
        const float v = (y[t] - mean) * rstd * lg + lb; YC[(tok0 + t) * 1536 + c] = (bf16)f2bf(v * sigm(v)); }
}
__device__ __forceinline__ void glu8(const bf16* P, size_t tok, int ch, float (&u)[8]) {
    const v4u av = *(const v4u*)(P + tok * IN_DIM + C_XA + ch * 8), bv = *(const v4u*)(P + tok * IN_DIM + C_XB + ch * 8);
    u[0] = lo16(av.x) * sigm(lo16(bv.x)); u[1] = hi16(av.x) * sigm(hi16(bv.x)); u[2] = lo16(av.y) * sigm(lo16(bv.y)); u[3] = hi16(av.y) * sigm(hi16(bv.y));
    u[4] = lo16(av.z) * sigm(lo16(bv.z)); u[5] = hi16(av.z) * sigm(hi16(bv.z)); u[6] = lo16(av.w) * sigm(lo16(bv.w)); u[7] = hi16(av.w) * sigm(hi16(bv.w));
}
__device__ __forceinline__ void conv_prompt_item(const Args& a, int l, int item, LAS unsigned char* lds) {
    int tid_o = threadIdx.x; asm volatile("" : "+v"(tid_o)); const int tid = tid_o, lane = tid & 63, wave = __builtin_amdgcn_readfirstlane(tid >> 6); (void)lane; (void)wave;
    const bf16* P = (const bf16*)(a.ws + WS_P);
    LAS float* U = (LAS float*)lds; LAS float* red = U + 62 * 512; LAS float* stat = red + 512;
    const int b = item >> 6, tile = item & 63, t0 = tile * 32;
#pragma unroll 4
    for (int c = tid; c < 62 * 64; c += 512) { const int r = c >> 6, ch = c & 63, t = t0 - 30 + r; float u[8];
        if (t >= 0) glu8(P, (size_t)b * SEQ + t, ch, u); else {
#pragma unroll
            for (int e = 0; e < 8; ++e) u[e] = 0.f; }
        *(LAS f32x4*)(U + r * 512 + ch * 8) = (f32x4){u[0], u[1], u[2], u[3]}; *(LAS f32x4*)(U + r * 512 + ch * 8 + 4) = (f32x4){u[4], u[5], u[6], u[7]};
        if (tile == 63 && t >= SEQ - 30) { float* o = a.out + O_NCP + ((size_t)(l * NB + b) * 30 + (t - (SEQ - 30))) * 512 + ch * 8;
            *(f32x4*)o = (f32x4){u[0], u[1], u[2], u[3]}; *(f32x4*)(o + 4) = (f32x4){u[4], u[5], u[6], u[7]}; } }
    __syncthreads();
    conv_compute<32>(a, l, U, red, stat, (size_t)b * SEQ + t0, tid, wave, lane);
    __syncthreads();
}
__device__ __forceinline__ void conv_sample_item(const Args& a, int l, int item, LAS unsigned char* lds) {
    int tid_o = threadIdx.x; asm volatile("" : "+v"(tid_o)); const int tid = tid_o, lane = tid & 63, wave = __builtin_amdgcn_readfirstlane(tid >> 6); (void)lane; (void)wave;
    const bf16* P = (const bf16*)(a.ws + WS_P);
    LAS float* U = (LAS float*)lds; LAS float* red = U + 62 * 512; LAS float* stat = red + 512;
    const int b = item; const float* sc = a.in[I_SCONV] + (size_t)(l * DECB + b) * 30 * 512;
#pragma unroll 5
    for (int c = tid; c < 38 * 64; c += 512) { const int r = c >> 6, ch = c & 63; float u[8];
        if (r < 30) { const f32x4 x0 = *(const f32x4*)(sc + r * 512 + ch * 8), x1 = *(const f32x4*)(sc + r * 512 + ch * 8 + 4);
            u[0] = x0[0]; u[1] = x0[1]; u[2] = x0[2]; u[3] = x0[3]; u[4] = x1[0]; u[5] = x1[1]; u[6] = x1[2]; u[7] = x1[3]; }
        else glu8(P, (size_t)NPTOK + b * DECT + (r - 30), ch, u);
        *(LAS f32x4*)(U + r * 512 + ch * 8) = (f32x4){u[0], u[1], u[2], u[3]}; *(LAS f32x4*)(U + r * 512 + ch * 8 + 4) = (f32x4){u[4], u[5], u[6], u[7]};
        if (r >= 8) { float* o = a.out + O_NCS + ((size_t)(l * DECB + b) * 30 + (r - 8)) * 512 + ch * 8;
            *(f32x4*)o = (f32x4){u[0], u[1], u[2], u[3]}; *(f32x4*)(o + 4) = (f32x4){u[4], u[5], u[6], u[7]}; } }
    __syncthreads();
    conv_compute<8>(a, l, U, red, stat, (size_t)NPTOK + b * DECT, tid, wave, lane);
    __syncthreads();
}

struct SsmLane { float ar, ai; f32x2 bz[16]; bf16x8 cf[4]; f32x4 dv; float a256r, a256i; };
__device__ __forceinline__ void ssm_setup(const Args& a, int l, int g, int lane, SsmLane& S) {
    const int p = lane, lg = l * 32 + g;
    const double are = (double)a.in[I_ARE][lg * 64 + p], aim = (double)a.in[I_AIM][lg * 64 + p], dt = dexp_((double)a.in[I_LDT][lg]);
    const double mag = dexp_(are * dt); double sn, cs; dsincos_(aim * dt, sn, cs);
    const double abr = mag * cs, abi = mag * sn, den = are * are + aim * aim;
    const double zr = ((abr - 1.0) * are + abi * aim) / den, zi = (abi * are - (abr - 1.0) * aim) / den;
    S.ar = (float)abr; S.ai = (float)abi;
    double pr = abr, pi = abi;
#pragma unroll
    for (int i = 0; i < 8; ++i) { const double nr = pr * pr - pi * pi, ni = 2.0 * pr * pi; pr = nr; pi = ni; }
    S.a256r = (float)pr; S.a256i = (float)pi;
    const float* br = a.in[I_BRE] + (size_t)(lg * 64 + p) * 16; const float* bi = a.in[I_BIM] + (size_t)(lg * 64 + p) * 16;
    const float zrf = (float)zr, zif = (float)zi;
#pragma unroll
    for (int c = 0; c < 16; ++c) { const float x = br[c], y = bi[c]; S.bz[c] = (f32x2){zrf * x - zif * y, zrf * y + zif * x}; }
    const int lr = lane & 15, q4 = lane >> 4;
#pragma unroll
    for (int ks = 0; ks < 4; ++ks) { const int k0 = (ks & 1) * 32 + 8 * q4; const float* src = (ks < 2 ? a.in[I_CRE] : a.in[I_CIM]) + (size_t)(lg * 16 + lr) * 64 + k0; const float sg = ks < 2 ? 1.f : -1.f;
        const f32x4 x0 = *(const f32x4*)src, x1 = *(const f32x4*)(src + 4);
        v4u w; w.x = pk2(sg * x0[0], sg * x0[1]); w.y = pk2(sg * x0[2], sg * x0[3]); w.z = pk2(sg * x1[0], sg * x1[1]); w.w = pk2(sg * x1[2], sg * x1[3]);
        S.cf[ks] = __builtin_bit_cast(bf16x8, w); }
    S.dv = *(const f32x4*)(a.in[I_SD] + l * 512 + g * 16 + 4 * q4);
}
__device__ __forceinline__ float gelu_tanh(float x) { const float z = 0.7978845608028654f * (x + 0.044715f * x * x * x); const float t = 1.f - 2.f * __builtin_amdgcn_rcpf(__expf(2.f * z) + 1.f); return 0.5f * x * (1.f + t); }

template <bool PASS2>
__device__ __forceinline__ void ssm_run(const Args& a, const SsmLane& S, int g, size_t tok0, int nsub, int nvalid, float& hr, float& hi, LAS float* ubuf, LAS bf16* hbuf, int lane) {
    const bf16* P = (const bf16*)(a.ws + WS_P); bf16* YS = (bf16*)(a.ws + WS_YS);
    const int lr = lane & 15, q4 = lane >> 4, st_l = lane >> 2, c4 = (lane & 3) * 4;
    v2u wnext = (v2u){0u, 0u};
    if (st_l < nvalid) wnext = *(const v2u*)(P + (tok0 + st_l) * IN_DIM + C_XS + g * 16 + c4);
#pragma nounroll
    for (int sub = 0; sub < nsub; ++sub) {
        *(LAS f32x4*)(ubuf + st_l * 16 + c4) = (f32x4){lo16(wnext.x), hi16(wnext.x), lo16(wnext.y), hi16(wnext.y)};
        if (sub + 1 < nsub) wnext = *(const v2u*)(P + (tok0 + (sub + 1) * 16 + st_l) * IN_DIM + C_XS + g * 16 + c4);
        WAVE_SYNC();
        f32x4 un[4];
#pragma unroll
        for (int q = 0; q < 4; ++q) un[q] = *(const LAS f32x4*)(ubuf + q * 4);
#pragma unroll
        for (int st = 0; st < 16; ++st) {
            f32x4 uc[4];
#pragma unroll
            for (int q = 0; q < 4; ++q) uc[q] = un[q];
            if (st < 15) {
#pragma unroll
                for (int q = 0; q < 4; ++q) un[q] = *(const LAS f32x4*)(ubuf + (st + 1) * 16 + q * 4);
            }
            if (st < nvalid) {
                f32x2 x2 = (f32x2){0.f, 0.f};
#pragma unroll
                for (int q = 0; q < 4; ++q)
#pragma unroll
                    for (int c = 0; c < 4; ++c) x2 = S.bz[4 * q + c] * (f32x2){uc[q][c], uc[q][c]} + x2;
                const f32x2 t2 = (f32x2){S.ar, S.ar} * (f32x2){hr, hi} + x2;
                const f32x2 n2 = (f32x2){-S.ai, S.ai} * (f32x2){hi, hr} + t2;
                hr = n2.x; hi = n2.y;
            }
            if (PASS2) { const unsigned hw = pk2(hr, hi); hbuf[st * 136 + lane] = (bf16)(hw & 0xffffu); hbuf[st * 136 + 64 + lane] = (bf16)(hw >> 16); }
            __builtin_amdgcn_sched_barrier(0);
        }
        if (PASS2) {
            WAVE_SYNC();
            f32x4 acc = (f32x4){0.f, 0.f, 0.f, 0.f};
#pragma unroll
            for (int ks = 0; ks < 4; ++ks) { const bf16x8 hb = *(const LAS bf16x8*)(hbuf + lr * 136 + 32 * ks + 8 * q4); acc = __builtin_amdgcn_mfma_f32_16x16x32_bf16(S.cf[ks], hb, acc, 0, 0, 0); }
            const f32x4 uv = *(const LAS f32x4*)(ubuf + lr * 16 + 4 * q4);
            if (lr < nvalid) { f32x4 yv = acc + S.dv * uv; v2u w; w.x = pk2(gelu_tanh(yv[0]), gelu_tanh(yv[1])); w.y = pk2(gelu_tanh(yv[2]), gelu_tanh(yv[3]));
                *(v2u*)(YS + (tok0 + sub * 16 + lr) * 512 + g * 16 + 4 * q4) = w; }
        }
        WAVE_SYNC();
    }
}
__device__ __forceinline__ void ssm_prompt_item(const Args& a, int l, int item, LAS unsigned char* lds) {
    int tid_o = threadIdx.x; asm volatile("" : "+v"(tid_o)); const int tid = tid_o, lane = tid & 63, wave = __builtin_amdgcn_readfirstlane(tid >> 6); (void)lane; (void)wave;
    const int g = item & 31, b = item >> 5;
    LAS float* ubuf = (LAS float*)(lds + wave * 5632); LAS bf16* hbuf = (LAS bf16*)(lds + wave * 5632 + 1024); LAS float* ex = (LAS float*)(lds + 8 * 5632);
    SsmLane S; ssm_setup(a, l, g, lane, S);
    const size_t tok0 = (size_t)b * SEQ + 256 * wave;
    float hr = 0.f, hi = 0.f;
    ssm_run<false>(a, S, g, tok0, 16, 16, hr, hi, ubuf, hbuf, lane);
    ex[(wave * 64 + lane) * 2] = hr; ex[(wave * 64 + lane) * 2 + 1] = hi;
    __syncthreads();
    hr = 0.f; hi = 0.f;
    for (int j = 0; j < wave; ++j) { const float er = ex[(j * 64 + lane) * 2], ei = ex[(j * 64 + lane) * 2 + 1]; const float nr = S.a256r * hr - S.a256i * hi + er, ni = S.a256r * hi + S.a256i * hr + ei; hr = nr; hi = ni; }
    ssm_run<true>(a, S, g, tok0, 16, 16, hr, hi, ubuf, hbuf, lane);
    if (wave == 7) { a.out[O_NRP + (size_t)((l * NB + b) * 32 + g) * 64 + lane] = hr; a.out[O_NIP + (size_t)((l * NB + b) * 32 + g) * 64 + lane] = hi; }
    __syncthreads();
}
__device__ __forceinline__ void ssm_sample_item(const Args& a, int l, int item, LAS unsigned char* lds) {
    int tid_o = threadIdx.x; asm volatile("" : "+v"(tid_o)); const int tid = tid_o, lane = tid & 63, wave = __builtin_amdgcn_readfirstlane(tid >> 6); (void)lane; (void)wave;
    const int g = item & 31, bg = item >> 5;
    LAS float* ubuf = (LAS float*)(lds + wave * 5632); LAS bf16* hbuf = (LAS bf16*)(lds + wave * 5632 + 1024);
    SsmLane S; ssm_setup(a, l, g, lane, S);
    for (int bb = 0; bb < 2; ++bb) {
        const int bs = bg * 16 + wave * 2 + bb; const size_t so = (size_t)((l * DECB + bs) * 32 + g) * 64 + lane;
        float hr = a.in[I_SRE][so], hi = a.in[I_SIM][so];
        ssm_run<true>(a, S, g, (size_t)NPTOK + bs * DECT, 1, 8, hr, hi, ubuf, hbuf, lane);
        a.out[O_NRS + so] = hr; a.out[O_NIS + so] = hi;
    }
    __syncthreads();
}

__device__ __forceinline__ void mixer_phase(const Args& a, int l, LAS unsigned char* lds) {
    unsigned* qctr = (unsigned*)(a.ws + WS_CTL + 640 * 1024) + l * 64;
    volatile LAS unsigned* qslot = (volatile LAS unsigned*)(lds + 131072 + 128);
    for (;;) {
        if (threadIdx.x == 0) *qslot = __hip_atomic_fetch_add(qctr, 1u, __ATOMIC_RELAXED, __HIP_MEMORY_SCOPE_AGENT);
        __syncthreads();
        const int it = (int)*qslot;
        __syncthreads();
        if (it >= 1280) break;
        if (0) {}
#ifndef NO_SSMP
        else if (it < 128) ssm_prompt_item(a, l, it, lds);
#endif
#ifndef NO_ATTP
        else if (it < 384) attn_prompt_item(a, l, it - 128, lds);
#endif
#ifndef NO_CONVP
        else if (it < 640) conv_prompt_item(a, l, it - 384, lds);
#endif
#ifndef NO_ATTS
        else if (it < 896) attn_sample_item(a, l, it - 640, lds);
#endif
#ifndef NO_SSMS
        else if (it < 1152) ssm_sample_item(a, l, it - 896, lds);
#endif
#ifndef NO_CONVS
        else if (it < 1280) conv_sample_item(a, l, it - 1152, lds);
#endif
    }
}

#define XB_TMO      128
#define XB_XCNT(j)  (256  + 64 * (j))
#define XB_XSUB(j)  (1280 + 64 * (j))
#define XB_XGEN(j)  (2304 + 64 * (j))
#define XB_TOP      3328
#define XB_TOPGEN   3392
#define XCD_BAR_WORDS 3456
#define XB_SPIN_CAP (1u << 18)

__device__ __forceinline__ unsigned xb_ld(unsigned* p)              { return __hip_atomic_load(p, __ATOMIC_RELAXED, __HIP_MEMORY_SCOPE_AGENT); }
__device__ __forceinline__ unsigned xb_add(unsigned* p, unsigned v) { return __hip_atomic_fetch_add(p, v, __ATOMIC_RELAXED, __HIP_MEMORY_SCOPE_AGENT); }
__device__ __forceinline__ unsigned xb_xcc_id() { return (unsigned)__builtin_amdgcn_s_getreg((3 << 11) | 20) & 0xFu; }
#define XB_SPIN(cond, bar) do { unsigned _sp = 0; while (cond) { __builtin_amdgcn_s_sleep(1); \
    if ((++_sp & 255u) == 0u) { if (xb_ld(&(bar)[XB_TMO])) break; if (_sp > XB_SPIN_CAP) { atomicAdd(&(bar)[XB_TMO], 1u); break; } } } } while (0)

struct XcdBarrier {
    unsigned* bar; unsigned x;
    volatile LAS unsigned* st;
};

__device__ __forceinline__ XcdBarrier xcd_barrier_post(unsigned* bar, volatile LAS unsigned* st) {
    XcdBarrier b; b.bar = bar; b.x = xb_xcc_id(); b.st = st;
    if (threadIdx.x == 0) (void)xb_add(&bar[XB_XCNT(b.x)], 1u);
    return b;
}
__device__ __forceinline__ void xcd_barrier_complete(unsigned* bar, unsigned x, unsigned& nloc, unsigned& nx) {
    const unsigned G = gridDim.x * gridDim.y * gridDim.z;
    unsigned sum, cnt, mine, sp = 0u;
    for (;;) {
        sum = 0u; cnt = 0u; mine = 0u;
#pragma unroll
        for (unsigned j = 0; j < 16; ++j) { const unsigned c = xb_ld(&bar[XB_XCNT(j)]); sum += c; cnt += (c > 0u) ? 1u : 0u; mine = (j == x) ? c : mine; }
        if (sum == G) break;
        __builtin_amdgcn_s_sleep(1);
        if ((++sp & 255u) == 0u) { if (xb_ld(&bar[XB_TMO])) break; if (sp > XB_SPIN_CAP) { atomicAdd(&bar[XB_TMO], 1u); break; } }
    }
    nloc = mine > 0u ? mine : 1u; nx = cnt > 0u ? cnt : 1u;
}

__device__ __forceinline__ void xcd_barrier(const XcdBarrier& b) {
    asm volatile("s_waitcnt vmcnt(0)" ::: "memory");
    __syncthreads();
    if (threadIdx.x == 0) {
        unsigned* bar = b.bar;
        __builtin_amdgcn_s_waitcnt(0);
        unsigned nloc = b.st[0], nx = b.st[1];
        if (nloc == 0u) { xcd_barrier_complete(bar, b.x, nloc, nx); b.st[0] = nloc; b.st[1] = nx; }
        const unsigned old = xb_add(&bar[XB_XSUB(b.x)], 1u);
        const unsigned gen = old / nloc;
        if (old + 1u == (gen + 1u) * nloc) {
            __builtin_amdgcn_fence(__ATOMIC_RELEASE, "agent");
            asm volatile("s_waitcnt vmcnt(0)" ::: "memory");
            const unsigned og = xb_add(&bar[XB_TOP], 1u);
            const unsigned tg = og / nx;
            if (og + 1u == (tg + 1u) * nx) xb_add(&bar[XB_TOPGEN], 1u);
            else XB_SPIN(xb_ld(&bar[XB_TOPGEN]) == tg, bar);
            __builtin_amdgcn_fence(__ATOMIC_ACQUIRE, "agent");
            xb_add(&bar[XB_XGEN(b.x)], 1u);
            asm volatile("s_waitcnt vmcnt(0)" ::: "memory");
        } else {
            XB_SPIN(xb_ld(&bar[XB_XGEN(b.x)]) == gen, bar);
            __builtin_amdgcn_fence(__ATOMIC_ACQUIRE, "agent");
            asm volatile("s_waitcnt vmcnt(0)" ::: "memory");
        }
    }
    __syncthreads();
}

constexpr size_t WS_BAR = 768 * 1024;
constexpr int LDS_ST_OFF = 131072 + 64;

#define IN(k) (lo <= (k) && (k) < hi)
#ifdef PROBE_SEL
#define SEAM(k) do { if (IN(k) && IN((k) + 1)) { xcd_barrier(xbar); } if (blockIdx.x == 0 && threadIdx.x == 0) ((unsigned long long*)(a.ws + WS_CTL + 512 * 1024))[(k) + 1] = __builtin_amdgcn_s_memrealtime(); } while (0)
#else
#define SEAM(k) do { if (IN(k) && IN((k) + 1)) { xcd_barrier(xbar); } } while (0)
#endif
#define GEMM(EPI, E, Aptr, Bptr, M_, N_, K_, S_, SLOTS_, CID_) GEMMS(EPI, E, Aptr, Bptr, M_, N_, K_, S_, SLOTS_, CID_, 0)
#define GEMMS(EPI, E, Aptr, Bptr, M_, N_, K_, S_, SLOTS_, CID_, SEGK_) do { pg8::Gemm g_{(const pg8::bf16_t*)(Aptr), (const pg8::bf16_t*)(Bptr), M_, N_, K_}; pg8::HybridOrder S_o; \
        S_o.init(M_, N_, K_, G, (int)blockIdx.x, S_, (float*)(SLOTS_), (unsigned*)(ws + WS_CTL) + (CID_) * 2048); \
        S_o.segk = SEGK_; pg8::gemm_phase<EPI, pg8::HybridOrder, true, true>(lds, g_, S_o, E); } while (0)
template <int l>
__device__ __forceinline__ void layer_phases(const Args& a, LAS unsigned char* lds, cg::grid_group& grid, const XcdBarrier& xbar, int lo, int hi) {
    const int G = gridDim.x; float* Y = a.out + O_Y;
        const int pb = 2 + 9 * l;
        int tid_l = threadIdx.x; asm volatile("" : "+v"(tid_l));
        unsigned char* ws = a.ws; asm volatile("" : "+s"(ws));
        const int tid = tid_l, lane = tid & 63, wave = __builtin_amdgcn_readfirstlane(tid >> 6), gw = blockIdx.x * 8 + wave, gtid = blockIdx.x * 512 + tid;
        float* mod = (float*)(ws + WS_MOD); bf16* Hb = (bf16*)(ws + WS_H); bf16* Pb = (bf16*)(ws + WS_P); float* MG = (float*)(ws + WS_MG); float* Xb = (float*)(ws + WS_X);
        const unsigned char* wl = ws + WS_WL + (size_t)l * WL_STRIDE;
        const float* xp = l == 0 ? a.in[I_XP] : Xb; const float* xs = l == 0 ? a.in[I_XS] : Xb + (size_t)NPTOK * DM;
        float* xout = l == 0 ? Xb : Y;
#ifndef NO_NORM
        if (IN(pb + 0)) norm_mod_phase(xp, xs, a.in[I_NORM1] + l * DM, mod, l, 0, Hb);
#endif
        SEAM(pb + 0);
#ifndef NO_G1
        if (IN(pb + 1)) { pg8::EpiP E{Pb}; GEMM(pg8::EpiP, E, Hb, wl + WL_IN, NTOK, IN_DIM, DM, SK_G1, ws + WS_WADA, 1 + 8 * l); }
#endif
        SEAM(pb + 1);
#ifndef NO_MIX
        if (IN(pb + 3)) mixer_phase(a, l, lds);
#endif
        SEAM(pb + 3);
#ifndef NO_MERGE
        if (IN(pb + 4)) {
            { pg8::EpiGlu E{(pg8::bf16_t*)MG, Pb}; GEMM(pg8::EpiGlu, E, ws + WS_YS, wl + WL_GA, NTOK, 2 * DM, 512, 1, ws + WS_WADA, 2 + 8 * l); }
            { pg8::EpiMergeMain E{(const pg8::bf16_t*)MG, Pb, Hb}; GEMMS(pg8::EpiMergeMain, E, ws + WS_O, wl + WL_O, NTOK, DM, 1536, 1, ws + WS_WADA, 3 + 8 * l, 16); }
        }
#endif
        SEAM(pb + 4);
#ifndef NO_REST
        if (IN(pb + 5)) { pg8::EpiResid E{xp, xs, mod + l * ADA_N + 2 * DM, Y}; GEMM(pg8::EpiResid, E, Hb, wl + WL_OUT, NTOK, DM, DM, SK_WO, ws + WS_WADA, 6 + 8 * l); }
        SEAM(pb + 5);
        if (IN(pb + 6)) norm_mod_phase(Y, Y + (size_t)NPTOK * DM, a.in[I_NORM2] + l * DM, mod, l, 1, Hb);
        SEAM(pb + 6);
        if (IN(pb + 7)) { pg8::EpiRelu2 E{Pb}; GEMM(pg8::EpiRelu2, E, Hb, wl + WL_F1, NTOK, FF, DM, SK_F1, ws + WS_WADA, 7 + 8 * l); }
        SEAM(pb + 7);
        if (IN(pb + 8)) { pg8::EpiResid E{Y, Y + (size_t)NPTOK * DM, mod + l * ADA_N + 5 * DM, xout}; GEMM(pg8::EpiResid, E, Pb, wl + WL_F2, NTOK, DM, FF, SK_F2, ws + WS_WADA, 8 + 8 * l); }
#endif
        SEAM(pb + 8);
}

__global__ void __launch_bounds__(512, 2) hybrid_fwd(Args a) {
    extern __shared__ __attribute__((aligned(16))) unsigned char lds_raw[];
    LAS unsigned char* lds = (LAS unsigned char*)lds_raw;
    cg::grid_group grid = cg::this_grid();
    const int tid = threadIdx.x, lane = tid & 63, wave = __builtin_amdgcn_readfirstlane(tid >> 6);
    const int G = gridDim.x, gw = blockIdx.x * 8 + wave, NGW = G * 8, gtid = blockIdx.x * 512 + tid, NGT = G * 512;
    unsigned char* ws = a.ws;
    const int lo = a.ph_lo, hi = a.ph_hi;
    if (threadIdx.x < 4) ((LAS unsigned*)(lds + LDS_ST_OFF))[threadIdx.x] = 0u;
    __syncthreads();
    if (a.ph_lo < 0) grid.sync();
    const XcdBarrier xbar = xcd_barrier_post((unsigned*)(a.ws + WS_CTL + WS_BAR), (volatile LAS unsigned*)(lds + LDS_ST_OFF));
    float* mod = (float*)(ws + WS_MOD);
    bf16* Hb = (bf16*)(ws + WS_H); bf16* Pb = (bf16*)(ws + WS_P); float* MG = (float*)(ws + WS_MG); float* Xb = (float*)(ws + WS_X);
    float* Y = a.out + O_Y;
#ifdef PROBE_SEL
    if (blockIdx.x == 0 && threadIdx.x == 0) ((unsigned long long*)(a.ws + WS_CTL + 512 * 1024))[0] = __builtin_amdgcn_s_memrealtime();
#endif
#ifndef NO_P0
    if (IN(0)) { p0_prologue(a, lds, gw, NGW, lane, wave, gtid, NGT); __syncthreads(); }
#endif
    SEAM(0);
#ifndef NO_ADA
    if (IN(1)) { pg8::EpiAda E{mod, a.in[I_BADA]}; GEMM(pg8::EpiAda, E, ws + WS_AC, ws + WS_WADA, 256, 2 * ADA_N, DM, 1, ws + WS_X, 0); convert_idle(a, lds, 0, 96, I_L0_PRO, I_LAYER); }
#endif
    SEAM(1);
    layer_phases<0>(a, lds, grid, xbar, lo, hi);
    layer_phases<1>(a, lds, grid, xbar, lo, hi);
#ifdef PROBE_SEL
    grid.sync();
    if (blockIdx.x == 0 && threadIdx.x == 0) { const unsigned long long* ts = (const unsigned long long*)(a.ws + WS_CTL + 512 * 1024);
        const float us = (float)(ts[PROBE_SEL + 1] - ts[PROBE_SEL]) * 0.01f;
#if PROBE_SEL < 50
        atomicAdd(a.out + O_NIS + 5, us * 0.01f);
#endif
    }
#if PROBE_SEL >= 50
    { const unsigned long long t0 = __builtin_amdgcn_s_memrealtime(); grid.sync(); grid.sync(); grid.sync(); grid.sync(); const unsigned long long t1 = __builtin_amdgcn_s_memrealtime();
      if (blockIdx.x == 0 && threadIdx.x == 0) atomicAdd(a.out + O_NIS + 5, (float)(t1 - t0) * 0.01f * 0.01f); }
#endif
#endif
#undef IN
#undef SEAM
#undef GEMM
}

extern "C" void kernel_launch(void* const* d_in, const int* in_sizes, int n_in, void* d_out, int out_size, void* d_ws, size_t ws_size, hipStream_t stream) {
    static int grid = 0;
    if (grid == 0) {
        if (n_in != 36 || (size_t)out_size != O_END || ws_size < WS_END) { fprintf(stderr, "kernel_launch: unexpected sizes n_in %d out %d ws %zu (need %zu)\n", n_in, out_size, ws_size, (size_t)WS_END); grid = -1; return; }
        int dev = 0, cus = 0, per_cu = 0;
        (void)hipGetDevice(&dev); (void)hipDeviceGetAttribute(&cus, hipDeviceAttributeMultiprocessorCount, dev);
        if (hipFuncSetAttribute((const void*)hybrid_fwd, hipFuncAttributeMaxDynamicSharedMemorySize, LDS_BYTES) != hipSuccess) { fprintf(stderr, "kernel_launch: hipFuncSetAttribute failed\n"); grid = -1; return; }
        if (hipOccupancyMaxActiveBlocksPerMultiprocessor(&per_cu, (const void*)hybrid_fwd, 512, LDS_BYTES) != hipSuccess || per_cu < 1) { fprintf(stderr, "kernel_launch: occupancy query failed (%d)\n", per_cu); per_cu = 1; }
        (void)hipGetLastError();
        if (per_cu > 1) per_cu = 1;
        grid = cus * per_cu;
        fprintf(stderr, "kernel_launch: grid %d (cus %d)\n", grid, cus);
    }
    if (grid < 0) return;
    (void)hipMemsetAsync((char*)d_ws + WS_CTL, 0, CTL_BYTES, stream);
    Args a{};
    for (int i = 0; i < 36; ++i) a.in[i] = (const float*)d_in[i];
    a.out = (float*)d_out; a.ws = (unsigned char*)d_ws;
#if MK_ONE_LAUNCH
    a.ph_lo = 0; a.ph_hi = NPHASE;
    void* args[] = {&a};
    hipError_t e = hipLaunchCooperativeKernel((const void*)hybrid_fwd, dim3(grid), dim3(512), args, LDS_BYTES, stream);
    if (e != hipSuccess) fprintf(stderr, "kernel_launch: cooperative launch failed: %s (grid %d)\n", hipGetErrorString(e), grid);
#else
    for (int k = 0; k < NPHASE; ++k) { a.ph_lo = k; a.ph_hi = k + 1; hipLaunchKernelGGL(hybrid_fwd, dim3(grid), dim3(512), LDS_BYTES, stream, a); }
#endif
}
```
